# Optimizing an MI355X kernel written in HIP

```python
import math
import jax
import jax.numpy as jnp
from jax import lax
import numpy as np


D_MODEL = 2048
BATCH = 2
SEQ = 4096
DEPTH = 4

HEAD_DIM = 64
ROT_DIM = HEAD_DIM // 4
ROPE_THETA = 500000.0
Q_CHUNK = 128
NEG = -1e30
FORCE = 1e30
LN_EPS = 1e-5
SCALE = HEAD_DIM ** -0.5

MOBA_HEADS = 8
MOBA_BLOCK = 256
MOBA_TOPK = 3

NSA_HEADS = 12
NSA_KV_HEADS = 3
CMP_LEN = 32
CMP_STRIDE = 16
CMP_HIDDEN = 128
SLC_BLOCK = 64
SLC_TOPK = 16
SLC_LOCAL = 2
NSA_WINDOW = 512

DIL_CONFIGS = ((128, 1), (512, 4), (2048, 16))
DIL_HEADS_PER_GROUP = 4
DIL_HEADS = DIL_HEADS_PER_GROUP * len(DIL_CONFIGS)

N_EXPERTS = 16
N_GROUPS = 4
EXPERTS_PER_GROUP = N_EXPERTS // N_GROUPS
TOP_K = 2
EXPERT_HIDDEN = D_MODEL // 4
PLE_DIM = 256

DEEPNORM_ALPHA = (2 * DEPTH) ** 0.25
DEEPNORM_BETA = (8 * DEPTH) ** -0.25

MOBA_W = MOBA_HEADS * HEAD_DIM
NSA_QW = NSA_HEADS * HEAD_DIM
NSA_KVW = NSA_KV_HEADS * HEAD_DIM
DIL_W = DIL_HEADS * HEAD_DIM
IN_SPLITS = (MOBA_W, MOBA_W, MOBA_W, NSA_QW) + (NSA_KVW,) * 6 + (NSA_HEADS * 3, DIL_W, DIL_W, DIL_W)
IN_COLS = sum(IN_SPLITS)
SPLIT_POINTS = tuple(int(c) for c in np.cumsum(IN_SPLITS)[:-1])
MIX_OUT = MOBA_W + NSA_QW + DIL_HEADS_PER_GROUP * HEAD_DIM

kernel_name = 'hybrid_moba_nsa_dilated_grouped_moe_deepnorm'


def layer_norm(x, g, b):
    xf = x.astype(jnp.float32)
    mu = jnp.mean(xf, axis=-1, keepdims=True)
    var = jnp.mean(jnp.square(xf - mu), axis=-1, keepdims=True)
    y = (xf - mu) * lax.rsqrt(var + LN_EPS) * g.astype(jnp.float32) + b.astype(jnp.float32)
    return y.astype(x.dtype)


def split_heads(t):
    b, s, w = t.shape
    return t.reshape(b, s, w // HEAD_DIM, HEAD_DIM).transpose(0, 2, 1, 3)


def merge_heads(t):
    b, h, s, d = t.shape
    return t.transpose(0, 2, 1, 3).reshape(b, s, h * d)


def partial_rotary(t, positions):
    half = ROT_DIM // 2
    inv_freq = jnp.exp(jnp.arange(half, dtype=jnp.float32) * (-2.0 * math.log(ROPE_THETA) / ROT_DIM))
    ang = positions.astype(jnp.float32)[:, None, :, None] * inv_freq
    cos = jnp.cos(ang).astype(t.dtype)
    sin = jnp.sin(ang).astype(t.dtype)
    t1 = t[..., :half]
    t2 = t[..., half:ROT_DIM]
    return jnp.concatenate([t1 * cos - t2 * sin, t2 * cos + t1 * sin, t[..., ROT_DIM:]], axis=-1)


def banded_attention(q, k, v, n_back):
    b, hk, g, m, d = q.shape
    blk = min(Q_CHUNK, m)
    nq = -(-m // blk)
    mp = nq * blk
    nbk = -(-n_back // blk)
    qb = jnp.pad(q, ((0, 0), (0, 0), (0, 0), (0, mp - m), (0, 0))).reshape(b, hk, g, nq, blk, d)
    kv_pad = ((0, 0), (0, 0), (nbk * blk, mp - m), (0, 0))
    kp = jnp.pad(k, kv_pad).reshape(b, hk, nbk + nq, blk, d)
    vp = jnp.pad(v, kv_pad).reshape(b, hk, nbk + nq, blk, d)
    k_band = jnp.concatenate([kp[:, :, j:j + nq] for j in range(nbk + 1)], axis=3)
    v_band = jnp.concatenate([vp[:, :, j:j + nq] for j in range(nbk + 1)], axis=3)
    qpos = jnp.arange(nq)[:, None] * blk + jnp.arange(blk)[None, :]
    kpos = jnp.arange(nq)[:, None] * blk + jnp.arange((nbk + 1) * blk)[None, :] - nbk * blk
    diff = qpos[:, :, None] - kpos[:, None, :]
    ok = (diff >= 0) & (diff <= n_back) & (kpos[:, None, :] >= 0)
    sc = jnp.einsum('bkgnid,bknjd->bkgnij', qb, k_band).astype(jnp.float32) * SCALE
    sc = jnp.where(ok, sc, NEG)
    lse = jax.nn.logsumexp(sc, axis=-1)
    pr = jnp.exp(sc - lse[..., None]).astype(v.dtype)
    o = jnp.einsum('bkgnij,bknjd->bkgnid', pr, v_band)
    return o.reshape(b, hk, g, mp, d)[:, :, :, :m], lse.reshape(b, hk, g, mp)[:, :, :, :m]


def moba_attention(q, k, v):
    b, h, s, d = q.shape
    nb = -(-s // MOBA_BLOCK)
    pad = ((0, 0), (0, 0), (0, nb * MOBA_BLOCK - s), (0, 0))
    kb = jnp.pad(k, pad).reshape(b, h, nb, MOBA_BLOCK, d)
    vb = jnp.pad(v, pad).reshape(b, h, nb, MOBA_BLOCK, d)
    k_mean = jnp.mean(kb, axis=3)
    n_sel = min(MOBA_TOPK, nb - 1)
    b_ix = jnp.arange(b)[:, None, None, None]
    h_ix = jnp.arange(h)[None, :, None, None]
    blk_ids = jnp.arange(nb)

    def chunk(c):
        q0 = c * Q_CHUNK
        qc = lax.dynamic_slice_in_dim(q, q0, Q_CHUNK, axis=2)
        qpos = q0 + jnp.arange(Q_CHUNK)
        cur = q0 // MOBA_BLOCK
        k_own = lax.dynamic_index_in_dim(kb, cur, axis=2, keepdims=False)
        v_own = lax.dynamic_index_in_dim(vb, cur, axis=2, keepdims=False)
        kpos_own = cur * MOBA_BLOCK + jnp.arange(MOBA_BLOCK)
        s_own = jnp.einsum('bhqd,bhkd->bhqk', qc, k_own).astype(jnp.float32) * SCALE
        s_own = jnp.where(kpos_own[None, :] <= qpos[:, None], s_own, NEG)
        if n_sel == 0:
            pr = jax.nn.softmax(s_own, axis=-1).astype(v.dtype)
            return jnp.einsum('bhqk,bhkd->bhqd', pr, v_own)
        gate = jnp.einsum('bhqd,bhnd->bhqn', qc, k_mean).astype(jnp.float32)
        gate = jnp.where(blk_ids < cur, gate, NEG)
        _, idx = lax.top_k(gate, n_sel)
        sel_ok = idx < cur
        k_sel = kb[b_ix, h_ix, idx]
        v_sel = vb[b_ix, h_ix, idx]
        s_sel = jnp.einsum('bhqd,bhqnkd->bhqnk', qc, k_sel).astype(jnp.float32) * SCALE
        s_sel = jnp.where(sel_ok[..., None], s_sel, NEG).reshape(b, h, Q_CHUNK, n_sel * MOBA_BLOCK)
        pr = jax.nn.softmax(jnp.concatenate([s_sel, s_own], axis=-1), axis=-1).astype(v.dtype)
        p_sel = pr[..., :n_sel * MOBA_BLOCK].reshape(b, h, Q_CHUNK, n_sel, MOBA_BLOCK)
        p_own = pr[..., n_sel * MOBA_BLOCK:]
        return jnp.einsum('bhqnk,bhqnkd->bhqd', p_sel, v_sel) + jnp.einsum('bhqk,bhkd->bhqd', p_own, v_own)

    out = lax.map(chunk, jnp.arange(s // Q_CHUNK))
    return out.transpose(1, 2, 0, 3, 4).reshape(b, h, s, d)


def nsa_attention(q, k_c, v_c, k_s, v_s, k_w, v_w, gates, ck1, ck2, pe_k, cv1, cv2, pe_v):
    b, hq, s, d = q.shape
    hk = k_c.shape[1]
    g = hq // hk
    qg = q.reshape(b, hk, g, s, d)
    n_cmp = (s - CMP_LEN) // CMP_STRIDE + 1
    starts = np.arange(n_cmp) * CMP_STRIDE
    cidx = starts[:, None] + np.arange(CMP_LEN)[None, :]

    def compress(t, w1, w2, pe):
        blocks = (t[:, :, cidx] + pe).reshape(b, hk, n_cmp, CMP_LEN * d)
        return jax.nn.gelu(blocks @ w1) @ w2

    k_cmp = compress(k_c, ck1, ck2, pe_k)
    v_cmp = compress(v_c, cv1, cv2, pe_v)
    cmp_last = jnp.asarray(starts + CMP_LEN - 1)
    n_slc = s // SLC_BLOCK
    slc_starts = np.arange(n_slc) * SLC_BLOCK
    overlap = jnp.asarray(((starts[:, None] < slc_starts[None, :] + SLC_BLOCK)
                           & (starts[:, None] + CMP_LEN > slc_starts[None, :])).astype(np.float32))
    ks_blk = k_s.reshape(b, hk, n_slc, SLC_BLOCK, d)
    vs_blk = v_s.reshape(b, hk, n_slc, SLC_BLOCK, d)
    n_top = min(SLC_TOPK, n_slc)
    b_ix = jnp.arange(b)[:, None, None, None]
    k_ix = jnp.arange(hk)[None, :, None, None]
    blk_ids = jnp.arange(n_slc)

    def chunk(c):
        q0 = c * Q_CHUNK
        qc = lax.dynamic_slice_in_dim(qg, q0, Q_CHUNK, axis=3)
        qpos = q0 + jnp.arange(Q_CHUNK)
        ok = cmp_last[None, :] <= qpos[:, None]
        s_c = jnp.einsum('bkgqd,bknd->bkgqn', qc, k_cmp).astype(jnp.float32) * SCALE
        p_c = jnp.where(ok, jax.nn.softmax(jnp.where(ok, s_c, NEG), axis=-1), 0.0)
        o_cmp = jnp.einsum('bkgqn,bknd->bkgqd', p_c.astype(v_c.dtype), v_cmp)
        imp = jnp.einsum('bkgqn,nm->bkqm', p_c, overlap)
        cur = (qpos // SLC_BLOCK)[:, None]
        valid = blk_ids[None, :] <= cur
        forced = valid & ((blk_ids[None, :] == 0) | (blk_ids[None, :] > cur - SLC_LOCAL))
        imp = jnp.where(forced, FORCE, jnp.where(valid, imp, NEG))
        _, idx = lax.top_k(imp, n_top)
        k_sel = ks_blk[b_ix, k_ix, idx]
        v_sel = vs_blk[b_ix, k_ix, idx].reshape(b, hk, Q_CHUNK, n_top * SLC_BLOCK, d)
        kpos = idx[..., None] * SLC_BLOCK + jnp.arange(SLC_BLOCK)
        causal = (kpos <= qpos[:, None, None])[:, :, None]
        s_s = jnp.einsum('bkgqd,bkqnjd->bkgqnj', qc, k_sel).astype(jnp.float32) * SCALE
        s_s = jnp.where(causal, s_s, NEG).reshape(b, hk, g, Q_CHUNK, n_top * SLC_BLOCK)
        p_s = jax.nn.softmax(s_s, axis=-1).astype(v_s.dtype)
        o_slc = jnp.einsum('bkgqj,bkqjd->bkgqd', p_s, v_sel)
        return o_cmp, o_slc

    o_cmp, o_slc = lax.map(chunk, jnp.arange(s // Q_CHUNK))
    o_cmp = o_cmp.transpose(1, 2, 3, 0, 4, 5).reshape(b, hk, g, s, d)
    o_slc = o_slc.transpose(1, 2, 3, 0, 4, 5).reshape(b, hk, g, s, d)
    o_win, _ = banded_attention(qg, k_w, v_w, NSA_WINDOW - 1)
    gt = gates.reshape(b, hk, g, s, 3).astype(q.dtype)
    o = gt[..., 0:1] * o_cmp + gt[..., 1:2] * o_slc + gt[..., 2:3] * o_win
    return o.reshape(b, hq, s, d)


def dilated_attention(q, k, v):
    b, h, s, d = q.shape
    outs, lses = [], []
    for gi, (window, dil) in enumerate(DIL_CONFIGS):
        lo = gi * DIL_HEADS_PER_GROUP
        m = s // dil

        def to_sub(t):
            t = t[:, lo:lo + DIL_HEADS_PER_GROUP]
            t = t.reshape(b, DIL_HEADS_PER_GROUP, m, dil, d).transpose(0, 1, 3, 2, 4)
            return t.reshape(b, DIL_HEADS_PER_GROUP * dil, m, d)

        o, lse = banded_attention(to_sub(q)[:, :, None], to_sub(k), to_sub(v), window // dil)
        o = o[:, :, 0].reshape(b, DIL_HEADS_PER_GROUP, dil, m, d).transpose(0, 1, 3, 2, 4)
        lse = lse[:, :, 0].reshape(b, DIL_HEADS_PER_GROUP, dil, m).transpose(0, 1, 3, 2)
        outs.append(o.reshape(b, DIL_HEADS_PER_GROUP, s, d))
        lses.append(lse.reshape(b, DIL_HEADS_PER_GROUP, s))
    w = jax.nn.softmax(jnp.stack(lses), axis=0).astype(q.dtype)
    return jnp.sum(w[..., None] * jnp.stack(outs), axis=0)


def token_mixers(h, positions, w_in, ck1, ck2, pe_k, cv1, cv2, pe_v):
    b, s, _ = h.shape
    z = h @ w_in
    (qa, ka, va, qb, kbc, vbc, kbs, vbs, kbw, vbw, gb, qc, kc, vc) = jnp.split(z, SPLIT_POINTS, axis=-1)
    o_a = moba_attention(partial_rotary(split_heads(qa), positions),
                         partial_rotary(split_heads(ka), positions), split_heads(va))
    gates = jax.nn.sigmoid(gb.astype(jnp.float32)).reshape(b, s, NSA_HEADS, 3).transpose(0, 2, 1, 3)
    o_b = nsa_attention(partial_rotary(split_heads(qb), positions),
                        partial_rotary(split_heads(kbc), positions), split_heads(vbc),
                        partial_rotary(split_heads(kbs), positions), split_heads(vbs),
                        partial_rotary(split_heads(kbw), positions), split_heads(vbw),
                        gates, ck1, ck2, pe_k, cv1, cv2, pe_v)
    o_c = dilated_attention(partial_rotary(split_heads(qc), positions),
                            partial_rotary(split_heads(kc), positions), split_heads(vc))
    return jnp.concatenate([merge_heads(o_a), merge_heads(o_b), merge_heads(o_c)], axis=-1)


def grouped_moe(h, router_w, router_b, w_gate, w_up, w_down):
    b, s, dm = h.shape
    t = h.reshape(b * s, dm)
    logits = (t @ router_w).astype(jnp.float32) + router_b.astype(jnp.float32)
    probs = jax.nn.softmax(logits, axis=-1)
    grp_top = lax.top_k(probs.reshape(-1, N_GROUPS, EXPERTS_PER_GROUP), TOP_K)[0]
    g_sel = jnp.argmax(jnp.sum(grp_top, axis=-1), axis=-1)
    in_grp = (jnp.arange(N_EXPERTS) // EXPERTS_PER_GROUP)[None, :] == g_sel[:, None]
    w_top, idx = lax.top_k(jnp.where(in_grp, probs, -1.0), TOP_K)
    w_top = w_top / jnp.sum(w_top, axis=-1, keepdims=True)
    combine = jnp.sum(jax.nn.one_hot(idx, N_EXPERTS, dtype=jnp.float32) * w_top[..., None], axis=1)
    hid = jax.nn.silu(jnp.einsum('td,edf->etf', t, w_gate)) * jnp.einsum('td,edf->etf', t, w_up)
    hid = hid * combine.T[:, :, None].astype(hid.dtype)
    return jnp.einsum('etf,efd->td', hid, w_down).reshape(b, s, dm)


def setup_inputs(seed: int = 0) -> dict:
    key = jax.random.key(seed)
    ks = jax.random.split(key, 25)
    f32 = jnp.float32

    def nrm(k, shape, scale):
        return jax.random.normal(k, shape, f32) * scale

    return {
        'x': nrm(ks[0], (BATCH, SEQ, D_MODEL), 1.0),
        'p': nrm(ks[1], (DEPTH, BATCH, SEQ, PLE_DIM), 1.0),
        'positions': jnp.arange(SEQ, dtype=jnp.int32)[None, :] + jax.random.randint(ks[2], (BATCH, 1), 0, 1024, dtype=jnp.int32),
        'ln_in_g': 1.0 + nrm(ks[3], (D_MODEL,), 0.02),
        'ln_in_b': nrm(ks[4], (D_MODEL,), 0.02),
        'w_in': nrm(ks[5], (DEPTH, D_MODEL, IN_COLS), D_MODEL ** -0.5),
        'w_out': nrm(ks[6], (DEPTH, MIX_OUT, D_MODEL), MIX_OUT ** -0.5 * DEEPNORM_BETA),
        'nsa_ck1': nrm(ks[7], (DEPTH, CMP_LEN * HEAD_DIM, CMP_HIDDEN), (CMP_LEN * HEAD_DIM) ** -0.5),
        'nsa_ck2': nrm(ks[8], (DEPTH, CMP_HIDDEN, HEAD_DIM), CMP_HIDDEN ** -0.5),
        'nsa_pe_k': nrm(ks[9], (DEPTH, CMP_LEN, HEAD_DIM), 0.1),
        'nsa_cv1': nrm(ks[10], (DEPTH, CMP_LEN * HEAD_DIM, CMP_HIDDEN), (CMP_LEN * HEAD_DIM) ** -0.5),
        'nsa_cv2': nrm(ks[11], (DEPTH, CMP_HIDDEN, HEAD_DIM), CMP_HIDDEN ** -0.5),
        'nsa_pe_v': nrm(ks[12], (DEPTH, CMP_LEN, HEAD_DIM), 0.1),
        'ln1_g': 1.0 + nrm(ks[13], (DEPTH, D_MODEL), 0.02),
        'ln1_b': nrm(ks[14], (DEPTH, D_MODEL), 0.02),
        'router_w': nrm(ks[15], (D_MODEL, N_EXPERTS), D_MODEL ** -0.5),
        'router_b': nrm(ks[16], (N_EXPERTS,), 0.01),
        'w_gate': nrm(ks[17], (DEPTH, N_EXPERTS, D_MODEL, EXPERT_HIDDEN), D_MODEL ** -0.5),
        'w_up': nrm(ks[18], (DEPTH, N_EXPERTS, D_MODEL, EXPERT_HIDDEN), D_MODEL ** -0.5),
        'w_down': nrm(ks[19], (DEPTH, N_EXPERTS, EXPERT_HIDDEN, D_MODEL), EXPERT_HIDDEN ** -0.5 * DEEPNORM_BETA),
        'ple_proj': nrm(ks[20], (DEPTH, PLE_DIM, D_MODEL), PLE_DIM ** -0.5 * DEEPNORM_BETA),
        'ple_gate_w': nrm(ks[21], (DEPTH, D_MODEL, D_MODEL), D_MODEL ** -0.5),
        'ple_gate_b': nrm(ks[22], (DEPTH, D_MODEL), 0.02),
        'ln2_g': 1.0 + nrm(ks[23], (DEPTH, D_MODEL), 0.02),
        'ln2_b': nrm(ks[24], (DEPTH, D_MODEL), 0.02),
    }


def reference(x, p, positions, ln_in_g, ln_in_b, w_in, w_out, nsa_ck1, nsa_ck2, nsa_pe_k,
              nsa_cv1, nsa_cv2, nsa_pe_v, ln1_g, ln1_b, router_w, router_b, w_gate, w_up, w_down,
              ple_proj, ple_gate_w, ple_gate_b, ln2_g, ln2_b):
    h = layer_norm(x, ln_in_g, ln_in_b)
    for i in range(DEPTH):
        mixed = token_mixers(h, positions, w_in[i], nsa_ck1[i], nsa_ck2[i], nsa_pe_k[i],
                             nsa_cv1[i], nsa_cv2[i], nsa_pe_v[i])
        h = layer_norm(DEEPNORM_ALPHA * h + mixed @ w_out[i], ln1_g[i], ln1_b[i])
        ffn = grouped_moe(h, router_w, router_b, w_gate[i], w_up[i], w_down[i])
        ple = jax.nn.sigmoid(h @ ple_gate_w[i] + ple_gate_b[i]) * (p[i] @ ple_proj[i])
        h = layer_norm(DEEPNORM_ALPHA * h + ffn + ple, ln2_g[i], ln2_b[i])
    return h
```

```cpp
#include <hip/hip_runtime.h>
#include <cstdio>
#include <cstdint>

#ifndef MK_SINGLE
#define MK_SINGLE 0
#endif

namespace pg8 {
#define PG8_LAS __attribute__((address_space(3)))
typedef unsigned short bf16_t;
typedef short bf16x8 __attribute__((ext_vector_type(8)));
typedef float f32x4 __attribute__((ext_vector_type(4)));
typedef unsigned u32x4 __attribute__((ext_vector_type(4)));
constexpr int BM = 256, BK = 64, HALF = 128, HTB = HALF * BK * 2, STAGE_BYTES = 8 * HTB, NXCD = 8, WGM = 8;

__host__ __device__ __forceinline__ int lds_byte(int r, int c) { const int st = (r >> 4) * 2 + (c >> 5), rr = r & 15, cc = c & 31, ob = rr * 64 + cc * 2; return st * 1024 + (ob ^ (((ob >> 9) & 1) << 5)); }
__host__ __device__ __forceinline__ void stage_rc(int b, int& R, int& C) { const int st = b / 1024, sb = b % 1024, swz = sb ^ (((sb >> 9) & 1) << 5); R = (st >> 1) * 16 + swz / 64; C = (st & 1) * 32 + (swz % 64) / 2; }
__host__ __device__ __forceinline__ int perm32(int rho) { const int n = rho >> 4, i = rho & 15; return 8 * (i >> 2) + 4 * n + (i & 3); }

struct Unit { const char* A; const char* B; const char* B2; int pm, pn, aux; };

struct StaticOrder {
    int nM, nN, nwg, G, c;
    __device__ void init(int M, int N, int G_, int c_) { nM = M / BM; nN = N / BM; nwg = nM * nN; G = G_; c = c_; }
    __device__ bool next(int i, int& pm, int& pn) const {
        const long L = (long)i * G + c; if (L >= nwg) return false;
        int wgid = (int)L; { const int q = nwg / NXCD, r = nwg % NXCD, xcd = wgid % NXCD, off = wgid / NXCD; wgid = (xcd < r ? xcd * (q + 1) : r * (q + 1) + (xcd - r) * q) + off; }
        const int nig = WGM * nN, gid = wgid / nig, fm = gid * WGM, gsz = (nM - fm) < WGM ? (nM - fm) : WGM;
        pm = fm + ((wgid % nig) % gsz); pn = (wgid % nig) / gsz; return true;
    }
};
struct SchedDense {
    const char* A; const char* Bt; size_t tA, tB; StaticOrder so;
    __device__ __forceinline__ bool next(int i, Unit& u) const { int pm, pn; if (!so.next(i, pm, pn)) return false; u.pm = pm; u.pn = pn; u.aux = 0; u.A = A + (size_t)pm * tA; u.B = Bt + (size_t)pn * tB; u.B2 = u.B; return true; }
};

__device__ __forceinline__ unsigned cvt_pk_bf16(float lo, float hi) { unsigned r; asm volatile("v_cvt_pk_bf16_f32 %0, %1, %2" : "=v"(r) : "v"(lo), "v"(hi)); return r; }

template <class Epi, class Sched, bool ALIGN_EPI>
__device__ __forceinline__ void gemm_phase(PG8_LAS unsigned char* lds, const int tid_in, const int lda, const int ldb, const int nt, const int ksplit, const Sched& S, const Epi& E) {
    int tid_ = tid_in; asm volatile("" : "+v"(tid_));
    const int tid = tid_, wid = __builtin_amdgcn_readfirstlane(tid >> 6), lane = tid & 63, wr = wid >> 2, wc = wid & 3, fr = lane & 15, fq = lane >> 4;
    unsigned voffA[2], voffB[2];
#pragma unroll
    for (int i = 0; i < 2; ++i) { int R, C; stage_rc(tid * 16 + i * 8192, R, C); const int Rb = Epi::PERM ? ((R & ~31) + perm32(R & 31)) : R;
        voffA[i] = (unsigned)(R * lda + C) * 2u; voffB[i] = (unsigned)(Rb * ldb + C) * 2u; }
    const size_t kstep = (size_t)(BK * 2);
    const size_t hA = (size_t)HALF * lda * 2, hB = (size_t)HALF * ldb * 2;
    const unsigned ldsw = (unsigned)wid * 1024u;
    const int aoff = lds_byte(wr * 64 + fr, fq * 8), boff = lds_byte(wc * 32 + fr, fq * 8);
#define PG8_SA(b, h) (((b) * 2 + (h)) * HTB)
#define PG8_SB(b, h) ((4 + (b) * 2 + (h)) * HTB)
#define PG8_STAGE(bufoff, gbase, voff) do { _Pragma("unroll") for (int _i = 0; _i < 2; ++_i) \
        __builtin_amdgcn_global_load_lds((const unsigned*)((const char*)(gbase) + (voff)[_i]), (PG8_LAS unsigned*)(lds + (bufoff) + ldsw + _i * 8192), 16, 0, 0); } while (0)
#define PG8_LDA(dst, b, h) do { _Pragma("unroll") for (int m = 0; m < 4; ++m) _Pragma("unroll") for (int k = 0; k < 2; ++k) dst[m][k] = *(const PG8_LAS bf16x8*)(lds + PG8_SA(b, h) + aoff + m * 2048 + k * 1024); } while (0)
#define PG8_LDB(dst, b, h) do { _Pragma("unroll") for (int n = 0; n < 2; ++n) _Pragma("unroll") for (int k = 0; k < 2; ++k) dst[n][k] = *(const PG8_LAS bf16x8*)(lds + PG8_SB(b, h) + boff + n * 2048 + k * 1024); } while (0)
#define PG8_MMA(ai, bj, At, Bt) do { __builtin_amdgcn_s_setprio(1); _Pragma("unroll") for (int m = 0; m < 4; ++m) _Pragma("unroll") for (int n = 0; n < 2; ++n) _Pragma("unroll") for (int k = 0; k < 2; ++k) \
        acc[ai][bj][m][n] = __builtin_amdgcn_mfma_f32_16x16x32_bf16(Bt[n][k], At[m][k], acc[ai][bj][m][n], 0, 0, 0); __builtin_amdgcn_s_setprio(0); } while (0)
#define PG8_WAIT_V(n) asm volatile("s_waitcnt vmcnt(" #n ")" ::: "memory")
#define PG8_WAIT_L(n) asm volatile("s_waitcnt lgkmcnt(" #n ")" ::: "memory")
#define PG8_BAR __builtin_amdgcn_s_barrier()
#define PG8_SCHED __builtin_amdgcn_sched_barrier(0)
    Unit cur, nxt; int ui = 0;
    if (!S.next(0, cur)) return;
    f32x4 acc[2][2][4][2];
#pragma unroll
    for (int a = 0; a < 2; ++a)
#pragma unroll
        for (int b = 0; b < 2; ++b)
#pragma unroll
            for (int m = 0; m < 4; ++m)
#pragma unroll
                for (int n = 0; n < 2; ++n) acc[a][b][m][n] = (f32x4){0.f, 0.f, 0.f, 0.f};
    bf16x8 At[4][2], B0[2][2], B1[2][2];
    const char* cA = cur.A; const char* cB = cur.B; const char* cB2 = cur.B2;
    PG8_STAGE(PG8_SB(0, 0), cB, voffB); PG8_STAGE(PG8_SB(0, 1), cB + hB, voffB); PG8_STAGE(PG8_SA(0, 0), cA, voffA); PG8_STAGE(PG8_SA(0, 1), cA + hA, voffA);
    if (wr == 1) PG8_BAR;
    PG8_WAIT_V(2); PG8_BAR;
    PG8_STAGE(PG8_SB(1, 0), cB + kstep, voffB); PG8_STAGE(PG8_SA(1, 0), cA + kstep, voffA); PG8_STAGE(PG8_SB(1, 1), cB + hB + kstep, voffB);
    PG8_WAIT_V(6); PG8_BAR;
    for (;;) {
        const bool has_next = S.next(ui + 1, nxt);
        const char* nA = has_next ? nxt.A : cA; const char* nB = has_next ? nxt.B : cB;
        for (int t = 0; t < nt; t += 2) {
            const bool last = (t == nt - 2);
            const int t2 = t + 2;
            const char* a1 = cA + (size_t)(t + 1) * kstep;
            const char* a2 = last ? nA : cA + (size_t)t2 * kstep;
            const char* b2 = last ? nB : (t2 < ksplit ? cB + (size_t)t2 * kstep : cB2 + (size_t)(t2 - ksplit) * kstep);
            const char* a3 = a2 + kstep; const char* b3 = b2 + kstep;
            PG8_LDB(B0, 0, 0); PG8_LDB(B1, 0, 1); PG8_SCHED; PG8_LDA(At, 0, 0); PG8_STAGE(PG8_SA(1, 1), a1 + hA, voffA);
            PG8_WAIT_V(8); PG8_WAIT_L(0); PG8_BAR; PG8_MMA(0, 0, At, B0); PG8_MMA(0, 1, At, B1); PG8_BAR; PG8_SCHED;
            PG8_LDA(At, 0, 1); PG8_STAGE(PG8_SB(0, 0), b2, voffB); PG8_STAGE(PG8_SB(0, 1), b2 + hB, voffB); PG8_STAGE(PG8_SA(0, 0), a2, voffA);
            PG8_WAIT_V(8); PG8_WAIT_L(0); PG8_BAR; PG8_MMA(1, 0, At, B0); PG8_MMA(1, 1, At, B1); PG8_BAR; PG8_SCHED;
            PG8_LDB(B0, 1, 0); PG8_LDB(B1, 1, 1); PG8_SCHED; PG8_LDA(At, 1, 0); PG8_STAGE(PG8_SA(0, 1), a2 + hA, voffA);
            PG8_WAIT_V(8); PG8_WAIT_L(0); PG8_BAR; PG8_MMA(0, 0, At, B0); PG8_MMA(0, 1, At, B1); PG8_BAR; PG8_SCHED;
            PG8_LDA(At, 1, 1); PG8_STAGE(PG8_SB(1, 0), b3, voffB); PG8_STAGE(PG8_SB(1, 1), b3 + hB, voffB); PG8_STAGE(PG8_SA(1, 0), a3, voffA);
            PG8_WAIT_V(8); PG8_WAIT_L(0); PG8_BAR; PG8_MMA(1, 0, At, B0); PG8_MMA(1, 1, At, B1); PG8_BAR; PG8_SCHED;
        }
        if constexpr (ALIGN_EPI) { if (wr == 0) PG8_BAR; }
        E(acc, cur, wr, wc, fr, fq);
        if (!has_next) break;
#pragma unroll
        for (int a = 0; a < 2; ++a)
#pragma unroll
            for (int b = 0; b < 2; ++b)
#pragma unroll
                for (int m = 0; m < 4; ++m)
#pragma unroll
                    for (int n = 0; n < 2; ++n) acc[a][b][m][n] = (f32x4){0.f, 0.f, 0.f, 0.f};
        cur = nxt; cA = nA; cB = nB; cB2 = nxt.B2; ++ui;
        if constexpr (ALIGN_EPI) { if (wr == 1) PG8_BAR; }
    }
    PG8_WAIT_V(0);
    if constexpr (!ALIGN_EPI) { if (wr == 0) PG8_BAR; }
    PG8_BAR;
#undef PG8_SA
#undef PG8_SB
#undef PG8_STAGE
#undef PG8_LDA
#undef PG8_LDB
#undef PG8_MMA
#undef PG8_WAIT_V
#undef PG8_WAIT_L
#undef PG8_BAR
#undef PG8_SCHED
}
}

constexpr int BATCH = 2, SEQ = 4096, T = BATCH * SEQ, D = 2048, DEPTH = 4;
constexpr int ZP = 5888;
constexpr int MIXW = 1536;
constexpr int NEXP = 16, EH = 512, PLE = 256;
constexpr float LN_EPS = 1e-5f;
constexpr float ALPHA = 1.681792830507429f;
constexpr float SC2 = 0.125f * 1.4426950408889634f;
constexpr int QA = 0, KA = 512, VA = 1024, QB = 1536, KBC = 2304, VBC = 2496, KBS = 2688, VBS = 2880, KBW = 3072, VBW = 3264, QC = 3456, KC = 4224, VC = 4992, GB = 5760;
constexpr int MAXTILES = 56, TPAD = MAXTILES * 256;

constexpr size_t MiB = 1u << 20;
constexpr size_t WS_CTL = 0, CTL_ZERO_BYTES = 1 * MiB;
constexpr size_t WS_CS = 1 * MiB;
constexpr size_t WS_KMEAN = 2 * MiB;
constexpr size_t WS_KCMP = 3 * MiB;
constexpr size_t WS_VCMP = 4 * MiB;
constexpr size_t WS_TOKC = 5 * MiB;
constexpr size_t WS_TOKS = 5 * MiB + 64 * 1024;
constexpr size_t WS_TOKW = 5 * MiB + 128 * 1024;
constexpr size_t WS_PTOK = 6 * MiB;
constexpr size_t WS_PW = 6 * MiB + 128 * 1024;
constexpr size_t WS_W = 16 * MiB;
constexpr size_t LW_IN = 0, LW_OUT = LW_IN + (size_t)ZP * D * 2, LW_GU = LW_OUT + (size_t)D * MIXW * 2, LW_D = LW_GU + (size_t)NEXP * 1024 * D * 2,
                 LW_PG = LW_D + (size_t)NEXP * D * EH * 2, LW_PP = LW_PG + (size_t)D * D * 2, LW_END = LW_PP + (size_t)D * PLE * 2;
constexpr size_t LW_STRIDE = 135 * MiB;
static_assert(LW_END <= LW_STRIDE, "layer weights");
constexpr size_t WS_H32 = 556 * MiB, WS_HB = 620 * MiB, WS_Z = 652 * MiB, WS_Y = 744 * MiB, WS_MIX = 808 * MiB, WS_XP = 832 * MiB, WS_HID = 888 * MiB,
                 WS_PPLE = 916 * MiB, WS_PB = 980 * MiB, WS_END = 996 * MiB;
static_assert(WS_W + 4 * LW_STRIDE <= WS_H32 && WS_Z + (size_t)T * ZP * 2 <= WS_Y && WS_XP + (size_t)TPAD * D * 2 <= WS_HID && WS_HID + (size_t)TPAD * 1024 * 2 <= WS_PPLE, "ws map");
constexpr int CW_BAR = 4096;
constexpr int CW_CNT = 16384;

constexpr int RING_BYTES = 131072, LDSCTL_OFF = RING_BYTES, MISC_OFF = LDSCTL_OFF + 320, TILE_OFF = LDSCTL_OFF + 1024;
constexpr int LDS_BYTES = 147456;

#define GAS __attribute__((address_space(1)))
#define LAS __attribute__((address_space(3)))
typedef unsigned short bf16;
typedef unsigned v4u __attribute__((ext_vector_type(4)));
typedef float f32x4 __attribute__((ext_vector_type(4)));
#define LDS_WAIT() asm volatile("s_waitcnt lgkmcnt(0)" ::: "memory")
__device__ __forceinline__ unsigned f2bf(float f) { unsigned u = __builtin_bit_cast(unsigned, f); return (u + 0x7fffu + ((u >> 16) & 1u)) >> 16; }
__device__ __forceinline__ unsigned pk2(float lo, float hi) { return f2bf(lo) | (f2bf(hi) << 16); }
__device__ __forceinline__ float bf_lo(unsigned u) { return __builtin_bit_cast(float, u << 16); }
__device__ __forceinline__ float bf_hi(unsigned u) { return __builtin_bit_cast(float, u & 0xffff0000u); }
__device__ __forceinline__ float bf1(bf16 u) { return __builtin_bit_cast(float, ((unsigned)u) << 16); }
__device__ __forceinline__ float ex2(float x) { return __builtin_amdgcn_exp2f(x); }

#define XB_TMO      128
#define XB_XCNT(j)  (256  + 64 * (j))
#define XB_XSUB(j)  (1280 + 64 * (j))
#define XB_XGEN(j)  (2304 + 64 * (j))
#define XB_TOP      3328
#define XB_TOPGEN   3392
#define XCD_BAR_WORDS 3456
#define XB_SPIN_CAP (1u << 18)
__device__ __forceinline__ unsigned xb_ld(unsigned* p)              { return __hip_atomic_load(p, __ATOMIC_RELAXED, __HIP_MEMORY_SCOPE_AGENT); }
__device__ __forceinline__ unsigned xb_add(unsigned* p, unsigned v) { return __hip_atomic_fetch_add(p, v, __ATOMIC_RELAXED, __HIP_MEMORY_SCOPE_AGENT); }
__device__ __forceinline__ unsigned xb_xcc_id() { return (unsigned)__builtin_amdgcn_s_getreg((3 << 11) | 20) & 0xFu; }
#define XB_SPIN(cond, bar) do { unsigned _sp = 0; while (cond) { __builtin_amdgcn_s_sleep(1); \
    if ((++_sp & 255u) == 0u) { if (xb_ld(&(bar)[XB_TMO])) break; if (_sp > XB_SPIN_CAP) { atomicAdd(&(bar)[XB_TMO], 1u); break; } } } } while (0)
struct XcdBarrier { unsigned* bar; unsigned x; volatile LAS unsigned* st; };
__device__ __forceinline__ XcdBarrier xcd_barrier_post(unsigned* bar, volatile LAS unsigned* st) {
    XcdBarrier b; b.bar = bar; b.x = xb_xcc_id(); b.st = st;
    if (threadIdx.x == 0) (void)xb_add(&bar[XB_XCNT(b.x)], 1u);
    return b;
}
__device__ __forceinline__ void xcd_barrier_complete(unsigned* bar, unsigned x, unsigned& nloc, unsigned& nx) {
    const unsigned G = gridDim.x * gridDim.y * gridDim.z;
    unsigned sum, cnt, mine, sp = 0u;
    for (;;) {
        sum = 0u; cnt = 0u; mine = 0u;
#pragma unroll
        for (unsigned j = 0; j < 16; ++j) { const unsigned c = xb_ld(&bar[XB_XCNT(j)]); sum += c; cnt += (c > 0u) ? 1u : 0u; mine = (j == x) ? c : mine; }
        if (sum == G) break;
        __builtin_amdgcn_s_sleep(1);
        if ((++sp & 255u) == 0u) { if (xb_ld(&bar[XB_TMO])) break; if (sp > XB_SPIN_CAP) { atomicAdd(&bar[XB_TMO], 1u); break; } }
    }
    nloc = mine > 0u ? mine : 1u; nx = cnt > 0u ? cnt : 1u;
}
__device__ __forceinline__ void xcd_barrier(const XcdBarrier& b, const int tid) {
    asm volatile("s_waitcnt vmcnt(0)" ::: "memory");
    __syncthreads();
    if (tid == 0) {
        unsigned* bar = b.bar;
        __builtin_amdgcn_s_waitcnt(0);
        unsigned nloc = b.st[0], nx = b.st[1];
        if (nloc == 0u) { xcd_barrier_complete(bar, b.x, nloc, nx); b.st[0] = nloc; b.st[1] = nx; }
        const unsigned old = xb_add(&bar[XB_XSUB(b.x)], 1u);
        const unsigned gen = old / nloc;
        if (old + 1u == (gen + 1u) * nloc) {
            __builtin_amdgcn_fence(__ATOMIC_RELEASE, "agent");
            asm volatile("s_waitcnt vmcnt(0)" ::: "memory");
            const unsigned og = xb_add(&bar[XB_TOP], 1u);
            const unsigned tg = og / nx;
            if (og + 1u == (tg + 1u) * nx) xb_add(&bar[XB_TOPGEN], 1u);
            else XB_SPIN(xb_ld(&bar[XB_TOPGEN]) == tg, bar);
            __builtin_amdgcn_fence(__ATOMIC_ACQUIRE, "agent");
            xb_add(&bar[XB_XGEN(b.x)], 1u);
            asm volatile("s_waitcnt vmcnt(0)" ::: "memory");
        } else {
            XB_SPIN(xb_ld(&bar[XB_XGEN(b.x)]) == gen, bar);
            __builtin_amdgcn_fence(__ATOMIC_ACQUIRE, "agent");
            asm volatile("s_waitcnt vmcnt(0)" ::: "memory");
        }
    }
    __syncthreads();
}

struct Args { const float* in[25]; float* out; unsigned char* ws; int ph_lo, ph_hi; };
enum { I_X = 0, I_P, I_POS, I_LNG, I_LNB, I_WIN, I_WOUT, I_CK1, I_CK2, I_PEK, I_CV1, I_CV2, I_PEV, I_LN1G, I_LN1B, I_RW, I_RB, I_WG, I_WU, I_WD, I_PP, I_PGW, I_PGB, I_LN2G, I_LN2B };

struct Frame {
    LAS unsigned char* lds;
    int tid, lane, wave, G, bx, gw, ngw;
    unsigned char* ws;
};

__device__ __forceinline__ float wave_sum(float v) {
#pragma unroll
    for (int o = 1; o < 64; o <<= 1) v += __shfl_xor(v, o);
    return v;
}
__device__ __forceinline__ float wave_max(float v) {
#pragma unroll
    for (int o = 1; o < 64; o <<= 1) v = fmaxf(v, __shfl_xor(v, o));
    return v;
}
template <int OFF> __device__ __forceinline__ void rs_step(float (&v)[64], int lane) {
    const bool up = (lane & OFF) != 0;
#pragma unroll
    for (int i = 0; i < OFF; ++i) { const float send = up ? v[i] : v[i + OFF]; const float keep = up ? v[i + OFF] : v[i]; v[i] = keep + __shfl_xor(send, OFF); }
}
__device__ __forceinline__ void reduce_scatter64(float (&v)[64], int lane) { rs_step<32>(v, lane); rs_step<16>(v, lane); rs_step<8>(v, lane); rs_step<4>(v, lane); rs_step<2>(v, lane); rs_step<1>(v, lane); }

template <int MAP>
__device__ __forceinline__ int rowmap(int n) {
    if (MAP == 1) return n < 3456 ? n : (n < 3492 ? n - 3456 + GB : n - 36);
    if (MAP == 2) return ((n >> 7) << 8) + (n & 127);
    if (MAP == 3) return ((n >> 7) << 8) + 128 + (n & 127);
    return n;
}
template <int MAP>
__device__ __forceinline__ void transpose_item(const float* W, int K, int N, bf16* WT, LAS float* scr, int item, int lane) {
    const int nblk = (N + 31) / 32, kb = item / nblk, nb = item % nblk, k0 = 64 * kb, n0 = 32 * nb;
    const int nn = n0 + (lane & 31); const bool okn = nn < N;
#pragma unroll 8
    for (int i = 0; i < 32; ++i) { const int kk = 2 * i + (lane >> 5); scr[kk * 33 + (lane & 31)] = okn ? W[(size_t)(k0 + kk) * N + nn] : 0.f; }
    LDS_WAIT(); asm volatile("" ::: "memory");
    const int c = lane & 7;
#pragma unroll
    for (int j = 0; j < 4; ++j) { const int n = (lane >> 3) + 8 * j; const LAS float* s = scr + (8 * c) * 33 + n;
        v4u o; o.x = pk2(s[0 * 33], s[1 * 33]); o.y = pk2(s[2 * 33], s[3 * 33]); o.z = pk2(s[4 * 33], s[5 * 33]); o.w = pk2(s[6 * 33], s[7 * 33]);
        if (n0 + n < N) *(v4u*)(WT + (size_t)rowmap<MAP>(n0 + n) * K + k0 + 8 * c) = o; }
    LDS_WAIT(); asm volatile("" ::: "memory");
}

__device__ __forceinline__ void ln_row(const float* src, const float* g, const float* b, float* dst32, bf16* dstb, int lane, f32x4 (&o)[8]) {
    const f32x4* xr = (const f32x4*)src + lane;
    f32x4 v[8]; float s = 0.f;
#pragma unroll
    for (int j = 0; j < 8; ++j) { v[j] = xr[64 * j]; s += (v[j].x + v[j].y) + (v[j].z + v[j].w); }
    const float mean = wave_sum(s) * (1.f / D); float s2 = 0.f;
#pragma unroll
    for (int j = 0; j < 8; ++j) { v[j] = v[j] - mean; s2 += (v[j].x * v[j].x + v[j].y * v[j].y) + (v[j].z * v[j].z + v[j].w * v[j].w); }
    const float rstd = 1.f / sqrtf(wave_sum(s2) * (1.f / D) + LN_EPS);
#pragma unroll
    for (int j = 0; j < 8; ++j) { const f32x4 gg = ((const f32x4*)g)[64 * j + lane], bb = ((const f32x4*)b)[64 * j + lane]; o[j] = v[j] * rstd * gg + bb; }
    if (dst32) {
#pragma unroll
        for (int j = 0; j < 8; ++j) ((f32x4*)dst32)[64 * j + lane] = o[j];
    }
    if (dstb) {
#pragma unroll
        for (int j = 0; j < 8; ++j) ((unsigned long long*)dstb)[64 * j + lane] = (unsigned long long)pk2(o[j].x, o[j].y) | ((unsigned long long)pk2(o[j].z, o[j].w) << 32);
    }
}

__device__ __forceinline__ void phase_prologue(Frame& F, const Args& a) {
    LAS float* scr = (LAS float*)(F.lds + F.wave * 16384);
    constexpr int N_IN = 32 * 182, N_OUT = 24 * 64, N_G1 = 32 * 16, N_D1 = 8 * 64, N_PG = 32 * 64, N_PP = 4 * 64;
    constexpr int PER_LAYER = N_IN + N_OUT + 16 * N_G1 * 2 + 16 * N_D1 + N_PG + N_PP;
    for (int it = F.gw; it < DEPTH * PER_LAYER; it += F.ngw) {
        const int L = it / PER_LAYER; int r = it % PER_LAYER;
        unsigned char* wl = F.ws + WS_W + (size_t)L * LW_STRIDE;
        if (r < N_IN) { transpose_item<1>(a.in[I_WIN] + (size_t)L * D * 5796, D, 5796, (bf16*)(wl + LW_IN), scr, r, F.lane); continue; } r -= N_IN;
        if (r < N_OUT) { transpose_item<0>(a.in[I_WOUT] + (size_t)L * MIXW * D, MIXW, D, (bf16*)(wl + LW_OUT), scr, r, F.lane); continue; } r -= N_OUT;
        if (r < 16 * N_G1) { const int e = r / N_G1; transpose_item<2>(a.in[I_WG] + ((size_t)L * NEXP + e) * D * EH, D, EH, (bf16*)(wl + LW_GU) + (size_t)e * 1024 * D, scr, r % N_G1, F.lane); continue; } r -= 16 * N_G1;
        if (r < 16 * N_G1) { const int e = r / N_G1; transpose_item<3>(a.in[I_WU] + ((size_t)L * NEXP + e) * D * EH, D, EH, (bf16*)(wl + LW_GU) + (size_t)e * 1024 * D, scr, r % N_G1, F.lane); continue; } r -= 16 * N_G1;
        if (r < 16 * N_D1) { const int e = r / N_D1; transpose_item<0>(a.in[I_WD] + ((size_t)L * NEXP + e) * EH * D, EH, D, (bf16*)(wl + LW_D) + (size_t)e * D * EH, scr, r % N_D1, F.lane); continue; } r -= 16 * N_D1;
        if (r < N_PG) { transpose_item<0>(a.in[I_PGW] + (size_t)L * D * D, D, D, (bf16*)(wl + LW_PG), scr, r, F.lane); continue; } r -= N_PG;
        transpose_item<0>(a.in[I_PP] + (size_t)L * PLE * D, PLE, D, (bf16*)(wl + LW_PP), scr, r, F.lane);
    }
    for (int i = F.gw * 64 + F.lane; i < DEPTH * 92 * (D / 8); i += F.ngw * 64) {
        const int L = i / (92 * (D / 8)), r = i % (92 * (D / 8));
        ((v4u*)(F.ws + WS_W + (size_t)L * LW_STRIDE + LW_IN + (size_t)5796 * D * 2))[r] = (v4u){0u, 0u, 0u, 0u};
    }
    { const f32x4* p4 = (const f32x4*)a.in[I_P]; unsigned long long* pb = (unsigned long long*)(F.ws + WS_PB);
      for (size_t i = (size_t)F.gw * 64 + F.lane; i < (size_t)DEPTH * T * PLE / 4; i += (size_t)F.ngw * 64) { const f32x4 v = p4[i]; pb[i] = (unsigned long long)pk2(v.x, v.y) | ((unsigned long long)pk2(v.z, v.w) << 32); } }
    { float* cs = (float*)(F.ws + WS_CS); const int* pos = (const int*)a.in[I_POS];
      for (int i = F.gw * 64 + F.lane; i < T * 8; i += F.ngw * 64) { const int t = i >> 3, j = i & 7;
          const float inv = expf((float)j * -1.6402954339981079f);
          const float ang = (float)pos[t] * inv;
          const double rev = (double)ang * 0.15915494309189535; const float fr = (float)(rev - floor(rev));
          cs[t * 16 + j] = __builtin_amdgcn_cosf(fr); cs[t * 16 + 8 + j] = __builtin_amdgcn_sinf(fr); } }
    for (int m = F.gw; m < T; m += F.ngw) { f32x4 o[8]; ln_row(a.in[I_X] + (size_t)m * D, a.in[I_LNG], a.in[I_LNB], (float*)(F.ws + WS_H32) + (size_t)m * D, (bf16*)(F.ws + WS_HB) + (size_t)m * D, F.lane, o); }
}

__device__ __forceinline__ bool rope_head(int hd) {
    const unsigned long long lo = 0xFFFFull | (0x7FFFull << 24) | (0x7ull << 42) | (0x7ull << 48) | (0x3FFull << 54), hi = 0x3FFFull;
    return hd < 64 ? ((lo >> hd) & 1ull) != 0ull : ((hi >> (hd - 64)) & 1ull) != 0ull;
}
struct EpiZ {
    static constexpr bool PERM = true;
    bf16* Z; const float* cs;
    __device__ __forceinline__ void operator()(const f32x4 (&acc)[2][2][4][2], const pg8::Unit& u, int wr, int wc, int fr, int fq) const {
        const int row0 = u.pm * 256 + wr * 64 + fr;
#pragma unroll
        for (int bj = 0; bj < 2; ++bj) {
            const int cb = u.pn * 256 + bj * 128 + wc * 32;
            const bool rp = ((wc & 1) == 0) && rope_head(cb >> 6);
#pragma unroll
            for (int ai = 0; ai < 2; ++ai)
#pragma unroll
                for (int m = 0; m < 4; ++m) {
                    const int row = row0 + ai * 128 + m * 16;
                    f32x4 v0 = acc[ai][bj][m][0], v1 = acc[ai][bj][m][1];
                    if (rp) {
                        f32x4 o0, o1;
#pragma unroll
                        for (int i = 0; i < 4; ++i) { o0[i] = __shfl_xor(v0[i], 16); o1[i] = __shfl_xor(v1[i], 16); }
                        const f32x4 c0 = *(const f32x4*)(cs + (size_t)row * 16), c1 = *(const f32x4*)(cs + (size_t)row * 16 + 4), s0 = *(const f32x4*)(cs + (size_t)row * 16 + 8), s1 = *(const f32x4*)(cs + (size_t)row * 16 + 12);
                        if (fq == 0) { v0 = v0 * c0 - o0 * s0; v1 = v1 * c1 - o1 * s1; }
                        else if (fq == 1) { v0 = v0 * c0 + o0 * s0; v1 = v1 * c1 + o1 * s1; }
                    }
                    v4u w; w.x = pg8::cvt_pk_bf16(v0[0], v0[1]); w.y = pg8::cvt_pk_bf16(v0[2], v0[3]); w.z = pg8::cvt_pk_bf16(v1[0], v1[1]); w.w = pg8::cvt_pk_bf16(v1[2], v1[3]);
                    *(v4u*)(Z + (size_t)row * ZP + cb + 8 * fq) = w;
                }
        }
    }
};
struct EpiRes {
    static constexpr bool PERM = false;
    const float* h; float* y;
    __device__ __forceinline__ void operator()(const f32x4 (&acc)[2][2][4][2], const pg8::Unit& u, int wr, int wc, int fr, int fq) const {
        const int row0 = u.pm * 256 + wr * 64 + fr, col0 = u.pn * 256 + wc * 32 + 4 * fq;
#pragma unroll
        for (int ai = 0; ai < 2; ++ai)
#pragma unroll
            for (int m = 0; m < 4; ++m) { const size_t off = (size_t)(row0 + ai * 128 + m * 16) * D + col0;
#pragma unroll
                for (int bj = 0; bj < 2; ++bj)
#pragma unroll
                    for (int n = 0; n < 2; ++n) { const size_t o = off + bj * 128 + n * 16; *(f32x4*)(y + o) = *(const f32x4*)(h + o) * ALPHA + acc[ai][bj][m][n]; } }
    }
};
struct EpiF32 {
    static constexpr bool PERM = false;
    float* C;
    __device__ __forceinline__ void operator()(const f32x4 (&acc)[2][2][4][2], const pg8::Unit& u, int wr, int wc, int fr, int fq) const {
        const int row0 = u.pm * 256 + wr * 64 + fr, col0 = u.pn * 256 + wc * 32 + 4 * fq;
#pragma unroll
        for (int ai = 0; ai < 2; ++ai)
#pragma unroll
            for (int m = 0; m < 4; ++m) { const size_t off = (size_t)(row0 + ai * 128 + m * 16) * D + col0;
#pragma unroll
                for (int bj = 0; bj < 2; ++bj)
#pragma unroll
                    for (int n = 0; n < 2; ++n) *(f32x4*)(C + off + bj * 128 + n * 16) = acc[ai][bj][m][n]; }
    }
};
struct EpiPle {
    static constexpr bool PERM = false;
    const float* h; const float* P; const float* bias; float* y2;
    __device__ __forceinline__ void operator()(const f32x4 (&acc)[2][2][4][2], const pg8::Unit& u, int wr, int wc, int fr, int fq) const {
        const int row0 = u.pm * 256 + wr * 64 + fr, col0 = u.pn * 256 + wc * 32 + 4 * fq;
#pragma unroll
        for (int bj = 0; bj < 2; ++bj)
#pragma unroll
            for (int n = 0; n < 2; ++n) { const f32x4 bv = *(const f32x4*)(bias + col0 + bj * 128 + n * 16);
#pragma unroll
                for (int ai = 0; ai < 2; ++ai)
#pragma unroll
                    for (int m = 0; m < 4; ++m) { const size_t o = (size_t)(row0 + ai * 128 + m * 16) * D + col0 + bj * 128 + n * 16;
                        const f32x4 x = acc[ai][bj][m][n] + bv; f32x4 sg;
#pragma unroll
                        for (int i = 0; i < 4; ++i) sg[i] = __builtin_amdgcn_rcpf(1.f + __expf(-x[i]));
                        *(f32x4*)(y2 + o) = *(const f32x4*)(h + o) * ALPHA + sg * *(const f32x4*)(P + o); } }
    }
};
struct EpiGU {
    static constexpr bool PERM = true;
    bf16* hid; const float* pw;
    __device__ __forceinline__ void operator()(const f32x4 (&acc)[2][2][4][2], const pg8::Unit& u, int wr, int wc, int fr, int fq) const {
        const int slot = u.aux, row0 = u.pm * 256 + wr * 64 + fr, cb = slot * 512 + u.pn * 128 + wc * 32 + 8 * fq;
#pragma unroll
        for (int ai = 0; ai < 2; ++ai)
#pragma unroll
            for (int m = 0; m < 4; ++m) { const int prow = row0 + ai * 128 + m * 16; const float w = pw[prow * 2 + slot];
                float r[8];
#pragma unroll
                for (int n = 0; n < 2; ++n)
#pragma unroll
                    for (int i = 0; i < 4; ++i) { const float g = acc[ai][0][m][n][i], up = acc[ai][1][m][n][i]; r[n * 4 + i] = g * __builtin_amdgcn_rcpf(1.f + __expf(-g)) * up * w; }
                v4u o; o.x = pg8::cvt_pk_bf16(r[0], r[1]); o.y = pg8::cvt_pk_bf16(r[2], r[3]); o.z = pg8::cvt_pk_bf16(r[4], r[5]); o.w = pg8::cvt_pk_bf16(r[6], r[7]);
                *(v4u*)(hid + (size_t)prow * 1024 + cb) = o; }
    }
};
struct EpiDown {
    static constexpr bool PERM = false;
    float* y2; const int* ptok;
    __device__ __forceinline__ void operator()(const f32x4 (&acc)[2][2][4][2], const pg8::Unit& u, int wr, int wc, int fr, int fq) const {
        const int row0 = u.pm * 256 + wr * 64 + fr, col0 = u.pn * 256 + wc * 32 + 4 * fq;
#pragma unroll
        for (int ai = 0; ai < 2; ++ai)
#pragma unroll
            for (int m = 0; m < 4; ++m) { const int tok = ptok[row0 + ai * 128 + m * 16];
                if (tok >= 0) { const size_t off = (size_t)tok * D + col0;
#pragma unroll
                    for (int bj = 0; bj < 2; ++bj)
#pragma unroll
                        for (int n = 0; n < 2; ++n) { float* p = y2 + off + bj * 128 + n * 16; *(f32x4*)p = *(const f32x4*)p + acc[ai][bj][m][n]; } } }
    }
};
struct SchedGU {
    const char* xp; const char* wgu; const volatile LAS int* tab; int G, c, ntiles;
    __device__ __forceinline__ bool next(int i, pg8::Unit& u) const {
        const int L = i * G + c; if (L >= ntiles * 8) return false;
        const int tile = L >> 3, pn = L & 7, cls = __builtin_amdgcn_readfirstlane(tab[tile]), g = cls / 6, pi = cls % 6;
        const int ea = 4 * g + (pi < 3 ? 0 : (pi < 5 ? 1 : 2)), eb = 4 * g + (pi == 0 ? 1 : ((pi == 1 || pi == 3) ? 2 : 3));
        const int slot = pn >> 2, j = pn & 3, e = slot ? eb : ea;
        u.pm = tile; u.pn = j; u.aux = slot; u.A = xp + (size_t)tile * 256 * D * 2; u.B = wgu + ((size_t)e * 1024 + (size_t)j * 256) * D * 2; u.B2 = u.B; return true;
    }
};
struct SchedDown {
    const char* hid; const char* wd; const volatile LAS int* tab; int G, c, ntiles;
    __device__ __forceinline__ bool next(int i, pg8::Unit& u) const {
        const int L = i * G + c; if (L >= ntiles * 8) return false;
        const int tile = L >> 3, pn = L & 7, cls = __builtin_amdgcn_readfirstlane(tab[tile]), g = cls / 6, pi = cls % 6;
        const int ea = 4 * g + (pi < 3 ? 0 : (pi < 5 ? 1 : 2)), eb = 4 * g + (pi == 0 ? 1 : ((pi == 1 || pi == 3) ? 2 : 3));
        u.pm = tile; u.pn = pn; u.aux = 0; u.A = hid + (size_t)tile * 256 * 1024 * 2;
        u.B = wd + ((size_t)ea * D + (size_t)pn * 256) * EH * 2; u.B2 = wd + ((size_t)eb * D + (size_t)pn * 256) * EH * 2; return true;
    }
};

__device__ __forceinline__ void load_row64(const bf16* p, float (&q)[64]) {
    const v4u* pp = (const v4u*)p;
#pragma unroll
    for (int c = 0; c < 8; ++c) { const v4u u = pp[c]; q[8 * c + 0] = bf_lo(u.x); q[8 * c + 1] = bf_hi(u.x); q[8 * c + 2] = bf_lo(u.y); q[8 * c + 3] = bf_hi(u.y);
        q[8 * c + 4] = bf_lo(u.z); q[8 * c + 5] = bf_hi(u.z); q[8 * c + 6] = bf_lo(u.w); q[8 * c + 7] = bf_hi(u.w); }
}
__device__ __forceinline__ float dot_row64(const float (&q)[64], const bf16* p) {
    const v4u* pp = (const v4u*)p; float s0 = 0.f, s1 = 0.f, s2 = 0.f, s3 = 0.f;
#pragma unroll
    for (int c = 0; c < 8; ++c) { const v4u u = pp[c];
        s0 += q[8 * c + 0] * bf_lo(u.x) + q[8 * c + 1] * bf_hi(u.x); s1 += q[8 * c + 2] * bf_lo(u.y) + q[8 * c + 3] * bf_hi(u.y);
        s2 += q[8 * c + 4] * bf_lo(u.z) + q[8 * c + 5] * bf_hi(u.z); s3 += q[8 * c + 6] * bf_lo(u.w) + q[8 * c + 7] * bf_hi(u.w); }
    return (s0 + s1) + (s2 + s3);
}
struct WAcc { float m, l; float a[64]; };
__device__ __forceinline__ void wacc_init(WAcc& A) { A.m = -1e30f; A.l = 0.f;
#pragma unroll
    for (int d = 0; d < 64; ++d) A.a[d] = 0.f; }
__device__ __forceinline__ void wacc_key(WAcc& A, float s2, const bf16* vrow) {
    const float mn = fmaxf(A.m, s2), f = ex2(A.m - mn), p = ex2(s2 - mn); A.m = mn; A.l = A.l * f + p;
    const v4u* pp = (const v4u*)vrow;
#pragma unroll
    for (int c = 0; c < 8; ++c) { const v4u u = pp[c];
        A.a[8 * c + 0] = A.a[8 * c + 0] * f + p * bf_lo(u.x); A.a[8 * c + 1] = A.a[8 * c + 1] * f + p * bf_hi(u.x);
        A.a[8 * c + 2] = A.a[8 * c + 2] * f + p * bf_lo(u.y); A.a[8 * c + 3] = A.a[8 * c + 3] * f + p * bf_hi(u.y);
        A.a[8 * c + 4] = A.a[8 * c + 4] * f + p * bf_lo(u.z); A.a[8 * c + 5] = A.a[8 * c + 5] * f + p * bf_hi(u.z);
        A.a[8 * c + 6] = A.a[8 * c + 6] * f + p * bf_lo(u.w); A.a[8 * c + 7] = A.a[8 * c + 7] * f + p * bf_hi(u.w); }
}
__device__ __forceinline__ float wacc_finish(WAcc& A, int lane, float& lse2) {
    const float M = wave_max(A.m), f = ex2(A.m - M), L = wave_sum(A.l * f);
#pragma unroll
    for (int d = 0; d < 64; ++d) A.a[d] *= f;
    reduce_scatter64(A.a, lane);
    lse2 = M + __log2f(L);
    return L > 0.f ? A.a[0] / L : 0.f;
}

__device__ __forceinline__ void phase_kmean(Frame& F) {
    const bf16* z = (const bf16*)(F.ws + WS_Z); float* km = (float*)(F.ws + WS_KMEAN); LAS float* red = (LAS float*)F.lds;
    for (int it = F.bx; it < 256; it += F.G) {
        const int b = it >> 7, h = (it >> 4) & 7, blk = it & 15, d = F.tid & 63, part = F.tid >> 6;
        const bf16* p = z + ((size_t)b * SEQ + blk * 256 + part * 32) * ZP + KA + h * 64 + d; float s = 0.f;
        for (int k = 0; k < 32; ++k) s += bf1(p[(size_t)k * ZP]);
        red[part * 64 + d] = s; __syncthreads();
        if (F.tid < 64) { float t = 0.f;
#pragma unroll
            for (int q = 0; q < 8; ++q) t += red[q * 64 + d];
            km[(size_t)it * 64 + d] = t * (1.f / 256.f); }
        __syncthreads();
    }
}
__device__ __forceinline__ float gelu_tanh(float x) { const float u = 0.7978845608028654f * (x + 0.044715f * x * x * x); const float e = __expf(2.f * u); const float th = 1.f - 2.f / (e + 1.f); return 0.5f * x * (1.f + th); }
__device__ __forceinline__ void phase_compress(Frame& F, const Args& a, int L) {
    const bf16* z = (const bf16*)(F.ws + WS_Z); LAS float* hs = (LAS float*)(F.lds + 65536) + F.wave * 1024;
    for (int it = F.gw; it < 384; it += F.ngw) {
        const int ng = it & 31, kv = (it >> 5) & 1, bh = it >> 6, b = bh / 3, hk = bh % 3, n0 = ng * 8, lane = F.lane;
        const float* W1 = a.in[kv ? I_CV1 : I_CK1] + (size_t)L * 2048 * 128; const float* W2 = a.in[kv ? I_CV2 : I_CK2] + (size_t)L * 128 * 64; const float* pe = a.in[kv ? I_PEV : I_PEK] + (size_t)L * 2048;
        const bf16* src = z + (size_t)b * SEQ * ZP + (kv ? VBC : KBC) + hk * 64;
        float h0[8], h1[8];
#pragma unroll
        for (int r = 0; r < 8; ++r) { h0[r] = 0.f; h1[r] = 0.f; }
        for (int j = 0; j < 32; ++j) {
#pragma unroll 4
            for (int d = 0; d < 64; ++d) { const int idx = j * 64 + d; const float w0 = W1[(size_t)idx * 128 + lane], w1 = W1[(size_t)idx * 128 + 64 + lane], pv = pe[idx];
#pragma unroll
                for (int r = 0; r < 8; ++r) { const int n = (n0 + r) < 255 ? (n0 + r) : 254; const float x = bf1(src[(size_t)(16 * n + j) * ZP + d]) + pv; h0[r] += x * w0; h1[r] += x * w1; } }
        }
#pragma unroll
        for (int r = 0; r < 8; ++r) { hs[r * 128 + lane] = gelu_tanh(h0[r]); hs[r * 128 + 64 + lane] = gelu_tanh(h1[r]); }
        LDS_WAIT(); asm volatile("" ::: "memory");
        float o[8];
#pragma unroll
        for (int r = 0; r < 8; ++r) o[r] = 0.f;
        for (int c = 0; c < 128; ++c) { const float w = W2[c * 64 + lane];
#pragma unroll
            for (int r = 0; r < 8; ++r) o[r] += hs[r * 128 + c] * w; }
        bf16* dst = (bf16*)(F.ws + (kv ? WS_VCMP : WS_KCMP)) + ((size_t)(b * 3 + hk) * 256) * 64;
#pragma unroll
        for (int r = 0; r < 8; ++r) if (n0 + r < 255) dst[(size_t)(n0 + r) * 64 + lane] = (bf16)f2bf(o[r]); else dst[(size_t)255 * 64 + lane] = 0;
        LDS_WAIT(); asm volatile("" ::: "memory");
    }
}
__device__ __forceinline__ void phase_dilated(Frame& F) {
    const bf16* z = (const bf16*)(F.ws + WS_Z); bf16* mix = (bf16*)(F.ws + WS_MIX); const int lane = F.lane;
    for (int it = F.gw; it < T * 4; it += F.ngw) {
        const int t = it >> 2, j = it & 3, b = t / SEQ, s = t % SEQ;
        float og[3], ls[3];
#pragma unroll
        for (int gi = 0; gi < 3; ++gi) {
            const int dil = gi == 0 ? 1 : (gi == 1 ? 4 : 16), head = gi * 4 + j;
            float q[64]; load_row64(z + (size_t)t * ZP + QC + head * 64, q);
            WAcc A; wacc_init(A);
            for (int k = lane; k <= 128; k += 64) { const int sk = s - k * dil;
                if (sk >= 0) { const bf16* kr = z + ((size_t)b * SEQ + sk) * ZP; const float sc = dot_row64(q, kr + KC + head * 64) * SC2; wacc_key(A, sc, kr + VC + head * 64); } }
            og[gi] = wacc_finish(A, lane, ls[gi]);
        }
        const float mx = fmaxf(ls[0], fmaxf(ls[1], ls[2])); const float w0 = ex2(ls[0] - mx), w1 = ex2(ls[1] - mx), w2 = ex2(ls[2] - mx);
        mix[(size_t)t * MIXW + 1280 + j * 64 + lane] = (bf16)f2bf((w0 * og[0] + w1 * og[1] + w2 * og[2]) / (w0 + w1 + w2));
    }
}
__device__ __forceinline__ void phase_moba(Frame& F) {
    const bf16* z = (const bf16*)(F.ws + WS_Z); bf16* mix = (bf16*)(F.ws + WS_MIX); const float* km = (const float*)(F.ws + WS_KMEAN); const int lane = F.lane;
    for (int it = F.gw; it < T * 8; it += F.ngw) {
        const int t = it >> 3, h = it & 7, b = t / SEQ, s = t % SEQ, cur = s >> 8;
        float q[64]; load_row64(z + (size_t)t * ZP + QA + h * 64, q);
        float gate = -1e30f;
        if (lane < cur) { const float* kmr = km + ((size_t)(b * 8 + h) * 16 + lane) * 64; float g = 0.f;
#pragma unroll
            for (int d = 0; d < 64; ++d) g += q[d] * kmr[d];
            gate = g; }
        int rank = 0;
        for (int jj = 0; jj < 16; ++jj) { const float gj = __shfl(gate, jj); rank += (gj > gate || (gj == gate && jj < lane)) ? 1 : 0; }
        const unsigned long long selm = __ballot(lane < cur && rank < 3);
        WAcc A; wacc_init(A);
        unsigned long long mm = selm;
        while (mm) { const int blk = __builtin_ctzll(mm); mm &= mm - 1;
            for (int i = 0; i < 4; ++i) { const bf16* kr = z + ((size_t)b * SEQ + blk * 256 + i * 64 + lane) * ZP; const float sc = dot_row64(q, kr + KA + h * 64) * SC2; wacc_key(A, sc, kr + VA + h * 64); } }
        for (int i = 0; i < 4; ++i) { const int sk = cur * 256 + i * 64 + lane;
            if (sk <= s) { const bf16* kr = z + ((size_t)b * SEQ + sk) * ZP; const float sc = dot_row64(q, kr + KA + h * 64) * SC2; wacc_key(A, sc, kr + VA + h * 64); } }
        float l2; const float o = wacc_finish(A, lane, l2);
        mix[(size_t)t * MIXW + h * 64 + lane] = (bf16)f2bf(o);
    }
}
__device__ __forceinline__ void phase_nsa(Frame& F) {
    const bf16* z = (const bf16*)(F.ws + WS_Z); bf16* mix = (bf16*)(F.ws + WS_MIX); const int lane = F.lane;
    LAS float* ps = (LAS float*)F.lds + F.wave * 320;
    for (int it = F.gw; it < T * 3; it += F.ngw) {
        const int t = it / 3, hk = it % 3, b = t / SEQ, s = t % SEQ, cur = s >> 6;
        const bf16* kc = (const bf16*)(F.ws + WS_KCMP) + ((size_t)(b * 3 + hk) * 256) * 64; const bf16* vc = (const bf16*)(F.ws + WS_VCMP) + ((size_t)(b * 3 + hk) * 256) * 64;
        const int ncv = s >= 31 ? ((s - 31) >> 4) + 1 : 0;
        float psum[4] = {0.f, 0.f, 0.f, 0.f}; float ocmp[4];
#pragma unroll
        for (int g = 0; g < 4; ++g) {
            float q[64]; load_row64(z + (size_t)t * ZP + QB + (hk * 4 + g) * 64, q);
            float sc[4]; float mx = -1e30f;
#pragma unroll
            for (int i = 0; i < 4; ++i) { const int n = lane + 64 * i; sc[i] = n < ncv ? dot_row64(q, kc + (size_t)n * 64) * SC2 : -1e30f; mx = fmaxf(mx, sc[i]); }
            mx = wave_max(mx); float p[4]; float ls = 0.f;
#pragma unroll
            for (int i = 0; i < 4; ++i) { const int n = lane + 64 * i; p[i] = n < ncv ? ex2(sc[i] - mx) : 0.f; ls += p[i]; }
            ls = wave_sum(ls); const float inv = ls > 0.f ? 1.f / ls : 0.f;
            float acc[64];
#pragma unroll
            for (int d = 0; d < 64; ++d) acc[d] = 0.f;
#pragma unroll
            for (int i = 0; i < 4; ++i) { const int n = lane + 64 * i; p[i] *= inv; psum[i] += p[i];
                if (n < ncv) { const v4u* pp = (const v4u*)(vc + (size_t)n * 64);
#pragma unroll
                    for (int c = 0; c < 8; ++c) { const v4u u = pp[c]; acc[8 * c + 0] += p[i] * bf_lo(u.x); acc[8 * c + 1] += p[i] * bf_hi(u.x); acc[8 * c + 2] += p[i] * bf_lo(u.y); acc[8 * c + 3] += p[i] * bf_hi(u.y);
                        acc[8 * c + 4] += p[i] * bf_lo(u.z); acc[8 * c + 5] += p[i] * bf_hi(u.z); acc[8 * c + 6] += p[i] * bf_lo(u.w); acc[8 * c + 7] += p[i] * bf_hi(u.w); } } }
            reduce_scatter64(acc, lane); ocmp[g] = acc[0];
        }
#pragma unroll
        for (int i = 0; i < 4; ++i) ps[lane + 64 * i] = (lane + 64 * i) < 255 ? psum[i] : 0.f;
        LDS_WAIT(); asm volatile("" ::: "memory");
        float imp = ps[4 * lane] + ps[4 * lane + 1] + ps[4 * lane + 2] + ps[4 * lane + 3]; if (lane > 0) imp += ps[4 * lane - 1];
        LDS_WAIT(); asm volatile("" ::: "memory");
        const bool valid = lane <= cur, forced = valid && (lane == 0 || lane > cur - 2);
        const float val = forced ? 1e30f : (valid ? imp : -1e30f);
        int rank = 0;
        for (int jj = 0; jj < 64; ++jj) { const float vj = __shfl(val, jj); rank += (vj > val || (vj == val && jj < lane)) ? 1 : 0; }
        const unsigned long long selm = __ballot(valid && rank < 16);
#pragma unroll
        for (int g = 0; g < 4; ++g) {
            const int head = hk * 4 + g;
            float q[64]; load_row64(z + (size_t)t * ZP + QB + head * 64, q);
            WAcc A; wacc_init(A);
            unsigned long long mm = selm;
            while (mm) { const int blk = __builtin_ctzll(mm); mm &= mm - 1; const int sk = blk * 64 + lane;
                if (sk <= s) { const bf16* kr = z + ((size_t)b * SEQ + sk) * ZP; const float scv = dot_row64(q, kr + KBS + hk * 64) * SC2; wacc_key(A, scv, kr + VBS + hk * 64); } }
            float l2; const float oslc = wacc_finish(A, lane, l2);
            wacc_init(A);
            for (int i = 0; i < 8; ++i) { const int sk = s - 511 + i * 64 + lane;
                if (sk >= 0) { const bf16* kr = z + ((size_t)b * SEQ + sk) * ZP; const float scv = dot_row64(q, kr + KBW + hk * 64) * SC2; wacc_key(A, scv, kr + VBW + hk * 64); } }
            const float owin = wacc_finish(A, lane, l2);
            const bf16* gp = z + (size_t)t * ZP + GB + head * 3;
            const float g0 = 1.f / (1.f + __expf(-bf1(gp[0]))), g1 = 1.f / (1.f + __expf(-bf1(gp[1]))), g2 = 1.f / (1.f + __expf(-bf1(gp[2])));
            mix[(size_t)t * MIXW + 512 + head * 64 + lane] = (bf16)f2bf(g0 * ocmp[g] + g1 * oslc + g2 * owin);
        }
    }
}

__device__ __forceinline__ void load_router(Frame& F, const float* rw) {
    LAS float* rwt = (LAS float*)F.lds;
    for (int i = F.tid; i < 8192; i += 512) { const f32x4 v = ((const f32x4*)rw)[i]; const int k = i >> 2, e0 = (i & 3) * 4; rwt[(e0 + 0) * 2048 + k] = v.x; rwt[(e0 + 1) * 2048 + k] = v.y; rwt[(e0 + 2) * 2048 + k] = v.z; rwt[(e0 + 3) * 2048 + k] = v.w; }
    __syncthreads();
}
__device__ __forceinline__ void phase_ln1_router(Frame& F, const Args& a, int L) {
    load_router(F, a.in[I_RW]);
    const LAS f32x4* rwt4 = (const LAS f32x4*)F.lds; const int lane = F.lane;
    const float* y = (const float*)(F.ws + WS_Y); float* h32 = (float*)(F.ws + WS_H32); bf16* hb = (bf16*)(F.ws + WS_HB);
    int* tokc = (int*)(F.ws + WS_TOKC); int* toks = (int*)(F.ws + WS_TOKS); float* tokw = (float*)(F.ws + WS_TOKW);
    unsigned* cnt = (unsigned*)(F.ws + WS_CTL) + CW_CNT + L * 32;
    for (int m = F.gw; m < T; m += F.ngw) {
        f32x4 o[8]; ln_row(y + (size_t)m * D, a.in[I_LN1G] + (size_t)L * D, a.in[I_LN1B] + (size_t)L * D, h32 + (size_t)m * D, hb + (size_t)m * D, lane, o);
        float myl = 0.f;
#pragma unroll 1
        for (int e = 0; e < 16; ++e) { float s = 0.f;
#pragma unroll
            for (int j = 0; j < 8; ++j) { const f32x4 w = rwt4[e * 512 + j * 64 + lane]; s += (o[j].x * w.x + o[j].y * w.y) + (o[j].z * w.z + o[j].w * w.w); }
            s = wave_sum(s); if (lane == e) myl = s; }
        if (lane < 16) myl += a.in[I_RB][lane];
        float pe[16]; float mx = -1e30f;
#pragma unroll
        for (int e = 0; e < 16; ++e) { pe[e] = __shfl(myl, e); mx = fmaxf(mx, pe[e]); }
#pragma unroll
        for (int e = 0; e < 16; ++e) pe[e] = expf(pe[e] - mx);
        int gsel = 0; float gbest = -1.f; int i1s = 0, i2s = 1; float p1s = 0.f, p2s = 0.f;
#pragma unroll
        for (int g = 0; g < 4; ++g) {
            int i1 = 0; float p1 = pe[4 * g];
#pragma unroll
            for (int i = 1; i < 4; ++i) if (pe[4 * g + i] > p1) { p1 = pe[4 * g + i]; i1 = i; }
            int i2 = -1; float p2 = -1.f;
#pragma unroll
            for (int i = 0; i < 4; ++i) if (i != i1 && pe[4 * g + i] > p2) { p2 = pe[4 * g + i]; i2 = i; }
            const float sg = p1 + p2;
            if (sg > gbest) { gbest = sg; gsel = g; i1s = i1; i2s = i2; p1s = p1; p2s = p2; }
        }
        const int lo = i1s < i2s ? i1s : i2s, hi = i1s < i2s ? i2s : i1s;
        const float wlo = (i1s < i2s ? p1s : p2s) / (p1s + p2s), whi = (i1s < i2s ? p2s : p1s) / (p1s + p2s);
        const int pi = lo == 0 ? hi - 1 : (lo == 1 ? hi + 1 : 5);
        const int cls = gsel * 6 + pi;
        if (lane == 0) { const unsigned slot = __hip_atomic_fetch_add(cnt + cls, 1u, __ATOMIC_RELAXED, __HIP_MEMORY_SCOPE_AGENT); tokc[m] = cls; toks[m] = (int)slot; tokw[2 * m] = wlo; tokw[2 * m + 1] = whi; }
    }
    __syncthreads();
}
__device__ __forceinline__ void build_tiles(Frame& F, int L) {
    volatile LAS int* tab = (volatile LAS int*)(F.lds + TILE_OFF);
    if (F.tid == 0) { const unsigned* cnt = (const unsigned*)(F.ws + WS_CTL) + CW_CNT + L * 32; int off = 0, nt = 0;
        for (int c = 0; c < 24; ++c) { const int n = (int)cnt[c]; tab[64 + c] = off; const int k = (n + 255) >> 8; for (int i = 0; i < k && nt < MAXTILES; ++i) tab[nt++] = c; off += k * 256; }
        tab[64 + 24] = off; tab[96] = nt; }
    __syncthreads();
}
__device__ __forceinline__ void phase_gather(Frame& F, int L) {
    volatile LAS int* tab = (volatile LAS int*)(F.lds + TILE_OFF);
    const int* tokc = (const int*)(F.ws + WS_TOKC); const int* toks = (const int*)(F.ws + WS_TOKS); const float* tokw = (const float*)(F.ws + WS_TOKW);
    int* ptok = (int*)(F.ws + WS_PTOK); float* pw = (float*)(F.ws + WS_PW); const v4u* hb = (const v4u*)(F.ws + WS_HB); v4u* xp = (v4u*)(F.ws + WS_XP);
    const unsigned* cnt = (const unsigned*)(F.ws + WS_CTL) + CW_CNT + L * 32;
    if (F.bx < 24) { const int c = F.bx; const int lo = tab[64 + c] + (int)cnt[c], hi = tab[64 + c + 1]; for (int r = lo + F.tid; r < hi; r += 512) ptok[r] = -1; }
    for (int t = F.gw; t < T; t += F.ngw) {
        const int pos = tab[64 + tokc[t]] + toks[t];
#pragma unroll
        for (int j = 0; j < 4; ++j) xp[(size_t)pos * 256 + j * 64 + F.lane] = hb[(size_t)t * 256 + j * 64 + F.lane];
        if (F.lane == 0) { ptok[pos] = t; pw[2 * pos] = tokw[2 * t]; pw[2 * pos + 1] = tokw[2 * t + 1]; }
    }
}

constexpr int NPH_LAYER = 9, NPH = 1 + DEPTH * NPH_LAYER;
__global__ void __launch_bounds__(512, 2) fwd(Args args) {
    extern __shared__ __attribute__((aligned(16))) unsigned char lds[];
    const int wave0 = __builtin_amdgcn_readfirstlane(threadIdx.x >> 6);
#define MKFRAME(F) Frame F; { int w_ = wave0; asm volatile("" : "+s"(w_)); int l_; asm volatile("v_mbcnt_lo_u32_b32 %0, -1, 0\n\tv_mbcnt_hi_u32_b32 %0, -1, %0" : "=v"(l_)); int t_ = w_ * 64 + l_; F.lds = (LAS unsigned char*)lds; F.tid = t_; F.lane = t_ & 63; F.wave = __builtin_amdgcn_readfirstlane(t_ >> 6); \
    int g_ = gridDim.x, b_ = blockIdx.x; asm volatile("" : "+s"(g_), "+s"(b_)); F.G = g_; F.bx = b_; F.gw = b_ * 8 + F.wave; F.ngw = g_ * 8; F.ws = args.ws; }
    MKFRAME(F);
    for (int u = F.tid; u < (LDS_BYTES - LDSCTL_OFF) / 4; u += 512) ((LAS unsigned*)(F.lds + LDSCTL_OFF))[u] = 0u;
    __syncthreads();
    volatile LAS unsigned* MISC = (volatile LAS unsigned*)(F.lds + MISC_OFF);
    XcdBarrier bar; bar.bar = (unsigned*)(F.ws + WS_CTL) + CW_BAR; bar.x = xb_xcc_id(); bar.st = MISC + 8;
    const int lo = args.ph_lo, hi = args.ph_hi;
    if (hi - lo > 1 && F.tid == 0) (void)xb_add(&bar.bar[XB_XCNT(bar.x)], 1u);
#ifndef PH_MASK
#define PH_MASK 0x3ff
#endif
#define IN(k) (lo <= (k) && (k) < hi)
#define EN(b) ((PH_MASK >> (b)) & 1)
#define SEAM(k) do { if (IN((k) + 1)) { MKFRAME(Fb_); xcd_barrier(bar, Fb_.tid); } } while (0)
    PG8_LAS unsigned char* ring = (PG8_LAS unsigned char*)lds;

    if (EN(9) && IN(0)) { MKFRAME(F0); phase_prologue(F0, args); SEAM(0); }

    for (int L = 0; L < DEPTH; ++L) {
        const int p0 = 1 + L * NPH_LAYER;
        unsigned char* wl = args.ws + WS_W + (size_t)L * LW_STRIDE;
        if (EN(0) && IN(p0 + 0)) {
            MKFRAME(F);
            pg8::SchedDense S; S.A = (const char*)(F.ws + WS_HB); S.Bt = (const char*)(wl + LW_IN); S.tA = (size_t)256 * D * 2; S.tB = (size_t)256 * D * 2; S.so.init(T, ZP, F.G, F.bx);
            EpiZ E{(bf16*)(F.ws + WS_Z), (const float*)(F.ws + WS_CS)};
            pg8::gemm_phase<EpiZ, pg8::SchedDense, true>(ring, F.tid, D, D, D / 64, D / 64, S, E);
            SEAM(p0 + 0);
        }
        if (EN(1) && IN(p0 + 1)) { { MKFRAME(F1); phase_kmean(F1); } { MKFRAME(F1); phase_compress(F1, args, L); } { MKFRAME(F1); phase_dilated(F1); } SEAM(p0 + 1); }
        if (EN(2) && IN(p0 + 2)) { { MKFRAME(F2); phase_moba(F2); } { MKFRAME(F2); phase_nsa(F2); } SEAM(p0 + 2); }
        if (EN(3) && IN(p0 + 3)) {
            MKFRAME(F);
            pg8::SchedDense S; S.A = (const char*)(F.ws + WS_MIX); S.Bt = (const char*)(wl + LW_OUT); S.tA = (size_t)256 * MIXW * 2; S.tB = (size_t)256 * MIXW * 2; S.so.init(T, D, F.G, F.bx);
            EpiRes E{(const float*)(F.ws + WS_H32), (float*)(F.ws + WS_Y)};
            pg8::gemm_phase<EpiRes, pg8::SchedDense, false>(ring, F.tid, MIXW, MIXW, MIXW / 64, MIXW / 64, S, E);
            SEAM(p0 + 3);
        }
        if (EN(4) && IN(p0 + 4)) { MKFRAME(F4); phase_ln1_router(F4, args, L); SEAM(p0 + 4); }
        if (EN(5) && IN(p0 + 5)) {
            { MKFRAME(F5); build_tiles(F5, L); phase_gather(F5, L); } __syncthreads();
            { MKFRAME(F); pg8::SchedDense S; S.A = (const char*)(F.ws + WS_PB) + (size_t)L * T * PLE * 2; S.Bt = (const char*)(wl + LW_PP); S.tA = (size_t)256 * PLE * 2; S.tB = (size_t)256 * PLE * 2; S.so.init(T, D, F.G, F.bx);
              EpiF32 E{(float*)(F.ws + WS_PPLE)};
              pg8::gemm_phase<EpiF32, pg8::SchedDense, false>(ring, F.tid, PLE, PLE, PLE / 64, PLE / 64, S, E); }
            { MKFRAME(F); pg8::SchedDense S; S.A = (const char*)(F.ws + WS_HB); S.Bt = (const char*)(wl + LW_PG); S.tA = (size_t)256 * D * 2; S.tB = (size_t)256 * D * 2; S.so.init(T, D, F.G, F.bx);
              EpiPle E{(const float*)(F.ws + WS_H32), (const float*)(F.ws + WS_PPLE), args.in[I_PGB] + (size_t)L * D, (float*)(F.ws + WS_Y)};
              pg8::gemm_phase<EpiPle, pg8::SchedDense, false>(ring, F.tid, D, D, D / 64, D / 64, S, E); }
            SEAM(p0 + 5);
        }
        if (EN(6) && IN(p0 + 6)) {
            MKFRAME(F); build_tiles(F, L);
            const volatile LAS int* tab = (const volatile LAS int*)(F.lds + TILE_OFF);
            SchedGU S{(const char*)(F.ws + WS_XP), (const char*)(wl + LW_GU), tab, F.G, F.bx, __builtin_amdgcn_readfirstlane(tab[96])};
            EpiGU E{(bf16*)(F.ws + WS_HID), (const float*)(F.ws + WS_PW)};
            pg8::gemm_phase<EpiGU, SchedGU, true>(ring, F.tid, D, D, D / 64, D / 64, S, E);
            SEAM(p0 + 6);
        }
        if (EN(7) && IN(p0 + 7)) {
            MKFRAME(F); build_tiles(F, L);
            const volatile LAS int* tab = (const volatile LAS int*)(F.lds + TILE_OFF);
            SchedDown S{(const char*)(F.ws + WS_HID), (const char*)(wl + LW_D), tab, F.G, F.bx, __builtin_amdgcn_readfirstlane(tab[96])};
            EpiDown E{(float*)(F.ws + WS_Y), (const int*)(F.ws + WS_PTOK)};
            pg8::gemm_phase<EpiDown, SchedDown, false>(ring, F.tid, 1024, EH, 16, 8, S, E);
            SEAM(p0 + 7);
        }
        if (EN(8) && IN(p0 + 8)) {
            const bool lastL = (L == DEPTH - 1); MKFRAME(F);
            for (int m = F.gw; m < T; m += F.ngw) { f32x4 o[8];
                ln_row((const float*)(F.ws + WS_Y) + (size_t)m * D, args.in[I_LN2G] + (size_t)L * D, args.in[I_LN2B] + (size_t)L * D,
                       lastL ? args.out + (size_t)m * D : (float*)(F.ws + WS_H32) + (size_t)m * D, lastL ? (bf16*)nullptr : (bf16*)(F.ws + WS_HB) + (size_t)m * D, F.lane, o); }
            SEAM(p0 + 8);
        }
    }
#undef IN
#undef SEAM
}

extern "C" void kernel_launch(void* const* d_in, const int* in_sizes, int n_in, void* d_out, int out_size, void* d_ws, size_t ws_size, hipStream_t stream) {
    static int grid = 0;
    if (grid == 0) {
        if (n_in != 25 || ws_size < WS_END) { fprintf(stderr, "kernel_launch: unexpected n_in %d / ws %zu\n", n_in, ws_size); grid = -1; return; }
        int dev = 0, cus = 0;
        if (hipGetDevice(&dev) != hipSuccess || hipDeviceGetAttribute(&cus, hipDeviceAttributeMultiprocessorCount, dev) != hipSuccess) { grid = -1; return; }
        if (hipFuncSetAttribute((const void*)fwd, hipFuncAttributeMaxDynamicSharedMemorySize, LDS_BYTES) != hipSuccess) { fprintf(stderr, "kernel_launch: hipFuncSetAttribute failed\n"); grid = -1; return; }
        int per_cu = 0; (void)hipOccupancyMaxActiveBlocksPerMultiprocessor(&per_cu, (const void*)fwd, 512, LDS_BYTES); (void)hipGetLastError();
        grid = cus;
    }
    if (grid < 0) return;
    (void)hipMemsetAsync((char*)d_ws + WS_CTL, 0, CTL_ZERO_BYTES, stream);
    Args a{};
    for (int i = 0; i < 25; ++i) a.in[i] = (const float*)d_in[i];
    a.out = (float*)d_out; a.ws = (unsigned char*)d_ws;
#if MK_SINGLE
    a.ph_lo = 0; a.ph_hi = NPH;
    hipLaunchKernelGGL(fwd, dim3(grid), dim3(512), LDS_BYTES, stream, a);
#else
    for (int p = 0; p < NPH; ++p) { a.ph_lo = p; a.ph_hi = p + 1; hipLaunchKernelGGL(fwd, dim3(grid), dim3(512), LDS_BYTES, stream, a); }
#endif
}
```

```cpp
#include <hip/hip_runtime.h>
#include <cstdio>
#include <cstdint>

#ifndef MK_SINGLE
#define MK_SINGLE 1
#endif

namespace pg8 {
#define PG8_LAS __attribute__((address_space(3)))
typedef unsigned short bf16_t;
typedef short bf16x8 __attribute__((ext_vector_type(8)));
typedef float f32x4 __attribute__((ext_vector_type(4)));
typedef unsigned u32x4 __attribute__((ext_vector_type(4)));
constexpr int BM = 256, BK = 64, HALF = 128, HTB = HALF * BK * 2, STAGE_BYTES = 8 * HTB, NXCD = 8, WGM = 8;

__host__ __device__ __forceinline__ int lds_byte(int r, int c) { const int st = (r >> 4) * 2 + (c >> 5), rr = r & 15, cc = c & 31, ob = rr * 64 + cc * 2; return st * 1024 + (ob ^ (((ob >> 9) & 1) << 5)); }
__host__ __device__ __forceinline__ void stage_rc(int b, int& R, int& C) { const int st = b / 1024, sb = b % 1024, swz = sb ^ (((sb >> 9) & 1) << 5); R = (st >> 1) * 16 + swz / 64; C = (st & 1) * 32 + (swz % 64) / 2; }
__host__ __device__ __forceinline__ int perm32(int rho) { const int n = rho >> 4, i = rho & 15; return 8 * (i >> 2) + 4 * n + (i & 3); }

struct Unit { const char* A; const char* B; const char* B2; int pm, pn, aux; };

struct StaticOrder {
    int nM, nN, nwg, G, c;
    __device__ void init(int M, int N, int G_, int c_) { nM = M / BM; nN = N / BM; nwg = nM * nN; G = G_; c = c_; }
    __device__ bool next(int i, int& pm, int& pn) const {
        const long L = (long)i * G + c; if (L >= nwg) return false;
        int wgid = (int)L; { const int q = nwg / NXCD, r = nwg % NXCD, xcd = wgid % NXCD, off = wgid / NXCD; wgid = (xcd < r ? xcd * (q + 1) : r * (q + 1) + (xcd - r) * q) + off; }
        const int nig = WGM * nN, gid = wgid / nig, fm = gid * WGM, gsz = (nM - fm) < WGM ? (nM - fm) : WGM;
        pm = fm + ((wgid % nig) % gsz); pn = (wgid % nig) / gsz; return true;
    }
};
struct SchedDense {
    const char* A; const char* Bt; size_t tA, tB; StaticOrder so;
    __device__ __forceinline__ bool next(int i, Unit& u) const { int pm, pn; if (!so.next(i, pm, pn)) return false; u.pm = pm; u.pn = pn; u.aux = 0; u.A = A + (size_t)pm * tA; u.B = Bt + (size_t)pn * tB; u.B2 = u.B; return true; }
};

__device__ __forceinline__ unsigned cvt_pk_bf16(float lo, float hi) { unsigned r; asm volatile("v_cvt_pk_bf16_f32 %0, %1, %2" : "=v"(r) : "v"(lo), "v"(hi)); return r; }

template <class Epi, class Sched, bool ALIGN_EPI>
__device__ __forceinline__ void gemm_phase(PG8_LAS unsigned char* lds, const int tid_in, const int lda, const int ldb, const int nt, const int ksplit, const Sched& S, const Epi& E) {
    int tid_ = tid_in; asm volatile("" : "+v"(tid_));
    const int tid = tid_, wid = __builtin_amdgcn_readfirstlane(tid >> 6), lane = tid & 63, wr = wid >> 2, wc = wid & 3, fr = lane & 15, fq = lane >> 4;
    unsigned voffA[2], voffB[2];
#pragma unroll
    for (int i = 0; i < 2; ++i) { int R, C; stage_rc(tid * 16 + i * 8192, R, C); const int Rb = Epi::PERM ? ((R & ~31) + perm32(R & 31)) : R;
        voffA[i] = (unsigned)(R * lda + C) * 2u; voffB[i] = (unsigned)(Rb * ldb + C) * 2u; }
    const size_t kstep = (size_t)(BK * 2);
    const size_t hA = (size_t)HALF * lda * 2, hB = (size_t)HALF * ldb * 2;
    const unsigned ldsw = (unsigned)wid * 1024u;
    const int aoff = lds_byte(wr * 64 + fr, fq * 8), boff = lds_byte(wc * 32 + fr, fq * 8);
#define PG8_SA(b, h) (((b) * 2 + (h)) * HTB)
#define PG8_SB(b, h) ((4 + (b) * 2 + (h)) * HTB)
#define PG8_STAGE(bufoff, gbase, voff) do { _Pragma("unroll") for (int _i = 0; _i < 2; ++_i) \
        __builtin_amdgcn_global_load_lds((const unsigned*)((const char*)(gbase) + (voff)[_i]), (PG8_LAS unsigned*)(lds + (bufoff) + ldsw + _i * 8192), 16, 0, 0); } while (0)
#define PG8_LDA(dst, b, h) do { _Pragma("unroll") for (int m = 0; m < 4; ++m) _Pragma("unroll") for (int k = 0; k < 2; ++k) dst[m][k] = *(const PG8_LAS bf16x8*)(lds + PG8_SA(b, h) + aoff + m * 2048 + k * 1024); } while (0)
#define PG8_LDB(dst, b, h) do { _Pragma("unroll") for (int n = 0; n < 2; ++n) _Pragma("unroll") for (int k = 0; k < 2; ++k) dst[n][k] = *(const PG8_LAS bf16x8*)(lds + PG8_SB(b, h) + boff + n * 2048 + k * 1024); } while (0)
#define PG8_MMA(ai, bj, At, Bt) do { __builtin_amdgcn_s_setprio(1); _Pragma("unroll") for (int m = 0; m < 4; ++m) _Pragma("unroll") for (int n = 0; n < 2; ++n) _Pragma("unroll") for (int k = 0; k < 2; ++k) \
        acc[ai][bj][m][n] = __builtin_amdgcn_mfma_f32_16x16x32_bf16(Bt[n][k], At[m][k], acc[ai][bj][m][n], 0, 0, 0); __builtin_amdgcn_s_setprio(0); } while (0)
#define PG8_WAIT_V(n) asm volatile("s_waitcnt vmcnt(" #n ")" ::: "memory")
#define PG8_WAIT_L(n) asm volatile("s_waitcnt lgkmcnt(" #n ")" ::: "memory")
#define PG8_BAR __builtin_amdgcn_s_barrier()
#define PG8_SCHED __builtin_amdgcn_sched_barrier(0)
    Unit cur, nxt; int ui = 0;
    if (!S.next(0, cur)) return;
    f32x4 acc[2][2][4][2];
#pragma unroll
    for (int a = 0; a < 2; ++a)
#pragma unroll
        for (int b = 0; b < 2; ++b)
#pragma unroll
            for (int m = 0; m < 4; ++m)
#pragma unroll
                for (int n = 0; n < 2; ++n) acc[a][b][m][n] = (f32x4){0.f, 0.f, 0.f, 0.f};
    bf16x8 At[4][2], B0[2][2], B1[2][2];
    const char* cA = cur.A; const char* cB = cur.B; const char* cB2 = cur.B2;
    PG8_STAGE(PG8_SB(0, 0), cB, voffB); PG8_STAGE(PG8_SB(0, 1), cB + hB, voffB); PG8_STAGE(PG8_SA(0, 0), cA, voffA); PG8_STAGE(PG8_SA(0, 1), cA + hA, voffA);
    if (wr == 1) PG8_BAR;
    PG8_WAIT_V(2); PG8_BAR;
    PG8_STAGE(PG8_SB(1, 0), cB + kstep, voffB); PG8_STAGE(PG8_SA(1, 0), cA + kstep, voffA); PG8_STAGE(PG8_SB(1, 1), cB + hB + kstep, voffB);
    PG8_WAIT_V(6); PG8_BAR;
    for (;;) {
        const bool has_next = S.next(ui + 1, nxt);
        const char* nA = has_next ? nxt.A : cA; const char* nB = has_next ? nxt.B : cB;
        for (int t = 0; t < nt; t += 2) {
            const bool last = (t == nt - 2);
            const int t2 = t + 2;
            const char* a1 = cA + (size_t)(t + 1) * kstep;
            const char* a2 = last ? nA : cA + (size_t)t2 * kstep;
            const char* b2 = last ? nB : (t2 < ksplit ? cB + (size_t)t2 * kstep : cB2 + (size_t)(t2 - ksplit) * kstep);
            const char* a3 = a2 + kstep; const char* b3 = b2 + kstep;
            PG8_LDB(B0, 0, 0); PG8_LDB(B1, 0, 1); PG8_SCHED; PG8_LDA(At, 0, 0); PG8_STAGE(PG8_SA(1, 1), a1 + hA, voffA);
            PG8_WAIT_V(8); PG8_WAIT_L(0); PG8_BAR; PG8_MMA(0, 0, At, B0); PG8_MMA(0, 1, At, B1); PG8_BAR; PG8_SCHED;
            PG8_LDA(At, 0, 1); PG8_STAGE(PG8_SB(0, 0), b2, voffB); PG8_STAGE(PG8_SB(0, 1), b2 + hB, voffB); PG8_STAGE(PG8_SA(0, 0), a2, voffA);
            PG8_WAIT_V(8); PG8_WAIT_L(0); PG8_BAR; PG8_MMA(1, 0, At, B0); PG8_MMA(1, 1, At, B1); PG8_BAR; PG8_SCHED;
            PG8_LDB(B0, 1, 0); PG8_LDB(B1, 1, 1); PG8_SCHED; PG8_LDA(At, 1, 0); PG8_STAGE(PG8_SA(0, 1), a2 + hA, voffA);
            PG8_WAIT_V(8); PG8_WAIT_L(0); PG8_BAR; PG8_MMA(0, 0, At, B0); PG8_MMA(0, 1, At, B1); PG8_BAR; PG8_SCHED;
            PG8_LDA(At, 1, 1); PG8_STAGE(PG8_SB(1, 0), b3, voffB); PG8_STAGE(PG8_SB(1, 1), b3 + hB, voffB); PG8_STAGE(PG8_SA(1, 0), a3, voffA);
            PG8_WAIT_V(8); PG8_WAIT_L(0); PG8_BAR; PG8_MMA(1, 0, At, B0); PG8_MMA(1, 1, At, B1); PG8_BAR; PG8_SCHED;
        }
        if constexpr (ALIGN_EPI) { if (wr == 0) PG8_BAR; }
        E(acc, cur, wr, wc, fr, fq);
        if (!has_next) break;
#pragma unroll
        for (int a = 0; a < 2; ++a)
#pragma unroll
            for (int b = 0; b < 2; ++b)
#pragma unroll
                for (int m = 0; m < 4; ++m)
#pragma unroll
                    for (int n = 0; n < 2; ++n) acc[a][b][m][n] = (f32x4){0.f, 0.f, 0.f, 0.f};
        cur = nxt; cA = nA; cB = nB; cB2 = nxt.B2; ++ui;
        if constexpr (ALIGN_EPI) { if (wr == 1) PG8_BAR; }
    }
    PG8_WAIT_V(0);
    if constexpr (!ALIGN_EPI) { if (wr == 0) PG8_BAR; }
    PG8_BAR;
#undef PG8_SA
#undef PG8_SB
#undef PG8_STAGE
#undef PG8_LDA
#undef PG8_LDB
#undef PG8_MMA
#undef PG8_WAIT_V
#undef PG8_WAIT_L
#undef PG8_BAR
#undef PG8_SCHED
}
}

constexpr int BATCH = 2, SEQ = 4096, T = BATCH * SEQ, D = 2048, DEPTH = 4;
constexpr int ZP = 5888;
constexpr int MIXW = 1536;
constexpr int NEXP = 16, EH = 512, PLE = 256;
constexpr float LN_EPS = 1e-5f;
constexpr float ALPHA = 1.681792830507429f;
constexpr float SC2 = 0.125f * 1.4426950408889634f;
constexpr int QA = 0, KA = 512, VA = 1024, QB = 1536, KBC = 2304, VBC = 2496, KBS = 2688, VBS = 2880, KBW = 3072, VBW = 3264, QC = 3456, KC = 4224, VC = 4992, GB = 5760;
constexpr int MAXTILES = 56, TPAD = MAXTILES * 256;

constexpr size_t MiB = 1u << 20;
constexpr size_t WS_CTL = 0, CTL_ZERO_BYTES = 1 * MiB;
constexpr size_t WS_CS = 1 * MiB;
constexpr size_t WS_KMEAN = 2 * MiB;
constexpr size_t WS_KCMP = 3 * MiB;
constexpr size_t WS_VCMP = 4 * MiB;
constexpr size_t WS_TOKC = 5 * MiB;
constexpr size_t WS_TOKS = 5 * MiB + 64 * 1024;
constexpr size_t WS_TOKW = 5 * MiB + 128 * 1024;
constexpr size_t WS_PTOK = 6 * MiB;
constexpr size_t WS_PW = 6 * MiB + 128 * 1024;
constexpr size_t WS_W = 16 * MiB;
constexpr size_t LW_IN = 0, LW_OUT = LW_IN + (size_t)ZP * D * 2, LW_GU = LW_OUT + (size_t)D * MIXW * 2, LW_D = LW_GU + (size_t)NEXP * 1024 * D * 2,
                 LW_PG = LW_D + (size_t)NEXP * D * EH * 2, LW_PP = LW_PG + (size_t)D * D * 2, LW_END = LW_PP + (size_t)D * PLE * 2;
constexpr size_t LW_STRIDE = 135 * MiB;
static_assert(LW_END <= LW_STRIDE, "layer weights");
constexpr size_t WS_H32 = 556 * MiB, WS_HB = 620 * MiB, WS_Z = 652 * MiB, WS_Y = 744 * MiB, WS_MIX = 808 * MiB, WS_XP = 832 * MiB, WS_HID = 888 * MiB,
                 WS_PPLE = 916 * MiB, WS_PB = 980 * MiB, WS_END = 996 * MiB;
static_assert(WS_W + 4 * LW_STRIDE <= WS_H32 && WS_Z + (size_t)T * ZP * 2 <= WS_Y && WS_XP + (size_t)TPAD * D * 2 <= WS_HID && WS_HID + (size_t)TPAD * 1024 * 2 <= WS_PPLE, "ws map");
constexpr int CW_BAR = 4096;
constexpr int CW_CNT = 16384;

constexpr int RING_BYTES = 131072, LDSCTL_OFF = RING_BYTES, MISC_OFF = LDSCTL_OFF + 320, TILE_OFF = LDSCTL_OFF + 1024;
constexpr int LDS_BYTES = 147456;

#define GAS __attribute__((address_space(1)))
#define LAS __attribute__((address_space(3)))
typedef unsigned short bf16;
typedef unsigned v4u __attribute__((ext_vector_type(4)));
typedef float f32x4 __attribute__((ext_vector_type(4)));
#define LDS_WAIT() asm volatile("s_waitcnt lgkmcnt(0)" ::: "memory")
__device__ __forceinline__ unsigned f2bf(float f) { unsigned u = __builtin_bit_cast(unsigned, f); return (u + 0x7fffu + ((u >> 16) & 1u)) >> 16; }
__device__ __forceinline__ unsigned pk2(float lo, float hi) { return f2bf(lo) | (f2bf(hi) << 16); }
__device__ __forceinline__ float bf_lo(unsigned u) { return __builtin_bit_cast(float, u << 16); }
__device__ __forceinline__ float bf_hi(unsigned u) { return __builtin_bit_cast(float, u & 0xffff0000u); }
__device__ __forceinline__ float bf1(bf16 u) { return __builtin_bit_cast(float, ((unsigned)u) << 16); }
__device__ __forceinline__ float ex2(float x) { return __builtin_amdgcn_exp2f(x); }

#define XB_TMO      128
#define XB_XCNT(j)  (256  + 64 * (j))
#define XB_XSUB(j)  (1280 + 64 * (j))
#define XB_XGEN(j)  (2304 + 64 * (j))
#define XB_TOP      3328
#define XB_TOPGEN   3392
#define XCD_BAR_WORDS 3456
#define XB_SPIN_CAP (1u << 18)
__device__ __forceinline__ unsigned xb_ld(unsigned* p)              { return __hip_atomic_load(p, __ATOMIC_RELAXED, __HIP_MEMORY_SCOPE_AGENT); }
__device__ __forceinline__ unsigned xb_add(unsigned* p, unsigned v) { return __hip_atomic_fetch_add(p, v, __ATOMIC_RELAXED, __HIP_MEMORY_SCOPE_AGENT); }
__device__ __forceinline__ unsigned xb_xcc_id() { return (unsigned)__builtin_amdgcn_s_getreg((3 << 11) | 20) & 0xFu; }
#define XB_SPIN(cond, bar) do { unsigned _sp = 0; while (cond) { __builtin_amdgcn_s_sleep(1); \
    if ((++_sp & 255u) == 0u) { if (xb_ld(&(bar)[XB_TMO])) break; if (_sp > XB_SPIN_CAP) { atomicAdd(&(bar)[XB_TMO], 1u); break; } } } } while (0)
struct XcdBarrier { unsigned* bar; unsigned x; volatile LAS unsigned* st; };
__device__ __forceinline__ XcdBarrier xcd_barrier_post(unsigned* bar, volatile LAS unsigned* st) {
    XcdBarrier b; b.bar = bar; b.x = xb_xcc_id(); b.st = st;
    if (threadIdx.x == 0) (void)xb_add(&bar[XB_XCNT(b.x)], 1u);
    return b;
}
__device__ __forceinline__ void xcd_barrier_complete(unsigned* bar, unsigned x, unsigned& nloc, unsigned& nx) {
    const unsigned G = gridDim.x * gridDim.y * gridDim.z;
    unsigned sum, cnt, mine, sp = 0u;
    for (;;) {
        sum = 0u; cnt = 0u; mine = 0u;
#pragma unroll
        for (unsigned j = 0; j < 16; ++j) { const unsigned c = xb_ld(&bar[XB_XCNT(j)]); sum += c; cnt += (c > 0u) ? 1u : 0u; mine = (j == x) ? c : mine; }
        if (sum == G) break;
        __builtin_amdgcn_s_sleep(1);
        if ((++sp & 255u) == 0u) { if (xb_ld(&bar[XB_TMO])) break; if (sp > XB_SPIN_CAP) { atomicAdd(&bar[XB_TMO], 1u); break; } }
    }
    nloc = mine > 0u ? mine : 1u; nx = cnt > 0u ? cnt : 1u;
}
__device__ __forceinline__ void xcd_barrier(const XcdBarrier& b, const int tid) {
    asm volatile("s_waitcnt vmcnt(0)" ::: "memory");
    __syncthreads();
    if (tid == 0) {
        unsigned* bar = b.bar;
        __builtin_amdgcn_s_waitcnt(0);
        unsigned nloc = b.st[0], nx = b.st[1];
        if (nloc == 0u) { xcd_barrier_complete(bar, b.x, nloc, nx); b.st[0] = nloc; b.st[1] = nx; }
        const unsigned old = xb_add(&bar[XB_XSUB(b.x)], 1u);
        const unsigned gen = old / nloc;
        if (old + 1u == (gen + 1u) * nloc) {
            __builtin_amdgcn_fence(__ATOMIC_RELEASE, "agent");
            asm volatile("s_waitcnt vmcnt(0)" ::: "memory");
            const unsigned og = xb_add(&bar[XB_TOP], 1u);
            const unsigned tg = og / nx;
            if (og + 1u == (tg + 1u) * nx) xb_add(&bar[XB_TOPGEN], 1u);
            else XB_SPIN(xb_ld(&bar[XB_TOPGEN]) == tg, bar);
            __builtin_amdgcn_fence(__ATOMIC_ACQUIRE, "agent");
            xb_add(&bar[XB_XGEN(b.x)], 1u);
            asm volatile("s_waitcnt vmcnt(0)" ::: "memory");
        } else {
            XB_SPIN(xb_ld(&bar[XB_XGEN(b.x)]) == gen, bar);
            __builtin_amdgcn_fence(__ATOMIC_ACQUIRE, "agent");
            asm volatile("s_waitcnt vmcnt(0)" ::: "memory");
        }
    }
    __syncthreads();
}

struct Args { const float* in[25]; float* out; unsigned char* ws; int ph_lo, ph_hi; };
enum { I_X = 0, I_P, I_POS, I_LNG, I_LNB, I_WIN, I_WOUT, I_CK1, I_CK2, I_PEK, I_CV1, I_CV2, I_PEV, I_LN1G, I_LN1B, I_RW, I_RB, I_WG, I_WU, I_WD, I_PP, I_PGW, I_PGB, I_LN2G, I_LN2B };

struct Frame {
    LAS unsigned char* lds;
    int tid, lane, wave, G, bx, gw, ngw;
    unsigned char* ws;
};

__device__ __forceinline__ float wave_sum(float v) {
#pragma unroll
    for (int o = 1; o < 64; o <<= 1) v += __shfl_xor(v, o);
    return v;
}
__device__ __forceinline__ float wave_max(float v) {
#pragma unroll
    for (int o = 1; o < 64; o <<= 1) v = fmaxf(v, __shfl_xor(v, o));
    return v;
}
template <int OFF> __device__ __forceinline__ void rs_step(float (&v)[64], int lane) {
    const bool up = (lane & OFF) != 0;
#pragma unroll
    for (int i = 0; i < OFF; ++i) { const float send = up ? v[i] : v[i + OFF]; const float keep = up ? v[i + OFF] : v[i]; v[i] = keep + __shfl_xor(send, OFF); }
}
__device__ __forceinline__ void reduce_scatter64(float (&v)[64], int lane) { rs_step<32>(v, lane); rs_step<16>(v, lane); rs_step<8>(v, lane); rs_step<4>(v, lane); rs_step<2>(v, lane); rs_step<1>(v, lane); }

template <int MAP>
__device__ __forceinline__ int rowmap(int n) {
    if (MAP == 1) return n < 3456 ? n : (n < 3492 ? n - 3456 + GB : n - 36);
    if (MAP == 2) return ((n >> 7) << 8) + (n & 127);
    if (MAP == 3) return ((n >> 7) << 8) + 128 + (n & 127);
    return n;
}
template <int MAP>
__device__ __forceinline__ void transpose_item(const float* W, int K, int N, bf16* WT, LAS float* scr, int item, int lane) {
    const int nblk = (N + 31) / 32, kb = item / nblk, nb = item % nblk, k0 = 64 * kb, n0 = 32 * nb;
    const int nn = n0 + (lane & 31); const bool okn = nn < N;
#pragma unroll 8
    for (int i = 0; i < 32; ++i) { const int kk = 2 * i + (lane >> 5); scr[kk * 33 + (lane & 31)] = okn ? W[(size_t)(k0 + kk) * N + nn] : 0.f; }
    LDS_WAIT(); asm volatile("" ::: "memory");
    const int c = lane & 7;
#pragma unroll
    for (int j = 0; j < 4; ++j) { const int n = (lane >> 3) + 8 * j; const LAS float* s = scr + (8 * c) * 33 + n;
        v4u o; o.x = pk2(s[0 * 33], s[1 * 33]); o.y = pk2(s[2 * 33], s[3 * 33]); o.z = pk2(s[4 * 33], s[5 * 33]); o.w = pk2(s[6 * 33], s[7 * 33]);
        if (n0 + n < N) *(v4u*)(WT + (size_t)rowmap<MAP>(n0 + n) * K + k0 + 8 * c) = o; }
    LDS_WAIT(); asm volatile("" ::: "memory");
}

__device__ __forceinline__ void ln_row(const float* src, const float* g, const float* b, float* dst32, bf16* dstb, int lane, f32x4 (&o)[8]) {
    const f32x4* xr = (const f32x4*)src + lane;
    f32x4 v[8]; float s = 0.f;
#pragma unroll
    for (int j = 0; j < 8; ++j) { v[j] = xr[64 * j]; s += (v[j].x + v[j].y) + (v[j].z + v[j].w); }
    const float mean = wave_sum(s) * (1.f / D); float s2 = 0.f;
#pragma unroll
    for (int j = 0; j < 8; ++j) { v[j] = v[j] - mean; s2 += (v[j].x * v[j].x + v[j].y * v[j].y) + (v[j].z * v[j].z + v[j].w * v[j].w); }
    const float rstd = 1.f / sqrtf(wave_sum(s2) * (1.f / D) + LN_EPS);
#pragma unroll
    for (int j = 0; j < 8; ++j) { const f32x4 gg = ((const f32x4*)g)[64 * j + lane], bb = ((const f32x4*)b)[64 * j + lane]; o[j] = v[j] * rstd * gg + bb; }
    if (dst32) {
#pragma unroll
        for (int j = 0; j < 8; ++j) ((f32x4*)dst32)[64 * j + lane] = o[j];
    }
    if (dstb) {
#pragma unroll
        for (int j = 0; j < 8; ++j) ((unsigned long long*)dstb)[64 * j + lane] = (unsigned long long)pk2(o[j].x, o[j].y) | ((unsigned long long)pk2(o[j].z, o[j].w) << 32);
    }
}

__device__ __forceinline__ void phase_prologue(Frame& F, const Args& a) {
    LAS float* scr = (LAS float*)(F.lds + F.wave * 16384);
    constexpr int N_IN = 32 * 182, N_OUT = 24 * 64, N_G1 = 32 * 16, N_D1 = 8 * 64, N_PG = 32 * 64, N_PP = 4 * 64;
    constexpr int PER_LAYER = N_IN + N_OUT + 16 * N_G1 * 2 + 16 * N_D1 + N_PG + N_PP;
    for (int it = F.gw; it < DEPTH * PER_LAYER; it += F.ngw) {
        const int L = it / PER_LAYER; int r = it % PER_LAYER;
        unsigned char* wl = F.ws + WS_W + (size_t)L * LW_STRIDE;
        if (r < N_IN) { transpose_item<1>(a.in[I_WIN] + (size_t)L * D * 5796, D, 5796, (bf16*)(wl + LW_IN), scr, r, F.lane); continue; } r -= N_IN;
        if (r < N_OUT) { transpose_item<0>(a.in[I_WOUT] + (size_t)L * MIXW * D, MIXW, D, (bf16*)(wl + LW_OUT), scr, r, F.lane); continue; } r -= N_OUT;
        if (r < 16 * N_G1) { const int e = r / N_G1; transpose_item<2>(a.in[I_WG] + ((size_t)L * NEXP + e) * D * EH, D, EH, (bf16*)(wl + LW_GU) + (size_t)e * 1024 * D, scr, r % N_G1, F.lane); continue; } r -= 16 * N_G1;
        if (r < 16 * N_G1) { const int e = r / N_G1; transpose_item<3>(a.in[I_WU] + ((size_t)L * NEXP + e) * D * EH, D, EH, (bf16*)(wl + LW_GU) + (size_t)e * 1024 * D, scr, r % N_G1, F.lane); continue; } r -= 16 * N_G1;
        if (r < 16 * N_D1) { const int e = r / N_D1; transpose_item<0>(a.in[I_WD] + ((size_t)L * NEXP + e) * EH * D, EH, D, (bf16*)(wl + LW_D) + (size_t)e * D * EH, scr, r % N_D1, F.lane); continue; } r -= 16 * N_D1;
        if (r < N_PG) { transpose_item<0>(a.in[I_PGW] + (size_t)L * D * D, D, D, (bf16*)(wl + LW_PG), scr, r, F.lane); continue; } r -= N_PG;
        transpose_item<0>(a.in[I_PP] + (size_t)L * PLE * D, PLE, D, (bf16*)(wl + LW_PP), scr, r, F.lane);
    }
    for (int i = F.gw * 64 + F.lane; i < DEPTH * 92 * (D / 8); i += F.ngw * 64) {
        const int L = i / (92 * (D / 8)), r = i % (92 * (D / 8));
        ((v4u*)(F.ws + WS_W + (size_t)L * LW_STRIDE + LW_IN + (size_t)5796 * D * 2))[r] = (v4u){0u, 0u, 0u, 0u};
    }
    { const f32x4* p4 = (const f32x4*)a.in[I_P]; unsigned long long* pb = (unsigned long long*)(F.ws + WS_PB);
      for (size_t i = (size_t)F.gw * 64 + F.lane; i < (size_t)DEPTH * T * PLE / 4; i += (size_t)F.ngw * 64) { const f32x4 v = p4[i]; pb[i] = (unsigned long long)pk2(v.x, v.y) | ((unsigned long long)pk2(v.z, v.w) << 32); } }
    { float* cs = (float*)(F.ws + WS_CS); const int* pos = (const int*)a.in[I_POS];
      for (int i = F.gw * 64 + F.lane; i < T * 8; i += F.ngw * 64) { const int t = i >> 3, j = i & 7;
          const float inv = expf((float)j * -1.6402954339981079f);
          const float ang = (float)pos[t] * inv;
          const double rev = (double)ang * 0.15915494309189535; const float fr = (float)(rev - floor(rev));
          cs[t * 16 + j] = __builtin_amdgcn_cosf(fr); cs[t * 16 + 8 + j] = __builtin_amdgcn_sinf(fr); } }
    for (int m = F.gw; m < T; m += F.ngw) { f32x4 o[8]; ln_row(a.in[I_X] + (size_t)m * D, a.in[I_LNG], a.in[I_LNB], (float*)(F.ws + WS_H32) + (size_t)m * D, (bf16*)(F.ws + WS_HB) + (size_t)m * D, F.lane, o); }
}

__device__ __forceinline__ bool rope_head(int hd) {
    const unsigned long long lo = 0xFFFFull | (0x7FFFull << 24) | (0x7ull << 42) | (0x7ull << 48) | (0x3FFull << 54), hi = 0x3FFFull;
    return hd < 64 ? ((lo >> hd) & 1ull) != 0ull : ((hi >> (hd - 64)) & 1ull) != 0ull;
}
struct EpiZ {
    static constexpr bool PERM = true;
    bf16* Z; const float* cs;
    __device__ __forceinline__ void operator()(const f32x4 (&acc)[2][2][4][2], const pg8::Unit& u, int wr, int wc, int fr, int fq) const {
        const int row0 = u.pm * 256 + wr * 64 + fr;
#pragma unroll
        for (int bj = 0; bj < 2; ++bj) {
            const int cb = u.pn * 256 + bj * 128 + wc * 32;
            const bool rp = ((wc & 1) == 0) && rope_head(cb >> 6);
#pragma unroll
            for (int ai = 0; ai < 2; ++ai)
#pragma unroll
                for (int m = 0; m < 4; ++m) {
                    const int row = row0 + ai * 128 + m * 16;
                    f32x4 v0 = acc[ai][bj][m][0], v1 = acc[ai][bj][m][1];
                    if (rp) {
                        f32x4 o0, o1;
#pragma unroll
                        for (int i = 0; i < 4; ++i) { o0[i] = __shfl_xor(v0[i], 16); o1[i] = __shfl_xor(v1[i], 16); }
                        const f32x4 c0 = *(const f32x4*)(cs + (size_t)row * 16), c1 = *(const f32x4*)(cs + (size_t)row * 16 + 4), s0 = *(const f32x4*)(cs + (size_t)row * 16 + 8), s1 = *(const f32x4*)(cs + (size_t)row * 16 + 12);
                        if (fq == 0) { v0 = v0 * c0 - o0 * s0; v1 = v1 * c1 - o1 * s1; }
                        else if (fq == 1) { v0 = v0 * c0 + o0 * s0; v1 = v1 * c1 + o1 * s1; }
                    }
                    v4u w; w.x = pg8::cvt_pk_bf16(v0[0], v0[1]); w.y = pg8::cvt_pk_bf16(v0[2], v0[3]); w.z = pg8::cvt_pk_bf16(v1[0], v1[1]); w.w = pg8::cvt_pk_bf16(v1[2], v1[3]);
                    *(v4u*)(Z + (size_t)row * ZP + cb + 8 * fq) = w;
                }
        }
    }
};
struct EpiRes {
    static constexpr bool PERM = false;
    const float* h; float* y;
    __device__ __forceinline__ void operator()(const f32x4 (&acc)[2][2][4][2], const pg8::Unit& u, int wr, int wc, int fr, int fq) const {
        const int row0 = u.pm * 256 + wr * 64 + fr, col0 = u.pn * 256 + wc * 32 + 4 * fq;
#pragma unroll
        for (int ai = 0; ai < 2; ++ai)
#pragma unroll
            for (int m = 0; m < 4; ++m) { const size_t off = (size_t)(row0 + ai * 128 + m * 16) * D + col0;
#pragma unroll
                for (int bj = 0; bj < 2; ++bj)
#pragma unroll
                    for (int n = 0; n < 2; ++n) { const size_t o = off + bj * 128 + n * 16; *(f32x4*)(y + o) = *(const f32x4*)(h + o) * ALPHA + acc[ai][bj][m][n]; } }
    }
};
struct EpiF32 {
    static constexpr bool PERM = false;
    float* C;
    __device__ __forceinline__ void operator()(const f32x4 (&acc)[2][2][4][2], const pg8::Unit& u, int wr, int wc, int fr, int fq) const {
        const int row0 = u.pm * 256 + wr * 64 + fr, col0 = u.pn * 256 + wc * 32 + 4 * fq;
#pragma unroll
        for (int ai = 0; ai < 2; ++ai)
#pragma unroll
            for (int m = 0; m < 4; ++m) { const size_t off = (size_t)(row0 + ai * 128 + m * 16) * D + col0;
#pragma unroll
                for (int bj = 0; bj < 2; ++bj)
#pragma unroll
                    for (int n = 0; n < 2; ++n) *(f32x4*)(C + off + bj * 128 + n * 16) = acc[ai][bj][m][n]; }
    }
};
struct EpiPle {
    static constexpr bool PERM = false;
    const float* h; const float* P; const float* bias; float* y2;
    __device__ __forceinline__ void operator()(const f32x4 (&acc)[2][2][4][2], const pg8::Unit& u, int wr, int wc, int fr, int fq) const {
        const int row0 = u.pm * 256 + wr * 64 + fr, col0 = u.pn * 256 + wc * 32 + 4 * fq;
#pragma unroll
        for (int bj = 0; bj < 2; ++bj)
#pragma unroll
            for (int n = 0; n < 2; ++n) { const f32x4 bv = *(const f32x4*)(bias + col0 + bj * 128 + n * 16);
#pragma unroll
                for (int ai = 0; ai < 2; ++ai)
#pragma unroll
                    for (int m = 0; m < 4; ++m) { const size_t o = (size_t)(row0 + ai * 128 + m * 16) * D + col0 + bj * 128 + n * 16;
                        const f32x4 x = acc[ai][bj][m][n] + bv; f32x4 sg;
#pragma unroll
                        for (int i = 0; i < 4; ++i) sg[i] = __builtin_amdgcn_rcpf(1.f + __expf(-x[i]));
                        *(f32x4*)(y2 + o) = *(const f32x4*)(h + o) * ALPHA + sg * *(const f32x4*)(P + o); } }
    }
};
struct EpiGU {
    static constexpr bool PERM = true;
    bf16* hid; const float* pw;
    __device__ __forceinline__ void operator()(const f32x4 (&acc)[2][2][4][2], const pg8::Unit& u, int wr, int wc, int fr, int fq) const {
        const int slot = u.aux, row0 = u.pm * 256 + wr * 64 + fr, cb = slot * 512 + u.pn * 128 + wc * 32 + 8 * fq;
#pragma unroll
        for (int ai = 0; ai < 2; ++ai)
#pragma unroll
            for (int m = 0; m < 4; ++m) { const int prow = row0 + ai * 128 + m * 16; const float w = pw[prow * 2 + slot];
                float r[8];
#pragma unroll
                for (int n = 0; n < 2; ++n)
#pragma unroll
                    for (int i = 0; i < 4; ++i) { const float g = acc[ai][0][m][n][i], up = acc[ai][1][m][n][i]; r[n * 4 + i] = g * __builtin_amdgcn_rcpf(1.f + __expf(-g)) * up * w; }
                v4u o; o.x = pg8::cvt_pk_bf16(r[0], r[1]); o.y = pg8::cvt_pk_bf16(r[2], r[3]); o.z = pg8::cvt_pk_bf16(r[4], r[5]); o.w = pg8::cvt_pk_bf16(r[6], r[7]);
                *(v4u*)(hid + (size_t)prow * 1024 + cb) = o; }
    }
};
struct EpiDown {
    static constexpr bool PERM = false;
    float* y2; const int* ptok;
    __device__ __forceinline__ void operator()(const f32x4 (&acc)[2][2][4][2], const pg8::Unit& u, int wr, int wc, int fr, int fq) const {
        const int row0 = u.pm * 256 + wr * 64 + fr, col0 = u.pn * 256 + wc * 32 + 4 * fq;
#pragma unroll
        for (int ai = 0; ai < 2; ++ai)
#pragma unroll
            for (int m = 0; m < 4; ++m) { const int tok = ptok[row0 + ai * 128 + m * 16];
                if (tok >= 0) { const size_t off = (size_t)tok * D + col0;
#pragma unroll
                    for (int bj = 0; bj < 2; ++bj)
#pragma unroll
                        for (int n = 0; n < 2; ++n) { float* p = y2 + off + bj * 128 + n * 16; *(f32x4*)p = *(const f32x4*)p + acc[ai][bj][m][n]; } } }
    }
};
struct SchedGU {
    const char* xp; const char* wgu; const volatile LAS int* tab; int G, c, ntiles;
    __device__ __forceinline__ bool next(int i, pg8::Unit& u) const {
        const int L = i * G + c; if (L >= ntiles * 8) return false;
        const int tile = L >> 3, pn = L & 7, cls = __builtin_amdgcn_readfirstlane(tab[tile]), g = cls / 6, pi = cls % 6;
        const int ea = 4 * g + (pi < 3 ? 0 : (pi < 5 ? 1 : 2)), eb = 4 * g + (pi == 0 ? 1 : ((pi == 1 || pi == 3) ? 2 : 3));
        const int slot = pn >> 2, j = pn & 3, e = slot ? eb : ea;
        u.pm = tile; u.pn = j; u.aux = slot; u.A = xp + (size_t)tile * 256 * D * 2; u.B = wgu + ((size_t)e * 1024 + (size_t)j * 256) * D * 2; u.B2 = u.B; return true;
    }
};
struct SchedDown {
    const char* hid; const char* wd; const volatile LAS int* tab; int G, c, ntiles;
    __device__ __forceinline__ bool next(int i, pg8::Unit& u) const {
        const int L = i * G + c; if (L >= ntiles * 8) return false;
        const int tile = L >> 3, pn = L & 7, cls = __builtin_amdgcn_readfirstlane(tab[tile]), g = cls / 6, pi = cls % 6;
        const int ea = 4 * g + (pi < 3 ? 0 : (pi < 5 ? 1 : 2)), eb = 4 * g + (pi == 0 ? 1 : ((pi == 1 || pi == 3) ? 2 : 3));
        u.pm = tile; u.pn = pn; u.aux = 0; u.A = hid + (size_t)tile * 256 * 1024 * 2;
        u.B = wd + ((size_t)ea * D + (size_t)pn * 256) * EH * 2; u.B2 = wd + ((size_t)eb * D + (size_t)pn * 256) * EH * 2; return true;
    }
};

__device__ __forceinline__ void load_row64(const bf16* p, float (&q)[64]) {
    const v4u* pp = (const v4u*)p;
#pragma unroll
    for (int c = 0; c < 8; ++c) { const v4u u = pp[c]; q[8 * c + 0] = bf_lo(u.x); q[8 * c + 1] = bf_hi(u.x); q[8 * c + 2] = bf_lo(u.y); q[8 * c + 3] = bf_hi(u.y);
        q[8 * c + 4] = bf_lo(u.z); q[8 * c + 5] = bf_hi(u.z); q[8 * c + 6] = bf_lo(u.w); q[8 * c + 7] = bf_hi(u.w); }
}
__device__ __forceinline__ float dot_row64(const float (&q)[64], const bf16* p) {
    const v4u* pp = (const v4u*)p; float s0 = 0.f, s1 = 0.f, s2 = 0.f, s3 = 0.f;
#pragma unroll
    for (int c = 0; c < 8; ++c) { const v4u u = pp[c];
        s0 += q[8 * c + 0] * bf_lo(u.x) + q[8 * c + 1] * bf_hi(u.x); s1 += q[8 * c + 2] * bf_lo(u.y) + q[8 * c + 3] * bf_hi(u.y);
        s2 += q[8 * c + 4] * bf_lo(u.z) + q[8 * c + 5] * bf_hi(u.z); s3 += q[8 * c + 6] * bf_lo(u.w) + q[8 * c + 7] * bf_hi(u.w); }
    return (s0 + s1) + (s2 + s3);
}
struct WAcc { float m, l; float a[64]; };
__device__ __forceinline__ void wacc_init(WAcc& A) { A.m = -1e30f; A.l = 0.f;
#pragma unroll
    for (int d = 0; d < 64; ++d) A.a[d] = 0.f; }
__device__ __forceinline__ void wacc_key(WAcc& A, float s2, const bf16* vrow) {
    const float mn = fmaxf(A.m, s2), f = ex2(A.m - mn), p = ex2(s2 - mn); A.m = mn; A.l = A.l * f + p;
    const v4u* pp = (const v4u*)vrow;
#pragma unroll
    for (int c = 0; c < 8; ++c) { const v4u u = pp[c];
        A.a[8 * c + 0] = A.a[8 * c + 0] * f + p * bf_lo(u.x); A.a[8 * c + 1] = A.a[8 * c + 1] * f + p * bf_hi(u.x);
        A.a[8 * c + 2] = A.a[8 * c + 2] * f + p * bf_lo(u.y); A.a[8 * c + 3] = A.a[8 * c + 3] * f + p * bf_hi(u.y);
        A.a[8 * c + 4] = A.a[8 * c + 4] * f + p * bf_lo(u.z); A.a[8 * c + 5] = A.a[8 * c + 5] * f + p * bf_hi(u.z);
        A.a[8 * c + 6] = A.a[8 * c + 6] * f + p * bf_lo(u.w); A.a[8 * c + 7] = A.a[8 * c + 7] * f + p * bf_hi(u.w); }
}
__device__ __forceinline__ float wacc_finish(WAcc& A, int lane, float& lse2) {
    const float M = wave_max(A.m), f = ex2(A.m - M), L = wave_sum(A.l * f);
#pragma unroll
    for (int d = 0; d < 64; ++d) A.a[d] *= f;
    reduce_scatter64(A.a, lane);
    lse2 = M + __log2f(L);
    return L > 0.f ? A.a[0] / L : 0.f;
}

__device__ __forceinline__ void phase_kmean(Frame& F) {
    const bf16* z = (const bf16*)(F.ws + WS_Z); float* km = (float*)(F.ws + WS_KMEAN); LAS float* red = (LAS float*)F.lds;
    for (int it = F.bx; it < 256; it += F.G) {
        const int b = it >> 7, h = (it >> 4) & 7, blk = it & 15, d = F.tid & 63, part = F.tid >> 6;
        const bf16* p = z + ((size_t)b * SEQ + blk * 256 + part * 32) * ZP + KA + h * 64 + d; float s = 0.f;
        for (int k = 0; k < 32; ++k) s += bf1(p[(size_t)k * ZP]);
        red[part * 64 + d] = s; __syncthreads();
        if (F.tid < 64) { float t = 0.f;
#pragma unroll
            for (int q = 0; q < 8; ++q) t += red[q * 64 + d];
            km[(size_t)it * 64 + d] = t * (1.f / 256.f); }
        __syncthreads();
    }
}
__device__ __forceinline__ float gelu_tanh(float x) { const float u = 0.7978845608028654f * (x + 0.044715f * x * x * x); const float e = __expf(2.f * u); const float th = 1.f - 2.f / (e + 1.f); return 0.5f * x * (1.f + th); }
__device__ __forceinline__ void phase_compress(Frame& F, const Args& a, int L) {
    const bf16* z = (const bf16*)(F.ws + WS_Z); LAS float* hs = (LAS float*)(F.lds + 65536) + F.wave * 1024;
    for (int it = F.gw; it < 384; it += F.ngw) {
        const int ng = it & 31, kv = (it >> 5) & 1, bh = it >> 6, b = bh / 3, hk = bh % 3, n0 = ng * 8, lane = F.lane;
        const float* W1 = a.in[kv ? I_CV1 : I_CK1] + (size_t)L * 2048 * 128; const float* W2 = a.in[kv ? I_CV2 : I_CK2] + (size_t)L * 128 * 64; const float* pe = a.in[kv ? I_PEV : I_PEK] + (size_t)L * 2048;
        const bf16* src = z + (size_t)b * SEQ * ZP + (kv ? VBC : KBC) + hk * 64;
        float h0[8], h1[8];
#pragma unroll
        for (int r = 0; r < 8; ++r) { h0[r] = 0.f; h1[r] = 0.f; }
        for (int j = 0; j < 32; ++j) {
#pragma unroll 4
            for (int d = 0; d < 64; ++d) { const int idx = j * 64 + d; const float w0 = W1[(size_t)idx * 128 + lane], w1 = W1[(size_t)idx * 128 + 64 + lane], pv = pe[idx];
#pragma unroll
                for (int r = 0; r < 8; ++r) { const int n = (n0 + r) < 255 ? (n0 + r) : 254; const float x = bf1(src[(size_t)(16 * n + j) * ZP + d]) + pv; h0[r] += x * w0; h1[r] += x * w1; } }
        }
#pragma unroll
        for (int r = 0; r < 8; ++r) { hs[r * 128 + lane] = gelu_tanh(h0[r]); hs[r * 128 + 64 + lane] = gelu_tanh(h1[r]); }
        LDS_WAIT(); asm volatile("" ::: "memory");
        float o[8];
#pragma unroll
        for (int r = 0; r < 8; ++r) o[r] = 0.f;
        for (int c = 0; c < 128; ++c) { const float w = W2[c * 64 + lane];
#pragma unroll
            for (int r = 0; r < 8; ++r) o[r] += hs[r * 128 + c] * w; }
        bf16* dst = (bf16*)(F.ws + (kv ? WS_VCMP : WS_KCMP)) + ((size_t)(b * 3 + hk) * 256) * 64;
#pragma unroll
        for (int r = 0; r < 8; ++r) if (n0 + r < 255) dst[(size_t)(n0 + r) * 64 + lane] = (bf16)f2bf(o[r]); else dst[(size_t)255 * 64 + lane] = 0;
        LDS_WAIT(); asm volatile("" ::: "memory");
    }
}
__device__ __forceinline__ void phase_dilated(Frame& F) {
    const bf16* z = (const bf16*)(F.ws + WS_Z); bf16* mix = (bf16*)(F.ws + WS_MIX); const int lane = F.lane;
    for (int it = F.gw; it < T * 4; it += F.ngw) {
        const int t = it >> 2, j = it & 3, b = t / SEQ, s = t % SEQ;
        float og[3], ls[3];
#pragma unroll
        for (int gi = 0; gi < 3; ++gi) {
            const int dil = gi == 0 ? 1 : (gi == 1 ? 4 : 16), head = gi * 4 + j;
            float q[64]; load_row64(z + (size_t)t * ZP + QC + head * 64, q);
            WAcc A; wacc_init(A);
            for (int k = lane; k <= 128; k += 64) { const int sk = s - k * dil;
                if (sk >= 0) { const bf16* kr = z + ((size_t)b * SEQ + sk) * ZP; const float sc = dot_row64(q, kr + KC + head * 64) * SC2; wacc_key(A, sc, kr + VC + head * 64); } }
            og[gi] = wacc_finish(A, lane, ls[gi]);
        }
        const float mx = fmaxf(ls[0], fmaxf(ls[1], ls[2])); const float w0 = ex2(ls[0] - mx), w1 = ex2(ls[1] - mx), w2 = ex2(ls[2] - mx);
        mix[(size_t)t * MIXW + 1280 + j * 64 + lane] = (bf16)f2bf((w0 * og[0] + w1 * og[1] + w2 * og[2]) / (w0 + w1 + w2));
    }
}
__device__ __forceinline__ void phase_moba(Frame& F) {
    const bf16* z = (const bf16*)(F.ws + WS_Z); bf16* mix = (bf16*)(F.ws + WS_MIX); const float* km = (const float*)(F.ws + WS_KMEAN); const int lane = F.lane;
    for (int it = F.gw; it < T * 8; it += F.ngw) {
        const int t = it >> 3, h = it & 7, b = t / SEQ, s = t % SEQ, cur = s >> 8;
        float q[64]; load_row64(z + (size_t)t * ZP + QA + h * 64, q);
        float gate = -1e30f;
        if (lane < cur) { const float* kmr = km + ((size_t)(b * 8 + h) * 16 + lane) * 64; float g = 0.f;
#pragma unroll
            for (int d = 0; d < 64; ++d) g += q[d] * kmr[d];
            gate = g; }
        int rank = 0;
        for (int jj = 0; jj < 16; ++jj) { const float gj = __shfl(gate, jj); rank += (gj > gate || (gj == gate && jj < lane)) ? 1 : 0; }
        const unsigned long long selm = __ballot(lane < cur && rank < 3);
        WAcc A; wacc_init(A);
        unsigned long long mm = selm;
        while (mm) { const int blk = __builtin_ctzll(mm); mm &= mm - 1;
            for (int i = 0; i < 4; ++i) { const bf16* kr = z + ((size_t)b * SEQ + blk * 256 + i * 64 + lane) * ZP; const float sc = dot_row64(q, kr + KA + h * 64) * SC2; wacc_key(A, sc, kr + VA + h * 64); } }
        for (int i = 0; i < 4; ++i) { const int sk = cur * 256 + i * 64 + lane;
            if (sk <= s) { const bf16* kr = z + ((size_t)b * SEQ + sk) * ZP; const float sc = dot_row64(q, kr + KA + h * 64) * SC2; wacc_key(A, sc, kr + VA + h * 64); } }
        float l2; const float o = wacc_finish(A, lane, l2);
        mix[(size_t)t * MIXW + h * 64 + lane] = (bf16)f2bf(o);
    }
}
__device__ __forceinline__ void phase_nsa(Frame& F) {
    const bf16* z = (const bf16*)(F.ws + WS_Z); bf16* mix = (bf16*)(F.ws + WS_MIX); const int lane = F.lane;
    LAS float* ps = (LAS float*)F.lds + F.wave * 320;
    for (int it = F.gw; it < T * 3; it += F.ngw) {
        const int t = it / 3, hk = it % 3, b = t / SEQ, s = t % SEQ, cur = s >> 6;
        const bf16* kc = (const bf16*)(F.ws + WS_KCMP) + ((size_t)(b * 3 + hk) * 256) * 64; const bf16* vc = (const bf16*)(F.ws + WS_VCMP) + ((size_t)(b * 3 + hk) * 256) * 64;
        const int ncv = s >= 31 ? ((s - 31) >> 4) + 1 : 0;
        float psum[4] = {0.f, 0.f, 0.f, 0.f}; float ocmp[4];
#pragma unroll
        for (int g = 0; g < 4; ++g) {
            float q[64]; load_row64(z + (size_t)t * ZP + QB + (hk * 4 + g) * 64, q);
            float sc[4]; float mx = -1e30f;
#pragma unroll
            for (int i = 0; i < 4; ++i) { const int n = lane + 64 * i; sc[i] = n < ncv ? dot_row64(q, kc + (size_t)n * 64) * SC2 : -1e30f; mx = fmaxf(mx, sc[i]); }
            mx = wave_max(mx); float p[4]; float ls = 0.f;
#pragma unroll
            for (int i = 0; i < 4; ++i) { const int n = lane + 64 * i; p[i] = n < ncv ? ex2(sc[i] - mx) : 0.f; ls += p[i]; }
            ls = wave_sum(ls); const float inv = ls > 0.f ? 1.f / ls : 0.f;
            float acc[64];
#pragma unroll
            for (int d = 0; d < 64; ++d) acc[d] = 0.f;
#pragma unroll
            for (int i = 0; i < 4; ++i) { const int n = lane + 64 * i; p[i] *= inv; psum[i] += p[i];
                if (n < ncv) { const v4u* pp = (const v4u*)(vc + (size_t)n * 64);
#pragma unroll
                    for (int c = 0; c < 8; ++c) { const v4u u = pp[c]; acc[8 * c + 0] += p[i] * bf_lo(u.x); acc[8 * c + 1] += p[i] * bf_hi(u.x); acc[8 * c + 2] += p[i] * bf_lo(u.y); acc[8 * c + 3] += p[i] * bf_hi(u.y);
                        acc[8 * c + 4] += p[i] * bf_lo(u.z); acc[8 * c + 5] += p[i] * bf_hi(u.z); acc[8 * c + 6] += p[i] * bf_lo(u.w); acc[8 * c + 7] += p[i] * bf_hi(u.w); } } }
            reduce_scatter64(acc, lane); ocmp[g] = acc[0];
        }
#pragma unroll
        for (int i = 0; i < 4; ++i) ps[lane + 64 * i] = (lane + 64 * i) < 255 ? psum[i] : 0.f;
        LDS_WAIT(); asm volatile("" ::: "memory");
        float imp = ps[4 * lane] + ps[4 * lane + 1] + ps[4 * lane + 2] + ps[4 * lane + 3]; if (lane > 0) imp += ps[4 * lane - 1];
        LDS_WAIT(); asm volatile("" ::: "memory");
        const bool valid = lane <= cur, forced = valid && (lane == 0 || lane > cur - 2);
        const float val = forced ? 1e30f : (valid ? imp : -1e30f);
        int rank = 0;
        for (int jj = 0; jj < 64; ++jj) { const float vj = __shfl(val, jj); rank += (vj > val || (vj == val && jj < lane)) ? 1 : 0; }
        const unsigned long long selm = __ballot(valid && rank < 16);
#pragma unroll
        for (int g = 0; g < 4; ++g) {
            const int head = hk * 4 + g;
            float q[64]; load_row64(z + (size_t)t * ZP + QB + head * 64, q);
            WAcc A; wacc_init(A);
            unsigned long long mm = selm;
            while (mm) { const int blk = __builtin_ctzll(mm); mm &= mm - 1; const int sk = blk * 64 + lane;
                if (sk <= s) { const bf16* kr = z + ((size_t)b * SEQ + sk) * ZP; const float scv = dot_row64(q, kr + KBS + hk * 64) * SC2; wacc_key(A, scv, kr + VBS + hk * 64); } }
            float l2; const float oslc = wacc_finish(A, lane, l2);
            wacc_init(A);
            for (int i = 0; i < 8; ++i) { const int sk = s - 511 + i * 64 + lane;
                if (sk >= 0) { const bf16* kr = z + ((size_t)b * SEQ + sk) * ZP; const float scv = dot_row64(q, kr + KBW + hk * 64) * SC2; wacc_key(A, scv, kr + VBW + hk * 64); } }
            const float owin = wacc_finish(A, lane, l2);
            const bf16* gp = z + (size_t)t * ZP + GB + head * 3;
            const float g0 = 1.f / (1.f + __expf(-bf1(gp[0]))), g1 = 1.f / (1.f + __expf(-bf1(gp[1]))), g2 = 1.f / (1.f + __expf(-bf1(gp[2])));
            mix[(size_t)t * MIXW + 512 + head * 64 + lane] = (bf16)f2bf(g0 * ocmp[g] + g1 * oslc + g2 * owin);
        }
    }
}

__device__ __forceinline__ void load_router(Frame& F, const float* rw) {
    LAS float* rwt = (LAS float*)F.lds;
    for (int i = F.tid; i < 8192; i += 512) { const f32x4 v = ((const f32x4*)rw)[i]; const int k = i >> 2, e0 = (i & 3) * 4; rwt[(e0 + 0) * 2048 + k] = v.x; rwt[(e0 + 1) * 2048 + k] = v.y; rwt[(e0 + 2) * 2048 + k] = v.z; rwt[(e0 + 3) * 2048 + k] = v.w; }
    __syncthreads();
}
__device__ __forceinline__ void phase_ln1_router(Frame& F, const Args& a, int L) {
    load_router(F, a.in[I_RW]);
    const LAS f32x4* rwt4 = (const LAS f32x4*)F.lds; const int lane = F.lane;
    const float* y = (const float*)(F.ws + WS_Y); float* h32 = (float*)(F.ws + WS_H32); bf16* hb = (bf16*)(F.ws + WS_HB);
    int* tokc = (int*)(F.ws + WS_TOKC); int* toks = (int*)(F.ws + WS_TOKS); float* tokw = (float*)(F.ws + WS_TOKW);
    unsigned* cnt = (unsigned*)(F.ws + WS_CTL) + CW_CNT + L * 32;
    for (int m = F.gw; m < T; m += F.ngw) {
        f32x4 o[8]; ln_row(y + (size_t)m * D, a.in[I_LN1G] + (size_t)L * D, a.in[I_LN1B] + (size_t)L * D, h32 + (size_t)m * D, hb + (size_t)m * D, lane, o);
        float myl = 0.f;
#pragma unroll 1
        for (int e = 0; e < 16; ++e) { float s = 0.f;
#pragma unroll
            for (int j = 0; j < 8; ++j) { const f32x4 w = rwt4[e * 512 + j * 64 + lane]; s += (o[j].x * w.x + o[j].y * w.y) + (o[j].z * w.z + o[j].w * w.w); }
            s = wave_sum(s); if (lane == e) myl = s; }
        if (lane < 16) myl += a.in[I_RB][lane];
        float pe[16]; float mx = -1e30f;
#pragma unroll
        for (int e = 0; e < 16; ++e) { pe[e] = __shfl(myl, e); mx = fmaxf(mx, pe[e]); }
#pragma unroll
        for (int e = 0; e < 16; ++e) pe[e] = expf(pe[e] - mx);
        int gsel = 0; float gbest = -1.f; int i1s = 0, i2s = 1; float p1s = 0.f, p2s = 0.f;
#pragma unroll
        for (int g = 0; g < 4; ++g) {
            int i1 = 0; float p1 = pe[4 * g];
#pragma unroll
            for (int i = 1; i < 4; ++i) if (pe[4 * g + i] > p1) { p1 = pe[4 * g + i]; i1 = i; }
            int i2 = -1; float p2 = -1.f;
#pragma unroll
            for (int i = 0; i < 4; ++i) if (i != i1 && pe[4 * g + i] > p2) { p2 = pe[4 * g + i]; i2 = i; }
            const float sg = p1 + p2;
            if (sg > gbest) { gbest = sg; gsel = g; i1s = i1; i2s = i2; p1s = p1; p2s = p2; }
        }
        const int lo = i1s < i2s ? i1s : i2s, hi = i1s < i2s ? i2s : i1s;
        const float wlo = (i1s < i2s ? p1s : p2s) / (p1s + p2s), whi = (i1s < i2s ? p2s : p1s) / (p1s + p2s);
        const int pi = lo == 0 ? hi - 1 : (lo == 1 ? hi + 1 : 5);
        const int cls = gsel * 6 + pi;
        if (lane == 0) { const unsigned slot = __hip_atomic_fetch_add(cnt + cls, 1u, __ATOMIC_RELAXED, __HIP_MEMORY_SCOPE_AGENT); tokc[m] = cls; toks[m] = (int)slot; tokw[2 * m] = wlo; tokw[2 * m + 1] = whi; }
    }
    __syncthreads();
}
__device__ __forceinline__ void build_tiles(Frame& F, int L) {
    volatile LAS int* tab = (volatile LAS int*)(F.lds + TILE_OFF);
    if (F.tid == 0) { const unsigned* cnt = (const unsigned*)(F.ws + WS_CTL) + CW_CNT + L * 32; int off = 0, nt = 0;
        for (int c = 0; c < 24; ++c) { const int n = (int)cnt[c]; tab[64 + c] = off; const int k = (n + 255) >> 8; for (int i = 0; i < k && nt < MAXTILES; ++i) tab[nt++] = c; off += k * 256; }
        tab[64 + 24] = off; tab[96] = nt; }
    __syncthreads();
}
__device__ __forceinline__ void phase_gather(Frame& F, int L) {
    volatile LAS int* tab = (volatile LAS int*)(F.lds + TILE_OFF);
    const int* tokc = (const int*)(F.ws + WS_TOKC); const int* toks = (const int*)(F.ws + WS_TOKS); const float* tokw = (const float*)(F.ws + WS_TOKW);
    int* ptok = (int*)(F.ws + WS_PTOK); float* pw = (float*)(F.ws + WS_PW); const v4u* hb = (const v4u*)(F.ws + WS_HB); v4u* xp = (v4u*)(F.ws + WS_XP);
    const unsigned* cnt = (const unsigned*)(F.ws + WS_CTL) + CW_CNT + L * 32;
    if (F.bx < 24) { const int c = F.bx; const int lo = tab[64 + c] + (int)cnt[c], hi = tab[64 + c + 1]; for (int r = lo + F.tid; r < hi; r += 512) ptok[r] = -1; }
    for (int t = F.gw; t < T; t += F.ngw) {
        const int pos = tab[64 + tokc[t]] + toks[t];
#pragma unroll
        for (int j = 0; j < 4; ++j) xp[(size_t)pos * 256 + j * 64 + F.lane] = hb[(size_t)t * 256 + j * 64 + F.lane];
        if (F.lane == 0) { ptok[pos] = t; pw[2 * pos] = tokw[2 * t]; pw[2 * pos + 1] = tokw[2 * t + 1]; }
    }
}

constexpr int NPH_LAYER = 9, NPH = 1 + DEPTH * NPH_LAYER;
__global__ void __launch_bounds__(512, 2) fwd(Args args) {
    extern __shared__ __attribute__((aligned(16))) unsigned char lds[];
    const int wave0 = __builtin_amdgcn_readfirstlane(threadIdx.x >> 6);
#define MKFRAME(F) Frame F; { int w_ = wave0; asm volatile("" : "+s"(w_)); int l_; asm volatile("v_mbcnt_lo_u32_b32 %0, -1, 0\n\tv_mbcnt_hi_u32_b32 %0, -1, %0" : "=v"(l_)); int t_ = w_ * 64 + l_; F.lds = (LAS unsigned char*)lds; F.tid = t_; F.lane = t_ & 63; F.wave = __builtin_amdgcn_readfirstlane(t_ >> 6); \
    int g_ = gridDim.x, b_ = blockIdx.x; asm volatile("" : "+s"(g_), "+s"(b_)); F.G = g_; F.bx = b_; F.gw = b_ * 8 + F.wave; F.ngw = g_ * 8; F.ws = args.ws; }
    MKFRAME(F);
    for (int u = F.tid; u < (LDS_BYTES - LDSCTL_OFF) / 4; u += 512) ((LAS unsigned*)(F.lds + LDSCTL_OFF))[u] = 0u;
    __syncthreads();
    volatile LAS unsigned* MISC = (volatile LAS unsigned*)(F.lds + MISC_OFF);
    XcdBarrier bar; bar.bar = (unsigned*)(F.ws + WS_CTL) + CW_BAR; bar.x = xb_xcc_id(); bar.st = MISC + 8;
    const int lo = args.ph_lo, hi = args.ph_hi;
    if (hi - lo > 1 && F.tid == 0) (void)xb_add(&bar.bar[XB_XCNT(bar.x)], 1u);
#ifndef PH_MASK
#define PH_MASK 0x3ff
#endif
#define IN(k) (lo <= (k) && (k) < hi)
#define EN(b) ((PH_MASK >> (b)) & 1)
#define SEAM(k) do { if (IN((k) + 1)) { MKFRAME(Fb_); xcd_barrier(bar, Fb_.tid); } } while (0)
    PG8_LAS unsigned char* ring = (PG8_LAS unsigned char*)lds;

    if (EN(9) && IN(0)) { MKFRAME(F0); phase_prologue(F0, args); SEAM(0); }

    for (int L = 0; L < DEPTH; ++L) {
        const int p0 = 1 + L * NPH_LAYER;
        unsigned char* wl = args.ws + WS_W + (size_t)L * LW_STRIDE;
        if (EN(0) && IN(p0 + 0)) {
            MKFRAME(F);
            pg8::SchedDense S; S.A = (const char*)(F.ws + WS_HB); S.Bt = (const char*)(wl + LW_IN); S.tA = (size_t)256 * D * 2; S.tB = (size_t)256 * D * 2; S.so.init(T, ZP, F.G, F.bx);
            EpiZ E{(bf16*)(F.ws + WS_Z), (const float*)(F.ws + WS_CS)};
            pg8::gemm_phase<EpiZ, pg8::SchedDense, true>(ring, F.tid, D, D, D / 64, D / 64, S, E);
            SEAM(p0 + 0);
        }
        if (EN(1) && IN(p0 + 1)) { { MKFRAME(F1); phase_kmean(F1); } { MKFRAME(F1); phase_compress(F1, args, L); } { MKFRAME(F1); phase_dilated(F1); } SEAM(p0 + 1); }
        if (EN(2) && IN(p0 + 2)) { { MKFRAME(F2); phase_moba(F2); } { MKFRAME(F2); phase_nsa(F2); } SEAM(p0 + 2); }
        if (EN(3) && IN(p0 + 3)) {
            MKFRAME(F);
            pg8::SchedDense S; S.A = (const char*)(F.ws + WS_MIX); S.Bt = (const char*)(wl + LW_OUT); S.tA = (size_t)256 * MIXW * 2; S.tB = (size_t)256 * MIXW * 2; S.so.init(T, D, F.G, F.bx);
            EpiRes E{(const float*)(F.ws + WS_H32), (float*)(F.ws + WS_Y)};
            pg8::gemm_phase<EpiRes, pg8::SchedDense, false>(ring, F.tid, MIXW, MIXW, MIXW / 64, MIXW / 64, S, E);
            SEAM(p0 + 3);
        }
        if (EN(4) && IN(p0 + 4)) { MKFRAME(F4); phase_ln1_router(F4, args, L); SEAM(p0 + 4); }
        if (EN(5) && IN(p0 + 5)) {
            { MKFRAME(F5); build_tiles(F5, L); phase_gather(F5, L); } __syncthreads();
            { MKFRAME(F); pg8::SchedDense S; S.A = (const char*)(F.ws + WS_PB) + (size_t)L * T * PLE * 2; S.Bt = (const char*)(wl + LW_PP); S.tA = (size_t)256 * PLE * 2; S.tB = (size_t)256 * PLE * 2; S.so.init(T, D, F.G, F.bx);
              EpiF32 E{(float*)(F.ws + WS_PPLE)};
              pg8::gemm_phase<EpiF32, pg8::SchedDense, false>(ring, F.tid, PLE, PLE, PLE / 64, PLE / 64, S, E); }
            { MKFRAME(F); pg8::SchedDense S; S.A = (const char*)(F.ws + WS_HB); S.Bt = (const char*)(wl + LW_PG); S.tA = (size_t)256 * D * 2; S.tB = (size_t)256 * D * 2; S.so.init(T, D, F.G, F.bx);
              EpiPle E{(const float*)(F.ws + WS_H32), (const float*)(F.ws + WS_PPLE), args.in[I_PGB] + (size_t)L * D, (float*)(F.ws + WS_Y)};
              pg8::gemm_phase<EpiPle, pg8::SchedDense, false>(ring, F.tid, D, D, D / 64, D / 64, S, E); }
            SEAM(p0 + 5);
        }
        if (EN(6) && IN(p0 + 6)) {
            MKFRAME(F); build_tiles(F, L);
            const volatile LAS int* tab = (const volatile LAS int*)(F.lds + TILE_OFF);
            SchedGU S{(const char*)(F.ws + WS_XP), (const char*)(wl + LW_GU), tab, F.G, F.bx, __builtin_amdgcn_readfirstlane(tab[96])};
            EpiGU E{(bf16*)(F.ws + WS_HID), (const float*)(F.ws + WS_PW)};
            pg8::gemm_phase<EpiGU, SchedGU, true>(ring, F.tid, D, D, D / 64, D / 64, S, E);
            SEAM(p0 + 6);
        }
        if (EN(7) && IN(p0 + 7)) {
            MKFRAME(F); build_tiles(F, L);
            const volatile LAS int* tab = (const volatile LAS int*)(F.lds + TILE_OFF);
            SchedDown S{(const char*)(F.ws + WS_HID), (const char*)(wl + LW_D), tab, F.G, F.bx, __builtin_amdgcn_readfirstlane(tab[96])};
            EpiDown E{(float*)(F.ws + WS_Y), (const int*)(F.ws + WS_PTOK)};
            pg8::gemm_phase<EpiDown, SchedDown, false>(ring, F.tid, 1024, EH, 16, 8, S, E);
            SEAM(p0 + 7);
        }
        if (EN(8) && IN(p0 + 8)) {
            const bool lastL = (L == DEPTH - 1); MKFRAME(F);
            for (int m = F.gw; m < T; m += F.ngw) { f32x4 o[8];
                ln_row((const float*)(F.ws + WS_Y) + (size_t)m * D, args.in[I_LN2G] + (size_t)L * D, args.in[I_LN2B] + (size_t)L * D,
                       lastL ? args.out + (size_t)m * D : (float*)(F.ws + WS_H32) + (size_t)m * D, lastL ? (bf16*)nullptr : (bf16*)(F.ws + WS_HB) + (size_t)m * D, F.lane, o); }
            SEAM(p0 + 8);
        }
    }
#undef IN
#undef SEAM
}

extern "C" void kernel_launch(void* const* d_in, const int* in_sizes, int n_in, void* d_out, int out_size, void* d_ws, size_t ws_size, hipStream_t stream) {
    static int grid = 0;
    if (grid == 0) {
        if (n_in != 25 || ws_size < WS_END) { fprintf(stderr, "kernel_launch: unexpected n_in %d / ws %zu\n", n_in, ws_size); grid = -1; return; }
        int dev = 0, cus = 0;
        if (hipGetDevice(&dev) != hipSuccess || hipDeviceGetAttribute(&cus, hipDeviceAttributeMultiprocessorCount, dev) != hipSuccess) { grid = -1; return; }
        if (hipFuncSetAttribute((const void*)fwd, hipFuncAttributeMaxDynamicSharedMemorySize, LDS_BYTES) != hipSuccess) { fprintf(stderr, "kernel_launch: hipFuncSetAttribute failed\n"); grid = -1; return; }
        int per_cu = 0; (void)hipOccupancyMaxActiveBlocksPerMultiprocessor(&per_cu, (const void*)fwd, 512, LDS_BYTES); (void)hipGetLastError();
        grid = cus;
    }
    if (grid < 0) return;
    (void)hipMemsetAsync((char*)d_ws + WS_CTL, 0, CTL_ZERO_BYTES, stream);
    Args a{};
    for (int i = 0; i < 25; ++i) a.in[i] = (const float*)d_in[i];
    a.out = (float*)d_out; a.ws = (unsigned char*)d_ws;
#if MK_SINGLE
    a.ph_lo = 0; a.ph_hi = NPH;
    hipLaunchKernelGGL(fwd, dim3(grid), dim3(512), LDS_BYTES, stream, a);
#else
    for (int p = 0; p < NPH; ++p) { a.ph_lo = p; a.ph_hi = p + 1; hipLaunchKernelGGL(fwd, dim3(grid), dim3(512), LDS_BYTES, stream, a); }
#endif
}
```

```cpp
#include <hip/hip_runtime.h>
#include <cstdio>
#include <cstdint>

#ifndef MK_SINGLE
#define MK_SINGLE 1
#endif

namespace pg8 {
#define PG8_LAS __attribute__((address_space(3)))
typedef unsigned short bf16_t;
typedef short bf16x8 __attribute__((ext_vector_type(8)));
typedef float f32x4 __attribute__((ext_vector_type(4)));
typedef unsigned u32x4 __attribute__((ext_vector_type(4)));
constexpr int BM = 256, BK = 64, HALF = 128, HTB = HALF * BK * 2, STAGE_BYTES = 8 * HTB, NXCD = 8, WGM = 8;

__host__ __device__ __forceinline__ int lds_byte(int r, int c) { const int st = (r >> 4) * 2 + (c >> 5), rr = r & 15, cc = c & 31, ob = rr * 64 + cc * 2; return st * 1024 + (ob ^ (((ob >> 9) & 1) << 5)); }
__host__ __device__ __forceinline__ void stage_rc(int b, int& R, int& C) { const int st = b / 1024, sb = b % 1024, swz = sb ^ (((sb >> 9) & 1) << 5); R = (st >> 1) * 16 + swz / 64; C = (st & 1) * 32 + (swz % 64) / 2; }
__host__ __device__ __forceinline__ int perm32(int rho) { const int n = rho >> 4, i = rho & 15; return 8 * (i >> 2) + 4 * n + (i & 3); }

struct Unit { const char* A; const char* B; const char* B2; int pm, pn, aux; };

struct StaticOrder {
    int nM, nN, nwg, G, c;
    __device__ void init(int M, int N, int G_, int c_) { nM = M / BM; nN = N / BM; nwg = nM * nN; G = G_; c = c_; }
    __device__ bool next(int i, int& pm, int& pn) const {
        const long L = (long)i * G + c; if (L >= nwg) return false;
        int wgid = (int)L; { const int q = nwg / NXCD, r = nwg % NXCD, xcd = wgid % NXCD, off = wgid / NXCD; wgid = (xcd < r ? xcd * (q + 1) : r * (q + 1) + (xcd - r) * q) + off; }
        const int nig = WGM * nN, gid = wgid / nig, fm = gid * WGM, gsz = (nM - fm) < WGM ? (nM - fm) : WGM;
        pm = fm + ((wgid % nig) % gsz); pn = (wgid % nig) / gsz; return true;
    }
};
struct SchedDense {
    const char* A; const char* Bt; size_t tA, tB; StaticOrder so;
    __device__ __forceinline__ bool next(int i, Unit& u) const { int pm, pn; if (!so.next(i, pm, pn)) return false; u.pm = pm; u.pn = pn; u.aux = 0; u.A = A + (size_t)pm * tA; u.B = Bt + (size_t)pn * tB; u.B2 = u.B; return true; }
};

__device__ __forceinline__ unsigned cvt_pk_bf16(float lo, float hi) { unsigned r; asm volatile("v_cvt_pk_bf16_f32 %0, %1, %2" : "=v"(r) : "v"(lo), "v"(hi)); return r; }

template <class Epi, class Sched, bool ALIGN_EPI>
__device__ __forceinline__ void gemm_phase(PG8_LAS unsigned char* lds, const int tid_in, const int lda, const int ldb, const int nt, const int ksplit, const Sched& S, const Epi& E) {
    int tid_ = tid_in; asm volatile("" : "+v"(tid_));
    const int tid = tid_, wid = __builtin_amdgcn_readfirstlane(tid >> 6), lane = tid & 63, wr = wid >> 2, wc = wid & 3, fr = lane & 15, fq = lane >> 4;
    unsigned voffA[2], voffB[2];
#pragma unroll
    for (int i = 0; i < 2; ++i) { int R, C; stage_rc(tid * 16 + i * 8192, R, C); const int Rb = Epi::PERM ? ((R & ~31) + perm32(R & 31)) : R;
        voffA[i] = (unsigned)(R * lda + C) * 2u; voffB[i] = (unsigned)(Rb * ldb + C) * 2u; }
    const size_t kstep = (size_t)(BK * 2);
    const size_t hA = (size_t)HALF * lda * 2, hB = (size_t)HALF * ldb * 2;
    const unsigned ldsw = (unsigned)wid * 1024u;
    const int aoff = lds_byte(wr * 64 + fr, fq * 8), boff = lds_byte(wc * 32 + fr, fq * 8);
#define PG8_SA(b, h) (((b) * 2 + (h)) * HTB)
#define PG8_SB(b, h) ((4 + (b) * 2 + (h)) * HTB)
#define PG8_STAGE(bufoff, gbase, voff) do { _Pragma("unroll") for (int _i = 0; _i < 2; ++_i) \
        __builtin_amdgcn_global_load_lds((const unsigned*)((const char*)(gbase) + (voff)[_i]), (PG8_LAS unsigned*)(lds + (bufoff) + ldsw + _i * 8192), 16, 0, 0); } while (0)
#define PG8_LDA(dst, b, h) do { _Pragma("unroll") for (int m = 0; m < 4; ++m) _Pragma("unroll") for (int k = 0; k < 2; ++k) dst[m][k] = *(const PG8_LAS bf16x8*)(lds + PG8_SA(b, h) + aoff + m * 2048 + k * 1024); } while (0)
#define PG8_LDB(dst, b, h) do { _Pragma("unroll") for (int n = 0; n < 2; ++n) _Pragma("unroll") for (int k = 0; k < 2; ++k) dst[n][k] = *(const PG8_LAS bf16x8*)(lds + PG8_SB(b, h) + boff + n * 2048 + k * 1024); } while (0)
#define PG8_MMA(ai, bj, At, Bt) do { __builtin_amdgcn_s_setprio(1); _Pragma("unroll") for (int m = 0; m < 4; ++m) _Pragma("unroll") for (int n = 0; n < 2; ++n) _Pragma("unroll") for (int k = 0; k < 2; ++k) \
        acc[ai][bj][m][n] = __builtin_amdgcn_mfma_f32_16x16x32_bf16(Bt[n][k], At[m][k], acc[ai][bj][m][n], 0, 0, 0); __builtin_amdgcn_s_setprio(0); } while (0)
#define PG8_WAIT_V(n) asm volatile("s_waitcnt vmcnt(" #n ")" ::: "memory")
#define PG8_WAIT_L(n) asm volatile("s_waitcnt lgkmcnt(" #n ")" ::: "memory")
#define PG8_BAR __builtin_amdgcn_s_barrier()
#define PG8_SCHED __builtin_amdgcn_sched_barrier(0)
    Unit cur, nxt; int ui = 0;
    if (!S.next(0, cur)) return;
    f32x4 acc[2][2][4][2];
#pragma unroll
    for (int a = 0; a < 2; ++a)
#pragma unroll
        for (int b = 0; b < 2; ++b)
#pragma unroll
            for (int m = 0; m < 4; ++m)
#pragma unroll
                for (int n = 0; n < 2; ++n) acc[a][b][m][n] = (f32x4){0.f, 0.f, 0.f, 0.f};
    bf16x8 At[4][2], B0[2][2], B1[2][2];
    const char* cA = cur.A; const char* cB = cur.B; const char* cB2 = cur.B2;
    PG8_STAGE(PG8_SB(0, 0), cB, voffB); PG8_STAGE(PG8_SB(0, 1), cB + hB, voffB); PG8_STAGE(PG8_SA(0, 0), cA, voffA); PG8_STAGE(PG8_SA(0, 1), cA + hA, voffA);
    if (wr == 1) PG8_BAR;
    PG8_WAIT_V(2); PG8_BAR;
    PG8_STAGE(PG8_SB(1, 0), cB + kstep, voffB); PG8_STAGE(PG8_SA(1, 0), cA + kstep, voffA); PG8_STAGE(PG8_SB(1, 1), cB + hB + kstep, voffB);
    PG8_WAIT_V(6); PG8_BAR;
    for (;;) {
        const bool has_next = S.next(ui + 1, nxt);
        const char* nA = has_next ? nxt.A : cA; const char* nB = has_next ? nxt.B : cB;
        for (int t = 0; t < nt; t += 2) {
            const bool last = (t == nt - 2);
            const int t2 = t + 2;
            const char* a1 = cA + (size_t)(t + 1) * kstep;
            const char* a2 = last ? nA : cA + (size_t)t2 * kstep;
            const char* b2 = last ? nB : (t2 < ksplit ? cB + (size_t)t2 * kstep : cB2 + (size_t)(t2 - ksplit) * kstep);
            const char* a3 = a2 + kstep; const char* b3 = b2 + kstep;
            PG8_LDB(B0, 0, 0); PG8_LDB(B1, 0, 1); PG8_SCHED; PG8_LDA(At, 0, 0); PG8_STAGE(PG8_SA(1, 1), a1 + hA, voffA);
            PG8_WAIT_V(8); PG8_WAIT_L(0); PG8_BAR; PG8_MMA(0, 0, At, B0); PG8_MMA(0, 1, At, B1); PG8_BAR; PG8_SCHED;
            PG8_LDA(At, 0, 1); PG8_STAGE(PG8_SB(0, 0), b2, voffB); PG8_STAGE(PG8_SB(0, 1), b2 + hB, voffB); PG8_STAGE(PG8_SA(0, 0), a2, voffA);
            PG8_WAIT_V(8); PG8_WAIT_L(0); PG8_BAR; PG8_MMA(1, 0, At, B0); PG8_MMA(1, 1, At, B1); PG8_BAR; PG8_SCHED;
            PG8_LDB(B0, 1, 0); PG8_LDB(B1, 1, 1); PG8_SCHED; PG8_LDA(At, 1, 0); PG8_STAGE(PG8_SA(0, 1), a2 + hA, voffA);
            PG8_WAIT_V(8); PG8_WAIT_L(0); PG8_BAR; PG8_MMA(0, 0, At, B0); PG8_MMA(0, 1, At, B1); PG8_BAR; PG8_SCHED;
            PG8_LDA(At, 1, 1); PG8_STAGE(PG8_SB(1, 0), b3, voffB); PG8_STAGE(PG8_SB(1, 1), b3 + hB, voffB); PG8_STAGE(PG8_SA(1, 0), a3, voffA);
            PG8_WAIT_V(8); PG8_WAIT_L(0); PG8_BAR; PG8_MMA(1, 0, At, B0); PG8_MMA(1, 1, At, B1); PG8_BAR; PG8_SCHED;
        }
        if constexpr (ALIGN_EPI) { if (wr == 0) PG8_BAR; }
        E(acc, cur, wr, wc, fr, fq);
        if (!has_next) break;
#pragma unroll
        for (int a = 0; a < 2; ++a)
#pragma unroll
            for (int b = 0; b < 2; ++b)
#pragma unroll
                for (int m = 0; m < 4; ++m)
#pragma unroll
                    for (int n = 0; n < 2; ++n) acc[a][b][m][n] = (f32x4){0.f, 0.f, 0.f, 0.f};
        cur = nxt; cA = nA; cB = nB; cB2 = nxt.B2; ++ui;
        if constexpr (ALIGN_EPI) { if (wr == 1) PG8_BAR; }
    }
    PG8_WAIT_V(0);
    if constexpr (!ALIGN_EPI) { if (wr == 0) PG8_BAR; }
    PG8_BAR;
#undef PG8_SA
#undef PG8_SB
#undef PG8_STAGE
#undef PG8_LDA
#undef PG8_LDB
#undef PG8_MMA
#undef PG8_WAIT_V
#undef PG8_WAIT_L
#undef PG8_BAR
#undef PG8_SCHED
}
}

constexpr int BATCH = 2, SEQ = 4096, T = BATCH * SEQ, D = 2048, DEPTH = 4;
constexpr int ZP = 5888;
constexpr int MIXW = 1536;
constexpr int NEXP = 16, EH = 512, PLE = 256;
constexpr float LN_EPS = 1e-5f;
constexpr float ALPHA = 1.681792830507429f;
constexpr float SC2 = 0.125f * 1.4426950408889634f;
constexpr int QA = 0, KA = 512, VA = 1024, QB = 1536, KBC = 2304, VBC = 2496, KBS = 2688, VBS = 2880, KBW = 3072, VBW = 3264, QC = 3456, KC = 4224, VC = 4992, GB = 5760;
constexpr int MAXTILES = 56, TPAD = MAXTILES * 256;

constexpr size_t MiB = 1u << 20;
constexpr size_t WS_CTL = 0, CTL_ZERO_BYTES = 1 * MiB;
constexpr size_t WS_CS = 1 * MiB;
constexpr size_t WS_KMEAN = 2 * MiB;
constexpr size_t WS_KCMP = 3 * MiB;
constexpr size_t WS_VCMP = 4 * MiB;
constexpr size_t WS_TOKC = 5 * MiB;
constexpr size_t WS_TOKS = 5 * MiB + 64 * 1024;
constexpr size_t WS_TOKW = 5 * MiB + 128 * 1024;
constexpr size_t WS_PTOK = 6 * MiB;
constexpr size_t WS_PW = 6 * MiB + 128 * 1024;
constexpr size_t WS_W = 16 * MiB;
constexpr size_t LW_IN = 0, LW_OUT = LW_IN + (size_t)ZP * D * 2, LW_GU = LW_OUT + (size_t)D * MIXW * 2, LW_D = LW_GU + (size_t)NEXP * 1024 * D * 2,
                 LW_PG = LW_D + (size_t)NEXP * D * EH * 2, LW_PP = LW_PG + (size_t)D * D * 2, LW_END = LW_PP + (size_t)D * PLE * 2;
constexpr size_t LW_STRIDE = 135 * MiB;
static_assert(LW_END <= LW_STRIDE, "layer weights");
constexpr size_t WS_H32 = 556 * MiB, WS_HB = 620 * MiB, WS_Z = 652 * MiB, WS_Y = 744 * MiB, WS_MIX = 808 * MiB, WS_XP = 832 * MiB, WS_HID = 888 * MiB,
                 WS_PPLE = 916 * MiB, WS_PB = 980 * MiB, WS_END = 996 * MiB;
static_assert(WS_W + 4 * LW_STRIDE <= WS_H32 && WS_Z + (size_t)T * ZP * 2 <= WS_Y && WS_XP + (size_t)TPAD * D * 2 <= WS_HID && WS_HID + (size_t)TPAD * 1024 * 2 <= WS_PPLE, "ws map");
constexpr int CW_BAR = 4096;
constexpr int CW_CNT = 16384;
constexpr int CW_Q = 20480;
constexpr size_t WS_DILO = WS_PPLE, WS_DILL = WS_PPLE + 32 * MiB;

constexpr int RING_BYTES = 131072, LDSCTL_OFF = RING_BYTES, MISC_OFF = LDSCTL_OFF + 320, TILE_OFF = LDSCTL_OFF + 1024;
constexpr int LDS_BYTES = 147456;

#define GAS __attribute__((address_space(1)))
#define LAS __attribute__((address_space(3)))
typedef unsigned short bf16;
typedef unsigned v4u __attribute__((ext_vector_type(4)));
typedef float f32x4 __attribute__((ext_vector_type(4)));
#define LDS_WAIT() asm volatile("s_waitcnt lgkmcnt(0)" ::: "memory")
__device__ __forceinline__ unsigned f2bf(float f) { unsigned u = __builtin_bit_cast(unsigned, f); return (u + 0x7fffu + ((u >> 16) & 1u)) >> 16; }
__device__ __forceinline__ unsigned pk2(float lo, float hi) { return f2bf(lo) | (f2bf(hi) << 16); }
__device__ __forceinline__ float bf_lo(unsigned u) { return __builtin_bit_cast(float, u << 16); }
__device__ __forceinline__ float bf_hi(unsigned u) { return __builtin_bit_cast(float, u & 0xffff0000u); }
__device__ __forceinline__ float bf1(bf16 u) { return __builtin_bit_cast(float, ((unsigned)u) << 16); }
__device__ __forceinline__ float ex2(float x) { return __builtin_amdgcn_exp2f(x); }

#define XB_TMO      128
#define XB_XCNT(j)  (256  + 64 * (j))
#define XB_XSUB(j)  (1280 + 64 * (j))
#define XB_XGEN(j)  (2304 + 64 * (j))
#define XB_TOP      3328
#define XB_TOPGEN   3392
#define XCD_BAR_WORDS 3456
#define XB_SPIN_CAP (1u << 18)
__device__ __forceinline__ unsigned xb_ld(unsigned* p)              { return __hip_atomic_load(p, __ATOMIC_RELAXED, __HIP_MEMORY_SCOPE_AGENT); }
__device__ __forceinline__ unsigned xb_add(unsigned* p, unsigned v) { return __hip_atomic_fetch_add(p, v, __ATOMIC_RELAXED, __HIP_MEMORY_SCOPE_AGENT); }
__device__ __forceinline__ unsigned xb_xcc_id() { return (unsigned)__builtin_amdgcn_s_getreg((3 << 11) | 20) & 0xFu; }
#define XB_SPIN(cond, bar) do { unsigned _sp = 0; while (cond) { __builtin_amdgcn_s_sleep(1); \
    if ((++_sp & 255u) == 0u) { if (xb_ld(&(bar)[XB_TMO])) break; if (_sp > XB_SPIN_CAP) { atomicAdd(&(bar)[XB_TMO], 1u); break; } } } } while (0)
struct XcdBarrier { unsigned* bar; unsigned x; volatile LAS unsigned* st; };
__device__ __forceinline__ XcdBarrier xcd_barrier_post(unsigned* bar, volatile LAS unsigned* st) {
    XcdBarrier b; b.bar = bar; b.x = xb_xcc_id(); b.st = st;
    if (threadIdx.x == 0) (void)xb_add(&bar[XB_XCNT(b.x)], 1u);
    return b;
}
__device__ __forceinline__ void xcd_barrier_complete(unsigned* bar, unsigned x, unsigned& nloc, unsigned& nx) {
    const unsigned G = gridDim.x * gridDim.y * gridDim.z;
    unsigned sum, cnt, mine, sp = 0u;
    for (;;) {
        sum = 0u; cnt = 0u; mine = 0u;
#pragma unroll
        for (unsigned j = 0; j < 16; ++j) { const unsigned c = xb_ld(&bar[XB_XCNT(j)]); sum += c; cnt += (c > 0u) ? 1u : 0u; mine = (j == x) ? c : mine; }
        if (sum == G) break;
        __builtin_amdgcn_s_sleep(1);
        if ((++sp & 255u) == 0u) { if (xb_ld(&bar[XB_TMO])) break; if (sp > XB_SPIN_CAP) { atomicAdd(&bar[XB_TMO], 1u); break; } }
    }
    nloc = mine > 0u ? mine : 1u; nx = cnt > 0u ? cnt : 1u;
}
__device__ __forceinline__ void xcd_barrier(const XcdBarrier& b, const int tid) {
    asm volatile("s_waitcnt vmcnt(0)" ::: "memory");
    __syncthreads();
    if (tid == 0) {
        unsigned* bar = b.bar;
        __builtin_amdgcn_s_waitcnt(0);
        unsigned nloc = b.st[0], nx = b.st[1];
        if (nloc == 0u) { xcd_barrier_complete(bar, b.x, nloc, nx); b.st[0] = nloc; b.st[1] = nx; }
        const unsigned old = xb_add(&bar[XB_XSUB(b.x)], 1u);
        const unsigned gen = old / nloc;
        if (old + 1u == (gen + 1u) * nloc) {
            __builtin_amdgcn_fence(__ATOMIC_RELEASE, "agent");
            asm volatile("s_waitcnt vmcnt(0)" ::: "memory");
            const unsigned og = xb_add(&bar[XB_TOP], 1u);
            const unsigned tg = og / nx;
            if (og + 1u == (tg + 1u) * nx) xb_add(&bar[XB_TOPGEN], 1u);
            else XB_SPIN(xb_ld(&bar[XB_TOPGEN]) == tg, bar);
            __builtin_amdgcn_fence(__ATOMIC_ACQUIRE, "agent");
            xb_add(&bar[XB_XGEN(b.x)], 1u);
            asm volatile("s_waitcnt vmcnt(0)" ::: "memory");
        } else {
            XB_SPIN(xb_ld(&bar[XB_XGEN(b.x)]) == gen, bar);
            __builtin_amdgcn_fence(__ATOMIC_ACQUIRE, "agent");
            asm volatile("s_waitcnt vmcnt(0)" ::: "memory");
        }
    }
    __syncthreads();
}

struct Args { const float* in[25]; float* out; unsigned char* ws; int ph_lo, ph_hi; };
enum { I_X = 0, I_P, I_POS, I_LNG, I_LNB, I_WIN, I_WOUT, I_CK1, I_CK2, I_PEK, I_CV1, I_CV2, I_PEV, I_LN1G, I_LN1B, I_RW, I_RB, I_WG, I_WU, I_WD, I_PP, I_PGW, I_PGB, I_LN2G, I_LN2B };

struct Frame {
    LAS unsigned char* lds;
    int tid, lane, wave, G, bx, gw, ngw;
    unsigned char* ws;
};

__device__ __forceinline__ float wave_sum(float v) {
#pragma unroll
    for (int o = 1; o < 64; o <<= 1) v += __shfl_xor(v, o);
    return v;
}
__device__ __forceinline__ float wave_max(float v) {
#pragma unroll
    for (int o = 1; o < 64; o <<= 1) v = fmaxf(v, __shfl_xor(v, o));
    return v;
}
template <int OFF> __device__ __forceinline__ void rs_step(float (&v)[64], int lane) {
    const bool up = (lane & OFF) != 0;
#pragma unroll
    for (int i = 0; i < OFF; ++i) { const float send = up ? v[i] : v[i + OFF]; const float keep = up ? v[i + OFF] : v[i]; v[i] = keep + __shfl_xor(send, OFF); }
}
__device__ __forceinline__ void reduce_scatter64(float (&v)[64], int lane) { rs_step<32>(v, lane); rs_step<16>(v, lane); rs_step<8>(v, lane); rs_step<4>(v, lane); rs_step<2>(v, lane); rs_step<1>(v, lane); }

template <int MAP>
__device__ __forceinline__ int rowmap(int n) {
    if (MAP == 1) return n < 3456 ? n : (n < 3492 ? n - 3456 + GB : n - 36);
    if (MAP == 2) return ((n >> 7) << 8) + (n & 127);
    if (MAP == 3) return ((n >> 7) << 8) + 128 + (n & 127);
    return n;
}
template <int MAP>
__device__ __forceinline__ void transpose_item(const float* W, int K, int N, bf16* WT, LAS float* scr, int item, int lane) {
    const int nblk = (N + 31) / 32, kb = item / nblk, nb = item % nblk, k0 = 64 * kb, n0 = 32 * nb;
    const int nn = n0 + (lane & 31); const bool okn = nn < N;
#pragma unroll 8
    for (int i = 0; i < 32; ++i) { const int kk = 2 * i + (lane >> 5); scr[kk * 33 + (lane & 31)] = okn ? W[(size_t)(k0 + kk) * N + nn] : 0.f; }
    LDS_WAIT(); asm volatile("" ::: "memory");
    const int c = lane & 7;
#pragma unroll
    for (int j = 0; j < 4; ++j) { const int n = (lane >> 3) + 8 * j; const LAS float* s = scr + (8 * c) * 33 + n;
        v4u o; o.x = pk2(s[0 * 33], s[1 * 33]); o.y = pk2(s[2 * 33], s[3 * 33]); o.z = pk2(s[4 * 33], s[5 * 33]); o.w = pk2(s[6 * 33], s[7 * 33]);
        if (n0 + n < N) *(v4u*)(WT + (size_t)rowmap<MAP>(n0 + n) * K + k0 + 8 * c) = o; }
    LDS_WAIT(); asm volatile("" ::: "memory");
}

__device__ __forceinline__ void ln_row(const float* src, const float* g, const float* b, float* dst32, bf16* dstb, int lane, f32x4 (&o)[8]) {
    const f32x4* xr = (const f32x4*)src + lane;
    f32x4 v[8]; float s = 0.f;
#pragma unroll
    for (int j = 0; j < 8; ++j) { v[j] = xr[64 * j]; s += (v[j].x + v[j].y) + (v[j].z + v[j].w); }
    const float mean = wave_sum(s) * (1.f / D); float s2 = 0.f;
#pragma unroll
    for (int j = 0; j < 8; ++j) { v[j] = v[j] - mean; s2 += (v[j].x * v[j].x + v[j].y * v[j].y) + (v[j].z * v[j].z + v[j].w * v[j].w); }
    const float rstd = 1.f / sqrtf(wave_sum(s2) * (1.f / D) + LN_EPS);
#pragma unroll
    for (int j = 0; j < 8; ++j) { const f32x4 gg = ((const f32x4*)g)[64 * j + lane], bb = ((const f32x4*)b)[64 * j + lane]; o[j] = v[j] * rstd * gg + bb; }
    if (dst32) {
#pragma unroll
        for (int j = 0; j < 8; ++j) ((f32x4*)dst32)[64 * j + lane] = o[j];
    }
    if (dstb) {
#pragma unroll
        for (int j = 0; j < 8; ++j) ((unsigned long long*)dstb)[64 * j + lane] = (unsigned long long)pk2(o[j].x, o[j].y) | ((unsigned long long)pk2(o[j].z, o[j].w) << 32);
    }
}

__device__ __forceinline__ void phase_prologue(Frame& F, const Args& a) {
    LAS float* scr = (LAS float*)(F.lds + F.wave * 16384);
    constexpr int N_IN = 32 * 182, N_OUT = 24 * 64, N_G1 = 32 * 16, N_D1 = 8 * 64, N_PG = 32 * 64, N_PP = 4 * 64;
    constexpr int PER_LAYER = N_IN + N_OUT + 16 * N_G1 * 2 + 16 * N_D1 + N_PG + N_PP;
    for (int it = F.gw; it < DEPTH * PER_LAYER; it += F.ngw) {
        const int L = it / PER_LAYER; int r = it % PER_LAYER;
        unsigned char* wl = F.ws + WS_W + (size_t)L * LW_STRIDE;
        if (r < N_IN) { transpose_item<1>(a.in[I_WIN] + (size_t)L * D * 5796, D, 5796, (bf16*)(wl + LW_IN), scr, r, F.lane); continue; } r -= N_IN;
        if (r < N_OUT) { transpose_item<0>(a.in[I_WOUT] + (size_t)L * MIXW * D, MIXW, D, (bf16*)(wl + LW_OUT), scr, r, F.lane); continue; } r -= N_OUT;
        if (r < 16 * N_G1) { const int e = r / N_G1; transpose_item<2>(a.in[I_WG] + ((size_t)L * NEXP + e) * D * EH, D, EH, (bf16*)(wl + LW_GU) + (size_t)e * 1024 * D, scr, r % N_G1, F.lane); continue; } r -= 16 * N_G1;
        if (r < 16 * N_G1) { const int e = r / N_G1; transpose_item<3>(a.in[I_WU] + ((size_t)L * NEXP + e) * D * EH, D, EH, (bf16*)(wl + LW_GU) + (size_t)e * 1024 * D, scr, r % N_G1, F.lane); continue; } r -= 16 * N_G1;
        if (r < 16 * N_D1) { const int e = r / N_D1; transpose_item<0>(a.in[I_WD] + ((size_t)L * NEXP + e) * EH * D, EH, D, (bf16*)(wl + LW_D) + (size_t)e * D * EH, scr, r % N_D1, F.lane); continue; } r -= 16 * N_D1;
        if (r < N_PG) { transpose_item<0>(a.in[I_PGW] + (size_t)L * D * D, D, D, (bf16*)(wl + LW_PG), scr, r, F.lane); continue; } r -= N_PG;
        transpose_item<0>(a.in[I_PP] + (size_t)L * PLE * D, PLE, D, (bf16*)(wl + LW_PP), scr, r, F.lane);
    }
    for (int i = F.gw * 64 + F.lane; i < DEPTH * 92 * (D / 8); i += F.ngw * 64) {
        const int L = i / (92 * (D / 8)), r = i % (92 * (D / 8));
        ((v4u*)(F.ws + WS_W + (size_t)L * LW_STRIDE + LW_IN + (size_t)5796 * D * 2))[r] = (v4u){0u, 0u, 0u, 0u};
    }
    { const f32x4* p4 = (const f32x4*)a.in[I_P]; unsigned long long* pb = (unsigned long long*)(F.ws + WS_PB);
      for (size_t i = (size_t)F.gw * 64 + F.lane; i < (size_t)DEPTH * T * PLE / 4; i += (size_t)F.ngw * 64) { const f32x4 v = p4[i]; pb[i] = (unsigned long long)pk2(v.x, v.y) | ((unsigned long long)pk2(v.z, v.w) << 32); } }
    { float* cs = (float*)(F.ws + WS_CS); const int* pos = (const int*)a.in[I_POS];
      for (int i = F.gw * 64 + F.lane; i < T * 8; i += F.ngw * 64) { const int t = i >> 3, j = i & 7;
          const float inv = expf((float)j * -1.6402954339981079f);
          const float ang = (float)pos[t] * inv;
          const double rev = (double)ang * 0.15915494309189535; const float fr = (float)(rev - floor(rev));
          cs[t * 16 + j] = __builtin_amdgcn_cosf(fr); cs[t * 16 + 8 + j] = __builtin_amdgcn_sinf(fr); } }
    for (int m = F.gw; m < T; m += F.ngw) { f32x4 o[8]; ln_row(a.in[I_X] + (size_t)m * D, a.in[I_LNG], a.in[I_LNB], (float*)(F.ws + WS_H32) + (size_t)m * D, (bf16*)(F.ws + WS_HB) + (size_t)m * D, F.lane, o); }
}

__device__ __forceinline__ bool rope_head(int hd) {
    const unsigned long long lo = 0xFFFFull | (0x7FFFull << 24) | (0x7ull << 42) | (0x7ull << 48) | (0x3FFull << 54), hi = 0x3FFFull;
    return hd < 64 ? ((lo >> hd) & 1ull) != 0ull : ((hi >> (hd - 64)) & 1ull) != 0ull;
}
struct EpiZ {
    static constexpr bool PERM = true;
    bf16* Z; const float* cs;
    __device__ __forceinline__ void operator()(const f32x4 (&acc)[2][2][4][2], const pg8::Unit& u, int wr, int wc, int fr, int fq) const {
        const int row0 = u.pm * 256 + wr * 64 + fr;
#pragma unroll
        for (int bj = 0; bj < 2; ++bj) {
            const int cb = u.pn * 256 + bj * 128 + wc * 32;
            const bool rp = ((wc & 1) == 0) && rope_head(cb >> 6);
#pragma unroll
            for (int ai = 0; ai < 2; ++ai)
#pragma unroll
                for (int m = 0; m < 4; ++m) {
                    const int row = row0 + ai * 128 + m * 16;
                    f32x4 v0 = acc[ai][bj][m][0], v1 = acc[ai][bj][m][1];
                    if (rp) {
                        f32x4 o0, o1;
#pragma unroll
                        for (int i = 0; i < 4; ++i) { o0[i] = __shfl_xor(v0[i], 16); o1[i] = __shfl_xor(v1[i], 16); }
                        const f32x4 c0 = *(const f32x4*)(cs + (size_t)row * 16), c1 = *(const f32x4*)(cs + (size_t)row * 16 + 4), s0 = *(const f32x4*)(cs + (size_t)row * 16 + 8), s1 = *(const f32x4*)(cs + (size_t)row * 16 + 12);
                        if (fq == 0) { v0 = v0 * c0 - o0 * s0; v1 = v1 * c1 - o1 * s1; }
                        else if (fq == 1) { v0 = v0 * c0 + o0 * s0; v1 = v1 * c1 + o1 * s1; }
                    }
                    v4u w; w.x = pg8::cvt_pk_bf16(v0[0], v0[1]); w.y = pg8::cvt_pk_bf16(v0[2], v0[3]); w.z = pg8::cvt_pk_bf16(v1[0], v1[1]); w.w = pg8::cvt_pk_bf16(v1[2], v1[3]);
                    *(v4u*)(Z + (size_t)row * ZP + cb + 8 * fq) = w;
                }
        }
    }
};
struct EpiRes {
    static constexpr bool PERM = false;
    const float* h; float* y;
    __device__ __forceinline__ void operator()(const f32x4 (&acc)[2][2][4][2], const pg8::Unit& u, int wr, int wc, int fr, int fq) const {
        const int row0 = u.pm * 256 + wr * 64 + fr, col0 = u.pn * 256 + wc * 32 + 4 * fq;
#pragma unroll
        for (int ai = 0; ai < 2; ++ai)
#pragma unroll
            for (int m = 0; m < 4; ++m) { const size_t off = (size_t)(row0 + ai * 128 + m * 16) * D + col0;
#pragma unroll
                for (int bj = 0; bj < 2; ++bj)
#pragma unroll
                    for (int n = 0; n < 2; ++n) { const size_t o = off + bj * 128 + n * 16; *(f32x4*)(y + o) = *(const f32x4*)(h + o) * ALPHA + acc[ai][bj][m][n]; } }
    }
};
struct EpiF32 {
    static constexpr bool PERM = false;
    float* C;
    __device__ __forceinline__ void operator()(const f32x4 (&acc)[2][2][4][2], const pg8::Unit& u, int wr, int wc, int fr, int fq) const {
        const int row0 = u.pm * 256 + wr * 64 + fr, col0 = u.pn * 256 + wc * 32 + 4 * fq;
#pragma unroll
        for (int ai = 0; ai < 2; ++ai)
#pragma unroll
            for (int m = 0; m < 4; ++m) { const size_t off = (size_t)(row0 + ai * 128 + m * 16) * D + col0;
#pragma unroll
                for (int bj = 0; bj < 2; ++bj)
#pragma unroll
                    for (int n = 0; n < 2; ++n) *(f32x4*)(C + off + bj * 128 + n * 16) = acc[ai][bj][m][n]; }
    }
};
struct EpiPle {
    static constexpr bool PERM = false;
    const float* h; const float* P; const float* bias; float* y2;
    __device__ __forceinline__ void operator()(const f32x4 (&acc)[2][2][4][2], const pg8::Unit& u, int wr, int wc, int fr, int fq) const {
        const int row0 = u.pm * 256 + wr * 64 + fr, col0 = u.pn * 256 + wc * 32 + 4 * fq;
#pragma unroll
        for (int bj = 0; bj < 2; ++bj)
#pragma unroll
            for (int n = 0; n < 2; ++n) { const f32x4 bv = *(const f32x4*)(bias + col0 + bj * 128 + n * 16);
#pragma unroll
                for (int ai = 0; ai < 2; ++ai)
#pragma unroll
                    for (int m = 0; m < 4; ++m) { const size_t o = (size_t)(row0 + ai * 128 + m * 16) * D + col0 + bj * 128 + n * 16;
                        const f32x4 x = acc[ai][bj][m][n] + bv; f32x4 sg;
#pragma unroll
                        for (int i = 0; i < 4; ++i) sg[i] = __builtin_amdgcn_rcpf(1.f + __expf(-x[i]));
                        *(f32x4*)(y2 + o) = *(const f32x4*)(h + o) * ALPHA + sg * *(const f32x4*)(P + o); } }
    }
};
struct EpiGU {
    static constexpr bool PERM = true;
    bf16* hid; const float* pw;
    __device__ __forceinline__ void operator()(const f32x4 (&acc)[2][2][4][2], const pg8::Unit& u, int wr, int wc, int fr, int fq) const {
        const int slot = u.aux, row0 = u.pm * 256 + wr * 64 + fr, cb = slot * 512 + u.pn * 128 + wc * 32 + 8 * fq;
#pragma unroll
        for (int ai = 0; ai < 2; ++ai)
#pragma unroll
            for (int m = 0; m < 4; ++m) { const int prow = row0 + ai * 128 + m * 16; const float w = pw[prow * 2 + slot];
                float r[8];
#pragma unroll
                for (int n = 0; n < 2; ++n)
#pragma unroll
                    for (int i = 0; i < 4; ++i) { const float g = acc[ai][0][m][n][i], up = acc[ai][1][m][n][i]; r[n * 4 + i] = g * __builtin_amdgcn_rcpf(1.f + __expf(-g)) * up * w; }
                v4u o; o.x = pg8::cvt_pk_bf16(r[0], r[1]); o.y = pg8::cvt_pk_bf16(r[2], r[3]); o.z = pg8::cvt_pk_bf16(r[4], r[5]); o.w = pg8::cvt_pk_bf16(r[6], r[7]);
                *(v4u*)(hid + (size_t)prow * 1024 + cb) = o; }
    }
};
struct EpiDown {
    static constexpr bool PERM = false;
    float* y2; const int* ptok;
    __device__ __forceinline__ void operator()(const f32x4 (&acc)[2][2][4][2], const pg8::Unit& u, int wr, int wc, int fr, int fq) const {
        const int row0 = u.pm * 256 + wr * 64 + fr, col0 = u.pn * 256 + wc * 32 + 4 * fq;
#pragma unroll
        for (int ai = 0; ai < 2; ++ai)
#pragma unroll
            for (int m = 0; m < 4; ++m) { const int tok = ptok[row0 + ai * 128 + m * 16];
                if (tok >= 0) { const size_t off = (size_t)tok * D + col0;
#pragma unroll
                    for (int bj = 0; bj < 2; ++bj)
#pragma unroll
                        for (int n = 0; n < 2; ++n) { float* p = y2 + off + bj * 128 + n * 16; *(f32x4*)p = *(const f32x4*)p + acc[ai][bj][m][n]; } } }
    }
};
struct SchedGU {
    const char* xp; const char* wgu; const volatile LAS int* tab; int G, c, ntiles;
    __device__ __forceinline__ bool next(int i, pg8::Unit& u) const {
        const int L = i * G + c; if (L >= ntiles * 8) return false;
        const int tile = L >> 3, pn = L & 7, cls = __builtin_amdgcn_readfirstlane(tab[tile]), g = cls / 6, pi = cls % 6;
        const int ea = 4 * g + (pi < 3 ? 0 : (pi < 5 ? 1 : 2)), eb = 4 * g + (pi == 0 ? 1 : ((pi == 1 || pi == 3) ? 2 : 3));
        const int slot = pn >> 2, j = pn & 3, e = slot ? eb : ea;
        u.pm = tile; u.pn = j; u.aux = slot; u.A = xp + (size_t)tile * 256 * D * 2; u.B = wgu + ((size_t)e * 1024 + (size_t)j * 256) * D * 2; u.B2 = u.B; return true;
    }
};
struct SchedDown {
    const char* hid; const char* wd; const volatile LAS int* tab; int G, c, ntiles;
    __device__ __forceinline__ bool next(int i, pg8::Unit& u) const {
        const int L = i * G + c; if (L >= ntiles * 8) return false;
        const int tile = L >> 3, pn = L & 7, cls = __builtin_amdgcn_readfirstlane(tab[tile]), g = cls / 6, pi = cls % 6;
        const int ea = 4 * g + (pi < 3 ? 0 : (pi < 5 ? 1 : 2)), eb = 4 * g + (pi == 0 ? 1 : ((pi == 1 || pi == 3) ? 2 : 3));
        u.pm = tile; u.pn = pn; u.aux = 0; u.A = hid + (size_t)tile * 256 * 1024 * 2;
        u.B = wd + ((size_t)ea * D + (size_t)pn * 256) * EH * 2; u.B2 = wd + ((size_t)eb * D + (size_t)pn * 256) * EH * 2; return true;
    }
};

__device__ __forceinline__ void load_row64(const bf16* p, float (&q)[64]) {
    const v4u* pp = (const v4u*)p;
#pragma unroll
    for (int c = 0; c < 8; ++c) { const v4u u = pp[c]; q[8 * c + 0] = bf_lo(u.x); q[8 * c + 1] = bf_hi(u.x); q[8 * c + 2] = bf_lo(u.y); q[8 * c + 3] = bf_hi(u.y);
        q[8 * c + 4] = bf_lo(u.z); q[8 * c + 5] = bf_hi(u.z); q[8 * c + 6] = bf_lo(u.w); q[8 * c + 7] = bf_hi(u.w); }
}
__device__ __forceinline__ float dot_row64(const float (&q)[64], const bf16* p) {
    const v4u* pp = (const v4u*)p; float s0 = 0.f, s1 = 0.f, s2 = 0.f, s3 = 0.f;
#pragma unroll
    for (int c = 0; c < 8; ++c) { const v4u u = pp[c];
        s0 += q[8 * c + 0] * bf_lo(u.x) + q[8 * c + 1] * bf_hi(u.x); s1 += q[8 * c + 2] * bf_lo(u.y) + q[8 * c + 3] * bf_hi(u.y);
        s2 += q[8 * c + 4] * bf_lo(u.z) + q[8 * c + 5] * bf_hi(u.z); s3 += q[8 * c + 6] * bf_lo(u.w) + q[8 * c + 7] * bf_hi(u.w); }
    return (s0 + s1) + (s2 + s3);
}
struct WAcc { float m, l; float a[64]; };
__device__ __forceinline__ void wacc_init(WAcc& A) { A.m = -1e30f; A.l = 0.f;
#pragma unroll
    for (int d = 0; d < 64; ++d) A.a[d] = 0.f; }
__device__ __forceinline__ void wacc_key(WAcc& A, float s2, const bf16* vrow) {
    const float mn = fmaxf(A.m, s2), f = ex2(A.m - mn), p = ex2(s2 - mn); A.m = mn; A.l = A.l * f + p;
    const v4u* pp = (const v4u*)vrow;
#pragma unroll
    for (int c = 0; c < 8; ++c) { const v4u u = pp[c];
        A.a[8 * c + 0] = A.a[8 * c + 0] * f + p * bf_lo(u.x); A.a[8 * c + 1] = A.a[8 * c + 1] * f + p * bf_hi(u.x);
        A.a[8 * c + 2] = A.a[8 * c + 2] * f + p * bf_lo(u.y); A.a[8 * c + 3] = A.a[8 * c + 3] * f + p * bf_hi(u.y);
        A.a[8 * c + 4] = A.a[8 * c + 4] * f + p * bf_lo(u.z); A.a[8 * c + 5] = A.a[8 * c + 5] * f + p * bf_hi(u.z);
        A.a[8 * c + 6] = A.a[8 * c + 6] * f + p * bf_lo(u.w); A.a[8 * c + 7] = A.a[8 * c + 7] * f + p * bf_hi(u.w); }
}
__device__ __forceinline__ float wacc_finish(WAcc& A, int lane, float& lse2) {
    const float M = wave_max(A.m), f = ex2(A.m - M), L = wave_sum(A.l * f);
#pragma unroll
    for (int d = 0; d < 64; ++d) A.a[d] *= f;
    reduce_scatter64(A.a, lane);
    lse2 = M + __log2f(L);
    return L > 0.f ? A.a[0] / L : 0.f;
}

__device__ __forceinline__ void phase_kmean(Frame& F) {
    const bf16* z = (const bf16*)(F.ws + WS_Z); float* km = (float*)(F.ws + WS_KMEAN); LAS float* red = (LAS float*)F.lds;
    for (int it = F.bx; it < 256; it += F.G) {
        const int b = it >> 7, h = (it >> 4) & 7, blk = it & 15, d = F.tid & 63, part = F.tid >> 6;
        const bf16* p = z + ((size_t)b * SEQ + blk * 256 + part * 32) * ZP + KA + h * 64 + d; float s = 0.f;
        for (int k = 0; k < 32; ++k) s += bf1(p[(size_t)k * ZP]);
        red[part * 64 + d] = s; __syncthreads();
        if (F.tid < 64) { float t = 0.f;
#pragma unroll
            for (int q = 0; q < 8; ++q) t += red[q * 64 + d];
            km[(size_t)it * 64 + d] = t * (1.f / 256.f); }
        __syncthreads();
    }
}
__device__ __forceinline__ float gelu_tanh(float x) { const float u = 0.7978845608028654f * (x + 0.044715f * x * x * x); const float e = __expf(2.f * u); const float th = 1.f - 2.f / (e + 1.f); return 0.5f * x * (1.f + th); }
__device__ __forceinline__ void phase_compress(Frame& F, const Args& a, int L) {
    const bf16* z = (const bf16*)(F.ws + WS_Z); LAS float* hs = (LAS float*)(F.lds + 65536) + F.wave * 1024;
    for (int it = (F.gw + F.ngw - 128 * 8) % F.ngw; it < 384; it += F.ngw) {
        const int ng = it & 31, kv = (it >> 5) & 1, bh = it >> 6, b = bh / 3, hk = bh % 3, n0 = ng * 8, lane = F.lane;
        const float* W1 = a.in[kv ? I_CV1 : I_CK1] + (size_t)L * 2048 * 128; const float* W2 = a.in[kv ? I_CV2 : I_CK2] + (size_t)L * 128 * 64; const float* pe = a.in[kv ? I_PEV : I_PEK] + (size_t)L * 2048;
        const bf16* src = z + (size_t)b * SEQ * ZP + (kv ? VBC : KBC) + hk * 64;
        float h0[8], h1[8];
#pragma unroll
        for (int r = 0; r < 8; ++r) { h0[r] = 0.f; h1[r] = 0.f; }
        for (int j = 0; j < 32; ++j) {
#pragma unroll 4
            for (int d = 0; d < 64; ++d) { const int idx = j * 64 + d; const float w0 = W1[(size_t)idx * 128 + lane], w1 = W1[(size_t)idx * 128 + 64 + lane], pv = pe[idx];
#pragma unroll
                for (int r = 0; r < 8; ++r) { const int n = (n0 + r) < 255 ? (n0 + r) : 254; const float x = bf1(src[(size_t)(16 * n + j) * ZP + d]) + pv; h0[r] += x * w0; h1[r] += x * w1; } }
        }
#pragma unroll
        for (int r = 0; r < 8; ++r) { hs[r * 128 + lane] = gelu_tanh(h0[r]); hs[r * 128 + 64 + lane] = gelu_tanh(h1[r]); }
        LDS_WAIT(); asm volatile("" ::: "memory");
        float o[8];
#pragma unroll
        for (int r = 0; r < 8; ++r) o[r] = 0.f;
        for (int c = 0; c < 128; ++c) { const float w = W2[c * 64 + lane];
#pragma unroll
            for (int r = 0; r < 8; ++r) o[r] += hs[r * 128 + c] * w; }
        bf16* dst = (bf16*)(F.ws + (kv ? WS_VCMP : WS_KCMP)) + ((size_t)(b * 3 + hk) * 256) * 64;
#pragma unroll
        for (int r = 0; r < 8; ++r) if (n0 + r < 255) dst[(size_t)(n0 + r) * 64 + lane] = (bf16)f2bf(o[r]); else dst[(size_t)255 * 64 + lane] = 0;
        LDS_WAIT(); asm volatile("" ::: "memory");
    }
}
__device__ __forceinline__ void phase_dilated(Frame& F) {
    const bf16* z = (const bf16*)(F.ws + WS_Z); bf16* mix = (bf16*)(F.ws + WS_MIX); const int lane = F.lane;
    for (int it = F.gw; it < T * 4; it += F.ngw) {
        const int t = it >> 2, j = it & 3, b = t / SEQ, s = t % SEQ;
        float og[3], ls[3];
#pragma unroll
        for (int gi = 0; gi < 3; ++gi) {
            const int dil = gi == 0 ? 1 : (gi == 1 ? 4 : 16), head = gi * 4 + j;
            float q[64]; load_row64(z + (size_t)t * ZP + QC + head * 64, q);
            WAcc A; wacc_init(A);
            for (int k = lane; k <= 128; k += 64) { const int sk = s - k * dil;
                if (sk >= 0) { const bf16* kr = z + ((size_t)b * SEQ + sk) * ZP; const float sc = dot_row64(q, kr + KC + head * 64) * SC2; wacc_key(A, sc, kr + VC + head * 64); } }
            og[gi] = wacc_finish(A, lane, ls[gi]);
        }
        const float mx = fmaxf(ls[0], fmaxf(ls[1], ls[2])); const float w0 = ex2(ls[0] - mx), w1 = ex2(ls[1] - mx), w2 = ex2(ls[2] - mx);
        mix[(size_t)t * MIXW + 1280 + j * 64 + lane] = (bf16)f2bf((w0 * og[0] + w1 * og[1] + w2 * og[2]) / (w0 + w1 + w2));
    }
}
__device__ __forceinline__ void phase_moba(Frame& F) {
    const bf16* z = (const bf16*)(F.ws + WS_Z); bf16* mix = (bf16*)(F.ws + WS_MIX); const float* km = (const float*)(F.ws + WS_KMEAN); const int lane = F.lane;
    for (int it = F.gw; it < T * 8; it += F.ngw) {
        const int t = it >> 3, h = it & 7, b = t / SEQ, s = t % SEQ, cur = s >> 8;
        float q[64]; load_row64(z + (size_t)t * ZP + QA + h * 64, q);
        float gate = -1e30f;
        if (lane < cur) { const float* kmr = km + ((size_t)(b * 8 + h) * 16 + lane) * 64; float g = 0.f;
#pragma unroll
            for (int d = 0; d < 64; ++d) g += q[d] * kmr[d];
            gate = g; }
        int rank = 0;
        for (int jj = 0; jj < 16; ++jj) { const float gj = __shfl(gate, jj); rank += (gj > gate || (gj == gate && jj < lane)) ? 1 : 0; }
        const unsigned long long selm = __ballot(lane < cur && rank < 3);
        WAcc A; wacc_init(A);
        unsigned long long mm = selm;
        while (mm) { const int blk = __builtin_ctzll(mm); mm &= mm - 1;
            for (int i = 0; i < 4; ++i) { const bf16* kr = z + ((size_t)b * SEQ + blk * 256 + i * 64 + lane) * ZP; const float sc = dot_row64(q, kr + KA + h * 64) * SC2; wacc_key(A, sc, kr + VA + h * 64); } }
        for (int i = 0; i < 4; ++i) { const int sk = cur * 256 + i * 64 + lane;
            if (sk <= s) { const bf16* kr = z + ((size_t)b * SEQ + sk) * ZP; const float sc = dot_row64(q, kr + KA + h * 64) * SC2; wacc_key(A, sc, kr + VA + h * 64); } }
        float l2; const float o = wacc_finish(A, lane, l2);
        mix[(size_t)t * MIXW + h * 64 + lane] = (bf16)f2bf(o);
    }
}
__device__ __forceinline__ void phase_nsa(Frame& F) {
    const bf16* z = (const bf16*)(F.ws + WS_Z); bf16* mix = (bf16*)(F.ws + WS_MIX); const int lane = F.lane;
    LAS float* ps = (LAS float*)F.lds + F.wave * 320;
    for (int it = F.gw; it < T * 3; it += F.ngw) {
        const int t = it / 3, hk = it % 3, b = t / SEQ, s = t % SEQ, cur = s >> 6;
        const bf16* kc = (const bf16*)(F.ws + WS_KCMP) + ((size_t)(b * 3 + hk) * 256) * 64; const bf16* vc = (const bf16*)(F.ws + WS_VCMP) + ((size_t)(b * 3 + hk) * 256) * 64;
        const int ncv = s >= 31 ? ((s - 31) >> 4) + 1 : 0;
        float psum[4] = {0.f, 0.f, 0.f, 0.f}; float ocmp[4];
#pragma unroll
        for (int g = 0; g < 4; ++g) {
            float q[64]; load_row64(z + (size_t)t * ZP + QB + (hk * 4 + g) * 64, q);
            float sc[4]; float mx = -1e30f;
#pragma unroll
            for (int i = 0; i < 4; ++i) { const int n = lane + 64 * i; sc[i] = n < ncv ? dot_row64(q, kc + (size_t)n * 64) * SC2 : -1e30f; mx = fmaxf(mx, sc[i]); }
            mx = wave_max(mx); float p[4]; float ls = 0.f;
#pragma unroll
            for (int i = 0; i < 4; ++i) { const int n = lane + 64 * i; p[i] = n < ncv ? ex2(sc[i] - mx) : 0.f; ls += p[i]; }
            ls = wave_sum(ls); const float inv = ls > 0.f ? 1.f / ls : 0.f;
            float acc[64];
#pragma unroll
            for (int d = 0; d < 64; ++d) acc[d] = 0.f;
#pragma unroll
            for (int i = 0; i < 4; ++i) { const int n = lane + 64 * i; p[i] *= inv; psum[i] += p[i];
                if (n < ncv) { const v4u* pp = (const v4u*)(vc + (size_t)n * 64);
#pragma unroll
                    for (int c = 0; c < 8; ++c) { const v4u u = pp[c]; acc[8 * c + 0] += p[i] * bf_lo(u.x); acc[8 * c + 1] += p[i] * bf_hi(u.x); acc[8 * c + 2] += p[i] * bf_lo(u.y); acc[8 * c + 3] += p[i] * bf_hi(u.y);
                        acc[8 * c + 4] += p[i] * bf_lo(u.z); acc[8 * c + 5] += p[i] * bf_hi(u.z); acc[8 * c + 6] += p[i] * bf_lo(u.w); acc[8 * c + 7] += p[i] * bf_hi(u.w); } } }
            reduce_scatter64(acc, lane); ocmp[g] = acc[0];
        }
#pragma unroll
        for (int i = 0; i < 4; ++i) ps[lane + 64 * i] = (lane + 64 * i) < 255 ? psum[i] : 0.f;
        LDS_WAIT(); asm volatile("" ::: "memory");
        float imp = ps[4 * lane] + ps[4 * lane + 1] + ps[4 * lane + 2] + ps[4 * lane + 3]; if (lane > 0) imp += ps[4 * lane - 1];
        LDS_WAIT(); asm volatile("" ::: "memory");
        const bool valid = lane <= cur, forced = valid && (lane == 0 || lane > cur - 2);
        const float val = forced ? 1e30f : (valid ? imp : -1e30f);
        int rank = 0;
        for (int jj = 0; jj < 64; ++jj) { const float vj = __shfl(val, jj); rank += (vj > val || (vj == val && jj < lane)) ? 1 : 0; }
        const unsigned long long selm = __ballot(valid && rank < 16);
#pragma unroll
        for (int g = 0; g < 4; ++g) {
            const int head = hk * 4 + g;
            float q[64]; load_row64(z + (size_t)t * ZP + QB + head * 64, q);
            WAcc A; wacc_init(A);
            unsigned long long mm = selm;
            while (mm) { const int blk = __builtin_ctzll(mm); mm &= mm - 1; const int sk = blk * 64 + lane;
                if (sk <= s) { const bf16* kr = z + ((size_t)b * SEQ + sk) * ZP; const float scv = dot_row64(q, kr + KBS + hk * 64) * SC2; wacc_key(A, scv, kr + VBS + hk * 64); } }
            float l2; const float oslc = wacc_finish(A, lane, l2);
            wacc_init(A);
            for (int i = 0; i < 8; ++i) { const int sk = s - 511 + i * 64 + lane;
                if (sk >= 0) { const bf16* kr = z + ((size_t)b * SEQ + sk) * ZP; const float scv = dot_row64(q, kr + KBW + hk * 64) * SC2; wacc_key(A, scv, kr + VBW + hk * 64); } }
            const float owin = wacc_finish(A, lane, l2);
            const bf16* gp = z + (size_t)t * ZP + GB + head * 3;
            const float g0 = 1.f / (1.f + __expf(-bf1(gp[0]))), g1 = 1.f / (1.f + __expf(-bf1(gp[1]))), g2 = 1.f / (1.f + __expf(-bf1(gp[2])));
            mix[(size_t)t * MIXW + 512 + head * 64 + lane] = (bf16)f2bf(g0 * ocmp[g] + g1 * oslc + g2 * owin);
        }
    }
}

namespace fa {
typedef short bf16x8 __attribute__((ext_vector_type(8)));
typedef short s16x4 __attribute__((ext_vector_type(4)));
typedef float f32x16 __attribute__((ext_vector_type(16)));
typedef short v4i16_t __attribute__((ext_vector_type(4)));
constexpr int SLOTB = 8192, LDS_K = 0, LDS_V = 3 * SLOTB, LDS_WS = 6 * SLOTB, LDS_PS = LDS_WS + 8 * 256, LDS_SEL = LDS_PS + 8 * 8192, LDS_Q = LDS_SEL + 1024, LDS_END = LDS_Q + 64;
constexpr float THR = 8.f;
constexpr int NEGBIG = -(1 << 29);
#define FA_MFMA(a, b, c) __builtin_amdgcn_mfma_f32_32x32x16_bf16(a, b, c, 0, 0, 0)
typedef LAS const char* lcp;
__device__ __forceinline__ int crow(int r, int hi) { return (r & 3) + 8 * (r >> 2) + 4 * hi; }
__device__ __forceinline__ void glds16(const void* gsrc, unsigned lds_dst) { unsigned keep;
    asm volatile("s_mov_b32 %0, m0\n\ts_mov_b32 m0, %2\n\ts_nop 0\n\tglobal_load_lds_dwordx4 %1, off\n\ts_mov_b32 m0, %0" : "=&s"(keep) : "v"(gsrc), "s"(lds_dst) : "memory"); }
__device__ __forceinline__ s16x4 vtr(lcp p) { return __builtin_bit_cast(s16x4, __builtin_amdgcn_ds_read_tr16_b64_v4i16((LAS v4i16_t*)p)); }
__device__ __forceinline__ unsigned cvtpk(float lo, float hi) { typedef float f2 __attribute__((ext_vector_type(2))); typedef __bf16 b2 __attribute__((ext_vector_type(2))); f2 v = {lo, hi}; b2 b = __builtin_convertvector(v, b2); return __builtin_bit_cast(unsigned, b); }
__device__ __forceinline__ void half_pair(float v, float& x0, float& x1) { unsigned a = __builtin_bit_cast(unsigned, v), b = a;
    asm volatile("s_nop 1\n\tv_permlane32_swap_b32 %0, %1\n\ts_nop 1" : "+v"(a), "+v"(b));
    x0 = __builtin_bit_cast(float, a); x1 = __builtin_bit_cast(float, b); }
__device__ __forceinline__ float half_max(float v) { float x0, x1; half_pair(v, x0, x1); return fmaxf(x0, x1); }
__device__ __forceinline__ float half_sum(float v) { float x0, x1; half_pair(v, x0, x1); return x0 + x1; }
#define FA_WAIT_BAR(N) asm volatile("s_waitcnt vmcnt(" #N ") lgkmcnt(0)\n\ts_barrier" ::: "memory")

struct Rows { int qlo, qhi, lo_min, lo_max, hi_min, hi_max; };
struct St { float m, l; f32x16 o[2]; };
__device__ __forceinline__ void st_init(St& s) { s.m = -INFINITY; s.l = 0.f; s.o[0] = f32x16{}; s.o[1] = f32x16{}; }

__device__ __forceinline__ void qk_tile(f32x16& p0, f32x16& p1, lcp kslot, const bf16x8 (&qr)[4], int r32, int hi) {
    lcp kb = kslot + hi * 1024 + r32 * 16;
    p0 = f32x16{}; p1 = f32x16{};
#pragma unroll
    for (int d0 = 0; d0 < 4; ++d0) { const bf16x8 b0 = *(const LAS bf16x8*)(kb + d0 * 2048), b1 = *(const LAS bf16x8*)(kb + d0 * 2048 + 512);
        p0 = FA_MFMA(b0, qr[d0], p0); p1 = FA_MFMA(b1, qr[d0], p1); }
}
__device__ __forceinline__ void band_mask(f32x16& p0, f32x16& p1, int kb, int hi, int qlo, int qhi) {
#pragma unroll
    for (int r = 0; r < 16; ++r) { const int k = kb + (r & 3) + 8 * (r >> 2) + 4 * hi;
        if (k > qhi || k < qlo) p0[r] = -INFINITY; if (k + 32 > qhi || k + 32 < qlo) p1[r] = -INFINITY; }
}
__device__ __forceinline__ void flash_step(St& s, f32x16& p0, f32x16& p1, lcp vslot, LAS float* wsf, int lane, int r32, int hi) {
    float mx = fmaxf(p0[0], p1[0]);
#pragma unroll
    for (int r = 1; r < 16; ++r) mx = fmaxf(mx, fmaxf(p0[r], p1[r]));
    mx = half_max(mx);
    const float t2 = mx * SC2;
    if (__any(t2 > s.m + THR)) {
        const float mn = fmaxf(s.m, t2);
        const float alpha = (mn == -INFINITY) ? 1.f : ex2(s.m - mn);
        s.l *= alpha; s.m = mn;
        if (hi == 0) wsf[r32] = alpha;
#pragma unroll
        for (int r = 0; r < 16; ++r) { const float a = wsf[crow(r, hi)]; s.o[0][r] *= a; s.o[1][r] *= a; }
    }
    const float mu = (s.m == -INFINITY) ? 0.f : s.m;
    float ls = 0.f;
#pragma unroll
    for (int r = 0; r < 16; ++r) { p0[r] = ex2(__builtin_fmaf(p0[r], SC2, -mu)); p1[r] = ex2(__builtin_fmaf(p1[r], SC2, -mu)); ls += p0[r] + p1[r]; }
    s.l += ls;
    typedef unsigned u32x4 __attribute__((ext_vector_type(4)));
    const u32x4 w0 = {cvtpk(p0[0], p0[1]), cvtpk(p0[2], p0[3]), cvtpk(p0[4], p0[5]), cvtpk(p0[6], p0[7])}, w1 = {cvtpk(p0[8], p0[9]), cvtpk(p0[10], p0[11]), cvtpk(p0[12], p0[13]), cvtpk(p0[14], p0[15])};
    const u32x4 w2 = {cvtpk(p1[0], p1[1]), cvtpk(p1[2], p1[3]), cvtpk(p1[4], p1[5]), cvtpk(p1[6], p1[7])}, w3 = {cvtpk(p1[8], p1[9]), cvtpk(p1[10], p1[11]), cvtpk(p1[12], p1[13]), cvtpk(p1[14], p1[15])};
    const bf16x8 pa[4] = {__builtin_bit_cast(bf16x8, w0), __builtin_bit_cast(bf16x8, w1), __builtin_bit_cast(bf16x8, w2), __builtin_bit_cast(bf16x8, w3)};
    lcp vp = vslot + ((lane >> 4) & 1) * 32 + (lane & 3) * 8 + (4 * hi + ((lane & 15) >> 2)) * 64;
#pragma unroll
    for (int d0 = 0; d0 < 2; ++d0)
#pragma unroll
        for (int kg = 0; kg < 4; ++kg) { const s16x4 lo = vtr(vp + d0 * 4096 + kg * 1024), hh = vtr(vp + d0 * 4096 + kg * 1024 + 512);
            const bf16x8 vf = {lo[0], lo[1], lo[2], lo[3], hh[0], hh[1], hh[2], hh[3]};
            s.o[d0] = FA_MFMA(pa[kg], vf, s.o[d0]); }
}
template <bool USESEL>
__device__ __forceinline__ void stream_pv(LAS char* L, int wid, int lane, const bf16* Kb, size_t sK, const bf16* Vb, size_t sV, int t_lo, int t_hi,
                                          const bf16x8 (&qr)[4], const Rows& R, unsigned long long selm, int tpb_shift, int cur_blk, St& s) {
    const int r32 = lane & 31, hi = lane >> 5, n = t_hi - t_lo + 1;
    if (n <= 0) return;
    const unsigned lds0 = (unsigned)(uintptr_t)L;
    const bf16* ksrc = Kb + ((size_t)t_lo * 64 + lane) * sK + wid * 8;
    const bf16* vsrc = Vb + ((size_t)t_lo * 64 + 16 * (wid & 3) + (lane >> 2)) * sV + (wid >> 2) * 32 + (lane & 3) * 8;
    const unsigned kdst = lds0 + LDS_K + wid * 1024, vdst = lds0 + LDS_V + wid * 1024;
    LAS float* wsf = (LAS float*)(L + LDS_WS) + wid * 64;
#define FA_ISSUE(i, slot) do { glds16(ksrc + (size_t)(i) * 64 * sK, (unsigned)__builtin_amdgcn_readfirstlane(kdst + (slot) * SLOTB)); glds16(vsrc + (size_t)(i) * 64 * sV, (unsigned)__builtin_amdgcn_readfirstlane(vdst + (slot) * SLOTB)); } while (0)
    asm volatile("s_waitcnt vmcnt(0)" ::: "memory");
    FA_ISSUE(0, 0); if (n > 1) FA_ISSUE(1, 1);
    int slot = 0;
    for (int i = 0; i < n; ++i) {
        if (i + 1 < n) FA_WAIT_BAR(2); else FA_WAIT_BAR(0);
        if (i + 2 < n) { const int s2 = slot >= 1 ? slot - 1 : 2; FA_ISSUE(i + 2, s2); }
        const int t = t_lo + i, kb = t * 64;
        int mode; bool sel = true;
        if (USESEL && (t >> tpb_shift) < cur_blk) { sel = ((selm >> (t >> tpb_shift)) & 1ull) != 0ull; const unsigned long long bal = __ballot(sel); mode = bal == 0ull ? 0 : (bal == ~0ull ? 1 : 3); }
        else mode = (kb > R.hi_max || kb + 63 < R.lo_min) ? 0 : ((kb + 63 <= R.hi_min && kb >= R.lo_max) ? 1 : 2);
        if (mode != 0) {
            f32x16 p0, p1; qk_tile(p0, p1, (lcp)L + LDS_K + slot * SLOTB, qr, r32, hi);
            if (mode == 2) band_mask(p0, p1, kb, hi, R.qlo, R.qhi);
            if (mode == 3) {
#pragma unroll
                for (int r = 0; r < 16; ++r) { p0[r] = sel ? p0[r] : -INFINITY; p1[r] = sel ? p1[r] : -INFINITY; } }
            flash_step(s, p0, p1, (lcp)L + LDS_V + slot * SLOTB, wsf, lane, r32, hi);
        }
        slot = slot == 2 ? 0 : slot + 1;
    }
    asm volatile("s_waitcnt lgkmcnt(0)\n\ts_barrier" ::: "memory");
#undef FA_ISSUE
}
__device__ __forceinline__ float st_invl(const St& s, float& ltot) { ltot = half_sum(s.l); return ltot > 0.f ? 1.f / ltot : 0.f; }
template <bool ACCUM>
__device__ __forceinline__ void scale_rows(f32x16 (&dst)[2], const f32x16 (&o)[2], float fac, LAS float* wsf, int r32, int hi) {
    if (hi == 0) wsf[r32] = fac;
#pragma unroll
    for (int r = 0; r < 16; ++r) { const float a = wsf[crow(r, hi)]; if (ACCUM) { dst[0][r] += o[0][r] * a; dst[1][r] += o[1][r] * a; } else { dst[0][r] = o[0][r] * a; dst[1][r] = o[1][r] * a; } }
}

__device__ __forceinline__ void unit_dilated(LAS char* L, unsigned char* ws, int wid, int lane, int uid) {
    const int r32 = lane & 31, hi = lane >> 5;
    const int b = uid / 192, gi = (uid % 192) >> 6, x = uid & 63, j = x >> 4, y = x & 15;
    const int dil = gi == 0 ? 1 : (gi == 1 ? 4 : 16), res = gi == 0 ? 0 : (gi == 1 ? (y >> 2) : y), u = gi == 0 ? y : (gi == 1 ? (y & 3) : 0), head = gi * 4 + j;
    const bf16* z = (const bf16*)(ws + WS_Z);
    const bf16* base = z + ((size_t)b * SEQ + res) * ZP + head * 64;
    const size_t sr = (size_t)dil * ZP;
    const int i = 256 * u + 32 * wid + r32;
    bf16x8 qr[4];
#pragma unroll
    for (int d0 = 0; d0 < 4; ++d0) qr[d0] = *(const bf16x8*)(base + QC + (size_t)i * sr + d0 * 16 + hi * 8);
    Rows R; R.qhi = i; R.qlo = i - 128; R.hi_min = 256 * u + 32 * wid; R.hi_max = R.hi_min + 31; R.lo_min = R.hi_min - 128; R.lo_max = R.hi_max - 128;
    St s; st_init(s);
    stream_pv<false>(L, wid, lane, base + KC, sr, base + VC, sr, (4 * u - 2) > 0 ? 4 * u - 2 : 0, 4 * u + 3, qr, R, 0ull, 0, 0, s);
    float ltot; const float inv = st_invl(s, ltot);
    LAS float* wsf = (LAS float*)(L + LDS_WS) + wid * 64;
    f32x16 out[2]; scale_rows<false>(out, s.o, inv, wsf, r32, hi);
    float* dout = (float*)(ws + WS_DILO) + (size_t)gi * T * 256; float* dlse = (float*)(ws + WS_DILL) + (size_t)gi * T * 4;
    if (hi == 0) dlse[((size_t)b * SEQ + (size_t)i * dil + res) * 4 + j] = s.m + __log2f(ltot);
#pragma unroll
    for (int r = 0; r < 16; ++r) { const int q = crow(r, hi); const size_t tok = (size_t)b * SEQ + (size_t)(256 * u + 32 * wid + q) * dil + res;
        dout[tok * 256 + j * 64 + r32] = out[0][r]; dout[tok * 256 + j * 64 + 32 + r32] = out[1][r]; }
}
__device__ __forceinline__ void unit_moba(LAS char* L, unsigned char* ws, int wid, int lane, int uid) {
    const int r32 = lane & 31, hi = lane >> 5, b = uid >> 7, h = (uid >> 4) & 7, qb = uid & 15;
    const bf16* z = (const bf16*)(ws + WS_Z) + (size_t)b * SEQ * ZP;
    const int s = 256 * qb + 32 * wid + r32;
    bf16x8 qr[4];
#pragma unroll
    for (int d0 = 0; d0 < 4; ++d0) qr[d0] = *(const bf16x8*)(z + (size_t)s * ZP + QA + h * 64 + d0 * 16 + hi * 8);
    unsigned long long selm = 0ull;
    if (qb > 0) {
        const float* km = (const float*)(ws + WS_KMEAN) + ((size_t)(b * 8 + h) * 16) * 64;
        f32x16 g = f32x16{};
#pragma unroll
        for (int d0 = 0; d0 < 4; ++d0) {
            f32x4 a0 = {0.f, 0.f, 0.f, 0.f}, a1 = {0.f, 0.f, 0.f, 0.f};
            if (r32 < 16) { a0 = *(const f32x4*)(km + r32 * 64 + d0 * 16 + hi * 8); a1 = *(const f32x4*)(km + r32 * 64 + d0 * 16 + hi * 8 + 4); }
            const float v[8] = {a0[0], a0[1], a0[2], a0[3], a1[0], a1[1], a1[2], a1[3]};
            unsigned wh[4], wl[4];
#pragma unroll
            for (int e = 0; e < 4; ++e) { const unsigned h0 = f2bf(v[2 * e]), h1 = f2bf(v[2 * e + 1]); wh[e] = h0 | (h1 << 16);
                wl[e] = pk2(v[2 * e] - __builtin_bit_cast(float, h0 << 16), v[2 * e + 1] - __builtin_bit_cast(float, h1 << 16)); }
            typedef unsigned u32x4 __attribute__((ext_vector_type(4)));
            const u32x4 uh = {wh[0], wh[1], wh[2], wh[3]}, ul = {wl[0], wl[1], wl[2], wl[3]};
            g = FA_MFMA(__builtin_bit_cast(bf16x8, uh), qr[d0], g); g = FA_MFMA(__builtin_bit_cast(bf16x8, ul), qr[d0], g);
        }
        float gv[16];
#pragma unroll
        for (int r = 0; r < 8; ++r) { float x0, x1; half_pair(g[r], x0, x1); gv[8 * (r >> 2) + (r & 3)] = x0; gv[8 * (r >> 2) + 4 + (r & 3)] = x1; }
#pragma unroll
        for (int i = 0; i < 16; ++i) if (i >= qb) gv[i] = -INFINITY;
#pragma unroll
        for (int i = 0; i < 16; ++i) { int rank = 0;
#pragma unroll
            for (int jx = 0; jx < 16; ++jx) rank += (gv[jx] > gv[i] || (gv[jx] == gv[i] && jx < i)) ? 1 : 0;
            if (i < qb && rank < 3) selm |= (1ull << i); }
    }
    Rows R; R.qhi = s; R.qlo = NEGBIG; R.hi_min = 256 * qb + 32 * wid; R.hi_max = R.hi_min + 31; R.lo_min = NEGBIG; R.lo_max = NEGBIG;
    St st; st_init(st);
    stream_pv<true>(L, wid, lane, z + KA + h * 64, (size_t)ZP, z + VA + h * 64, (size_t)ZP, 0, 4 * qb + 3, qr, R, selm, 2, qb, st);
    float ltot; const float inv = st_invl(st, ltot);
    LAS float* wsf = (LAS float*)(L + LDS_WS) + wid * 64;
    f32x16 out[2]; scale_rows<false>(out, st.o, inv, wsf, r32, hi);
    bf16* mix = (bf16*)(ws + WS_MIX) + ((size_t)b * SEQ + 256 * qb + 32 * wid) * MIXW + h * 64;
#pragma unroll
    for (int r = 0; r < 16; ++r) { const int q = crow(r, hi); mix[(size_t)q * MIXW + r32] = (bf16)f2bf(out[0][r]); mix[(size_t)q * MIXW + 32 + r32] = (bf16)f2bf(out[1][r]); }
}
__device__ __forceinline__ void unit_nsa(LAS char* L, unsigned char* ws, int wid, int lane, int uid) {
    const int r32 = lane & 31, hi = lane >> 5, bh = uid >> 6, b = bh / 3, hk = bh % 3, tb = uid & 63;
    const int jt = r32 & 7, g = r32 >> 3, head = hk * 4 + g, s = 64 * tb + 8 * wid + jt, smin = 64 * tb + 8 * wid, smax = smin + 7;
    const bf16* z = (const bf16*)(ws + WS_Z) + (size_t)b * SEQ * ZP;
    LAS float* wsf = (LAS float*)(L + LDS_WS) + wid * 64;
    bf16x8 qr[4];
#pragma unroll
    for (int d0 = 0; d0 < 4; ++d0) qr[d0] = *(const bf16x8*)(z + (size_t)s * ZP + QB + head * 64 + d0 * 16 + hi * 8);
    const bf16* gp = z + (size_t)s * ZP + GB + head * 3;
    const float g0 = 1.f / (1.f + __expf(-bf1(gp[0]))), g1 = 1.f / (1.f + __expf(-bf1(gp[1]))), g2 = 1.f / (1.f + __expf(-bf1(gp[2])));
    f32x16 fin[2];
    const bf16* kc = (const bf16*)(ws + WS_KCMP) + ((size_t)(b * 3 + hk) * 256) * 64; const bf16* vc = (const bf16*)(ws + WS_VCMP) + ((size_t)(b * 3 + hk) * 256) * 64;
    const int ncv = s >= 31 ? ((s - 31) >> 4) + 1 : 0, ncv_lo = smin >= 31 ? ((smin - 31) >> 4) + 1 : 0, ncv_hi = smax >= 31 ? ((smax - 31) >> 4) + 1 : 0;
    const int ncv_blk = ((64 * tb + 63 - 31) >> 4) + 1, ct_hi = (ncv_blk - 1) >> 6;
    Rows Rc; Rc.qhi = ncv - 1; Rc.qlo = NEGBIG; Rc.hi_min = ncv_lo - 1; Rc.hi_max = ncv_hi - 1; Rc.lo_min = NEGBIG; Rc.lo_max = NEGBIG;
    St st; st_init(st);
    stream_pv<false>(L, wid, lane, kc, (size_t)64, vc, (size_t)64, 0, ct_hi, qr, Rc, 0ull, 0, 0, st);
    float ltot; const float invc = st_invl(st, ltot);
    scale_rows<false>(fin, st.o, invc * g0, wsf, r32, hi);
    {
        LAS float* ps = (LAS float*)(L + LDS_PS) + wid * 2048;
        for (int i = lane; i < 2048; i += 64) ps[i] = 0.f;
        const float mu = (st.m == -INFINITY) ? 0.f : st.m;
        const unsigned lds0 = (unsigned)(uintptr_t)L; const bf16* ksrc = kc + (size_t)lane * 64 + wid * 8; const unsigned kdst = lds0 + LDS_K + wid * 1024;
        const int n = ct_hi + 1;
        asm volatile("s_waitcnt vmcnt(0)" ::: "memory");
        glds16(ksrc, (unsigned)__builtin_amdgcn_readfirstlane(kdst)); if (n > 1) glds16(ksrc + 64 * 64, (unsigned)__builtin_amdgcn_readfirstlane(kdst + SLOTB));
        int slot = 0;
        for (int i = 0; i < n; ++i) {
            if (i + 1 < n) FA_WAIT_BAR(1); else FA_WAIT_BAR(0);
            if (i + 2 < n) { const int s2 = slot >= 1 ? slot - 1 : 2; glds16(ksrc + (size_t)(i + 2) * 64 * 64, (unsigned)__builtin_amdgcn_readfirstlane(kdst + s2 * SLOTB)); }
            const int kb = i * 64;
            if (kb <= Rc.hi_max) {
                f32x16 p0, p1; qk_tile(p0, p1, (lcp)L + LDS_K + slot * SLOTB, qr, r32, hi);
#pragma unroll
                for (int r = 0; r < 16; ++r) { const int k = kb + crow(r, hi);
                    float a = (k <= Rc.qhi) ? ex2(__builtin_fmaf(p0[r], SC2, -mu)) * invc : 0.f, c = (k + 32 <= Rc.qhi) ? ex2(__builtin_fmaf(p1[r], SC2, -mu)) * invc : 0.f;
                    a += __shfl_xor(a, 8); a += __shfl_xor(a, 16); c += __shfl_xor(c, 8); c += __shfl_xor(c, 16);
                    if (r32 < 8) { ps[r32 * 256 + k] = a; ps[r32 * 256 + k + 32] = c; } }
            }
            slot = slot == 2 ? 0 : slot + 1;
        }
        asm volatile("s_waitcnt lgkmcnt(0)\n\ts_barrier" ::: "memory");
    }
    unsigned long long selm = 0ull;
    {
        const LAS float* ps = (const LAS float*)(L + LDS_PS) + wid * 2048;
#pragma unroll 1
        for (int j = 0; j < 8; ++j) {
            const LAS float* pj = ps + j * 256;
            float imp = (pj[4 * lane] + pj[4 * lane + 1]) + (pj[4 * lane + 2] + (lane < 63 ? pj[4 * lane + 3] : 0.f)); if (lane > 0) imp += pj[4 * lane - 1];
            const bool valid = lane <= tb, forced = valid && (lane == 0 || lane > tb - 2);
            const float val = forced ? 1e30f : (valid ? imp : -1e30f);
            int rank = 0;
            for (int jj = 0; jj < 64; ++jj) { const float vj = __shfl(val, jj); rank += (vj > val || (vj == val && jj < lane)) ? 1 : 0; }
            const unsigned long long mk = __ballot(valid && rank < 16);
            if (jt == j) selm = mk;
        }
    }
    Rows Rs; Rs.qhi = s; Rs.qlo = NEGBIG; Rs.hi_min = smin; Rs.hi_max = smax; Rs.lo_min = NEGBIG; Rs.lo_max = NEGBIG;
    st_init(st);
    stream_pv<true>(L, wid, lane, z + KBS + hk * 64, (size_t)ZP, z + VBS + hk * 64, (size_t)ZP, 0, tb, qr, Rs, selm, 0, tb, st);
    { const float inv = st_invl(st, ltot); scale_rows<true>(fin, st.o, inv * g1, wsf, r32, hi); }
    Rows Rw; Rw.qhi = s; Rw.qlo = s - 511; Rw.hi_min = smin; Rw.hi_max = smax; Rw.lo_min = smin - 511; Rw.lo_max = smax - 511;
    st_init(st);
    stream_pv<false>(L, wid, lane, z + KBW + hk * 64, (size_t)ZP, z + VBW + hk * 64, (size_t)ZP, (tb - 8) > 0 ? tb - 8 : 0, tb, qr, Rw, 0ull, 0, 0, st);
    { const float inv = st_invl(st, ltot); scale_rows<true>(fin, st.o, inv * g2, wsf, r32, hi); }
    bf16* mix = (bf16*)(ws + WS_MIX) + ((size_t)b * SEQ + 64 * tb + 8 * wid) * MIXW + 512 + hk * 256;
#pragma unroll
    for (int r = 0; r < 16; ++r) { const int q = crow(r, hi); bf16* o = mix + (size_t)(q & 7) * MIXW + (q >> 3) * 64;
        o[r32] = (bf16)f2bf(fin[0][r]); o[32 + r32] = (bf16)f2bf(fin[1][r]); }
}
#undef FA_MFMA
}
__device__ const unsigned short P2_ORDER[640] = {63,127,191,255,319,383,62,126,190,254,318,382,61,125,189,253,317,381,60,124,188,252,316,380,59,123,187,251,315,379,58,122,186,250,314,378,57,121,185,249,313,377,56,120,184,248,312,376,55,119,183,247,311,375,54,118,182,246,310,374,53,117,181,245,309,373,52,116,180,244,308,372,51,115,179,243,307,371,50,114,178,242,306,370,49,113,177,241,305,369,48,112,176,240,304,368,47,111,175,239,303,367,46,110,174,238,302,366,399,415,431,447,463,479,495,511,527,543,559,575,591,607,623,639,45,109,173,237,301,365,44,108,172,236,300,364,43,107,171,235,299,363,42,106,170,234,298,362,398,414,430,446,462,478,494,510,526,542,558,574,590,606,622,638,41,105,169,233,297,361,40,104,168,232,296,360,39,103,167,231,295,359,38,102,166,230,294,358,397,413,429,445,461,477,493,509,525,541,557,573,589,605,621,637,37,101,165,229,293,357,36,100,164,228,292,356,35,99,163,227,291,355,34,98,162,226,290,354,396,412,428,444,460,476,492,508,524,540,556,572,588,604,620,636,33,97,161,225,289,353,32,96,160,224,288,352,395,411,427,443,459,475,491,507,523,539,555,571,587,603,619,635,31,95,159,223,287,351,30,94,158,222,286,350,29,93,157,221,285,349,28,92,156,220,284,348,394,410,426,442,458,474,490,506,522,538,554,570,586,602,618,634,27,91,155,219,283,347,26,90,154,218,282,346,25,89,153,217,281,345,24,88,152,216,280,344,393,409,425,441,457,473,489,505,521,537,553,569,585,601,617,633,23,87,151,215,279,343,22,86,150,214,278,342,21,85,149,213,277,341,20,84,148,212,276,340,392,408,424,440,456,472,488,504,520,536,552,568,584,600,616,632,19,83,147,211,275,339,18,82,146,210,274,338,17,81,145,209,273,337,16,80,144,208,272,336,391,407,423,439,455,471,487,503,519,535,551,567,583,599,615,631,15,79,143,207,271,335,14,78,142,206,270,334,390,406,422,438,454,470,486,502,518,534,550,566,582,598,614,630,13,77,141,205,269,333,12,76,140,204,268,332,11,75,139,203,267,331,10,74,138,202,266,330,389,405,421,437,453,469,485,501,517,533,549,565,581,597,613,629,9,73,137,201,265,329,8,72,136,200,264,328,7,71,135,199,263,327,388,404,420,436,452,468,484,500,516,532,548,564,580,596,612,628,6,70,134,198,262,326,5,69,133,197,261,325,387,403,419,435,451,467,483,499,515,531,547,563,579,595,611,627,4,68,132,196,260,324,3,67,131,195,259,323,386,402,418,434,450,466,482,498,514,530,546,562,578,594,610,626,2,66,130,194,258,322,1,65,129,193,257,321,385,401,417,433,449,465,481,497,513,529,545,561,577,593,609,625,0,64,128,192,256,320,384,400,416,432,448,464,480,496,512,528,544,560,576,592,608,624};

__device__ __forceinline__ int dequeue(unsigned* ctr, volatile LAS int* w, int tid) {
    if (tid == 0) *w = (int)__hip_atomic_fetch_add(ctr, 1u, __ATOMIC_RELAXED, __HIP_MEMORY_SCOPE_AGENT);
    __syncthreads(); const int v = *w; __syncthreads(); return __builtin_amdgcn_readfirstlane(v);
}
__device__ __forceinline__ void dil_combine(Frame& F) {
    const float* dout = (const float*)(F.ws + WS_DILO); const float* dlse = (const float*)(F.ws + WS_DILL); bf16* mix = (bf16*)(F.ws + WS_MIX);
    for (int i = F.gw * 64 + F.lane; i < T * 256; i += F.ngw * 64) { const int t = i >> 8, c = i & 255, j = c >> 6;
        const float l0 = dlse[(size_t)t * 4 + j], l1 = dlse[(size_t)T * 4 + (size_t)t * 4 + j], l2 = dlse[(size_t)2 * T * 4 + (size_t)t * 4 + j];
        const float mx = fmaxf(l0, fmaxf(l1, l2)), w0 = ex2(l0 - mx), w1 = ex2(l1 - mx), w2 = ex2(l2 - mx);
        const float o = w0 * dout[i] + w1 * dout[(size_t)T * 256 + i] + w2 * dout[(size_t)2 * T * 256 + i];
        mix[(size_t)t * MIXW + 1280 + c] = (bf16)f2bf(o / (w0 + w1 + w2)); }
}
__device__ __forceinline__ void load_router(Frame& F, const float* rw) {
    LAS float* rwt = (LAS float*)F.lds;
    for (int i = F.tid; i < 8192; i += 512) { const f32x4 v = ((const f32x4*)rw)[i]; const int k = i >> 2, e0 = (i & 3) * 4; rwt[(e0 + 0) * 2048 + k] = v.x; rwt[(e0 + 1) * 2048 + k] = v.y; rwt[(e0 + 2) * 2048 + k] = v.z; rwt[(e0 + 3) * 2048 + k] = v.w; }
    __syncthreads();
}
__device__ __forceinline__ void phase_ln1_router(Frame& F, const Args& a, int L) {
    load_router(F, a.in[I_RW]);
    const LAS f32x4* rwt4 = (const LAS f32x4*)F.lds; const int lane = F.lane;
    const float* y = (const float*)(F.ws + WS_Y); float* h32 = (float*)(F.ws + WS_H32); bf16* hb = (bf16*)(F.ws + WS_HB);
    int* tokc = (int*)(F.ws + WS_TOKC); int* toks = (int*)(F.ws + WS_TOKS); float* tokw = (float*)(F.ws + WS_TOKW);
    unsigned* cnt = (unsigned*)(F.ws + WS_CTL) + CW_CNT + L * 32;
    for (int m = F.gw; m < T; m += F.ngw) {
        f32x4 o[8]; ln_row(y + (size_t)m * D, a.in[I_LN1G] + (size_t)L * D, a.in[I_LN1B] + (size_t)L * D, h32 + (size_t)m * D, hb + (size_t)m * D, lane, o);
        float myl = 0.f;
#pragma unroll 1
        for (int e = 0; e < 16; ++e) { float s = 0.f;
#pragma unroll
            for (int j = 0; j < 8; ++j) { const f32x4 w = rwt4[e * 512 + j * 64 + lane]; s += (o[j].x * w.x + o[j].y * w.y) + (o[j].z * w.z + o[j].w * w.w); }
            s = wave_sum(s); if (lane == e) myl = s; }
        if (lane < 16) myl += a.in[I_RB][lane];
        float pe[16]; float mx = -1e30f;
#pragma unroll
        for (int e = 0; e < 16; ++e) { pe[e] = __shfl(myl, e); mx = fmaxf(mx, pe[e]); }
#pragma unroll
        for (int e = 0; e < 16; ++e) pe[e] = expf(pe[e] - mx);
        int gsel = 0; float gbest = -1.f; int i1s = 0, i2s = 1; float p1s = 0.f, p2s = 0.f;
#pragma unroll
        for (int g = 0; g < 4; ++g) {
            int i1 = 0; float p1 = pe[4 * g];
#pragma unroll
            for (int i = 1; i < 4; ++i) if (pe[4 * g + i] > p1) { p1 = pe[4 * g + i]; i1 = i; }
            int i2 = -1; float p2 = -1.f;
#pragma unroll
            for (int i = 0; i < 4; ++i) if (i != i1 && pe[4 * g + i] > p2) { p2 = pe[4 * g + i]; i2 = i; }
            const float sg = p1 + p2;
            if (sg > gbest) { gbest = sg; gsel = g; i1s = i1; i2s = i2; p1s = p1; p2s = p2; }
        }
        const int lo = i1s < i2s ? i1s : i2s, hi = i1s < i2s ? i2s : i1s;
        const float wlo = (i1s < i2s ? p1s : p2s) / (p1s + p2s), whi = (i1s < i2s ? p2s : p1s) / (p1s + p2s);
        const int pi = lo == 0 ? hi - 1 : (lo == 1 ? hi + 1 : 5);
        const int cls = gsel * 6 + pi;
        if (lane == 0) { const unsigned slot = __hip_atomic_fetch_add(cnt + cls, 1u, __ATOMIC_RELAXED, __HIP_MEMORY_SCOPE_AGENT); tokc[m] = cls; toks[m] = (int)slot; tokw[2 * m] = wlo; tokw[2 * m + 1] = whi; }
    }
    __syncthreads();
}
__device__ __forceinline__ void build_tiles(Frame& F, int L) {
    volatile LAS int* tab = (volatile LAS int*)(F.lds + TILE_OFF);
    if (F.tid == 0) { const unsigned* cnt = (const unsigned*)(F.ws + WS_CTL) + CW_CNT + L * 32; int off = 0, nt = 0;
        for (int c = 0; c < 24; ++c) { const int n = (int)cnt[c]; tab[64 + c] = off; const int k = (n + 255) >> 8; for (int i = 0; i < k && nt < MAXTILES; ++i) tab[nt++] = c; off += k * 256; }
        tab[64 + 24] = off; tab[96] = nt; }
    __syncthreads();
}
__device__ __forceinline__ void phase_gather(Frame& F, int L) {
    volatile LAS int* tab = (volatile LAS int*)(F.lds + TILE_OFF);
    const int* tokc = (const int*)(F.ws + WS_TOKC); const int* toks = (const int*)(F.ws + WS_TOKS); const float* tokw = (const float*)(F.ws + WS_TOKW);
    int* ptok = (int*)(F.ws + WS_PTOK); float* pw = (float*)(F.ws + WS_PW); const v4u* hb = (const v4u*)(F.ws + WS_HB); v4u* xp = (v4u*)(F.ws + WS_XP);
    const unsigned* cnt = (const unsigned*)(F.ws + WS_CTL) + CW_CNT + L * 32;
    if (F.bx < 24) { const int c = F.bx; const int lo = tab[64 + c] + (int)cnt[c], hi = tab[64 + c + 1]; for (int r = lo + F.tid; r < hi; r += 512) ptok[r] = -1; }
    for (int t = F.gw; t < T; t += F.ngw) {
        const int pos = tab[64 + tokc[t]] + toks[t];
#pragma unroll
        for (int j = 0; j < 4; ++j) xp[(size_t)pos * 256 + j * 64 + F.lane] = hb[(size_t)t * 256 + j * 64 + F.lane];
        if (F.lane == 0) { ptok[pos] = t; pw[2 * pos] = tokw[2 * t]; pw[2 * pos + 1] = tokw[2 * t + 1]; }
    }
}

constexpr int NPH_LAYER = 9, NPH = 1 + DEPTH * NPH_LAYER;
__global__ void __launch_bounds__(512, 2) fwd(Args args) {
    extern __shared__ __attribute__((aligned(16))) unsigned char lds[];
    const int wave0 = __builtin_amdgcn_readfirstlane(threadIdx.x >> 6);
#define MKFRAME(F) Frame F; { int w_ = wave0; asm volatile("" : "+s"(w_)); int l_; asm volatile("v_mbcnt_lo_u32_b32 %0, -1, 0\n\tv_mbcnt_hi_u32_b32 %0, -1, %0" : "=v"(l_)); int t_ = w_ * 64 + l_; F.lds = (LAS unsigned char*)lds; F.tid = t_; F.lane = t_ & 63; F.wave = __builtin_amdgcn_readfirstlane(t_ >> 6); \
    int g_ = gridDim.x, b_ = blockIdx.x; asm volatile("" : "+s"(g_), "+s"(b_)); F.G = g_; F.bx = b_; F.gw = b_ * 8 + F.wave; F.ngw = g_ * 8; F.ws = args.ws; }
    MKFRAME(F);
    for (int u = F.tid; u < (LDS_BYTES - LDSCTL_OFF) / 4; u += 512) ((LAS unsigned*)(F.lds + LDSCTL_OFF))[u] = 0u;
    __syncthreads();
    volatile LAS unsigned* MISC = (volatile LAS unsigned*)(F.lds + MISC_OFF);
    XcdBarrier bar; bar.bar = (unsigned*)(F.ws + WS_CTL) + CW_BAR; bar.x = xb_xcc_id(); bar.st = MISC + 8;
    const int lo = args.ph_lo, hi = args.ph_hi;
    if (hi - lo > 1 && F.tid == 0) (void)xb_add(&bar.bar[XB_XCNT(bar.x)], 1u);
#ifndef PH_MASK
#define PH_MASK 0x3ff
#endif
#define IN(k) (lo <= (k) && (k) < hi)
#define EN(b) ((PH_MASK >> (b)) & 1)
#define SEAM(k) do { if (IN((k) + 1)) { MKFRAME(Fb_); xcd_barrier(bar, Fb_.tid); } } while (0)
    PG8_LAS unsigned char* ring = (PG8_LAS unsigned char*)lds;

    if (EN(9) && IN(0)) { MKFRAME(F0); phase_prologue(F0, args); SEAM(0); }

    for (int L = 0; L < DEPTH; ++L) {
        const int p0 = 1 + L * NPH_LAYER;
        unsigned char* wl = args.ws + WS_W + (size_t)L * LW_STRIDE;
        if (EN(0) && IN(p0 + 0)) {
            MKFRAME(F);
            pg8::SchedDense S; S.A = (const char*)(F.ws + WS_HB); S.Bt = (const char*)(wl + LW_IN); S.tA = (size_t)256 * D * 2; S.tB = (size_t)256 * D * 2; S.so.init(T, ZP, F.G, F.bx);
            EpiZ E{(bf16*)(F.ws + WS_Z), (const float*)(F.ws + WS_CS)};
            pg8::gemm_phase<EpiZ, pg8::SchedDense, true>(ring, F.tid, D, D, D / 64, D / 64, S, E);
            SEAM(p0 + 0);
        }
        if (EN(1) && IN(p0 + 1)) {
            { MKFRAME(F1); for (int u = F1.bx; u < 384; u += F1.G) { MKFRAME(Fu); fa::unit_dilated((LAS char*)Fu.lds, Fu.ws, Fu.wave, Fu.lane, u); } }
            { MKFRAME(F1); phase_kmean(F1); } { MKFRAME(F1); phase_compress(F1, args, L); }
            SEAM(p0 + 1); }
        if (EN(2) && IN(p0 + 2)) {
            { MKFRAME(F2); unsigned* qh = (unsigned*)(F2.ws + WS_CTL) + CW_Q + (L * 2) * 64; volatile LAS int* qw = (volatile LAS int*)(F2.lds + MISC_OFF + 64);
              for (;;) { const int k = dequeue(qh, qw, F2.tid); if (k >= 640) break; const int uid = P2_ORDER[k];
                  if (uid < 384) { MKFRAME(Fu); fa::unit_nsa((LAS char*)Fu.lds, Fu.ws, Fu.wave, Fu.lane, uid); } else { MKFRAME(Fu); fa::unit_moba((LAS char*)Fu.lds, Fu.ws, Fu.wave, Fu.lane, uid - 384); } } }
            { MKFRAME(F2); dil_combine(F2); }
            SEAM(p0 + 2); }
        if (EN(3) && IN(p0 + 3)) {
            MKFRAME(F);
            pg8::SchedDense S; S.A = (const char*)(F.ws + WS_MIX); S.Bt = (const char*)(wl + LW_OUT); S.tA = (size_t)256 * MIXW * 2; S.tB = (size_t)256 * MIXW * 2; S.so.init(T, D, F.G, F.bx);
            EpiRes E{(const float*)(F.ws + WS_H32), (float*)(F.ws + WS_Y)};
            pg8::gemm_phase<EpiRes, pg8::SchedDense, false>(ring, F.tid, MIXW, MIXW, MIXW / 64, MIXW / 64, S, E);
            SEAM(p0 + 3);
        }
        if (EN(4) && IN(p0 + 4)) { MKFRAME(F4); phase_ln1_router(F4, args, L); SEAM(p0 + 4); }
        if (EN(5) && IN(p0 + 5)) {
            { MKFRAME(F5); build_tiles(F5, L); phase_gather(F5, L); } __syncthreads();
            { MKFRAME(F); pg8::SchedDense S; S.A = (const char*)(F.ws + WS_PB) + (size_t)L * T * PLE * 2; S.Bt = (const char*)(wl + LW_PP); S.tA = (size_t)256 * PLE * 2; S.tB = (size_t)256 * PLE * 2; S.so.init(T, D, F.G, F.bx);
              EpiF32 E{(float*)(F.ws + WS_PPLE)};
              pg8::gemm_phase<EpiF32, pg8::SchedDense, false>(ring, F.tid, PLE, PLE, PLE / 64, PLE / 64, S, E); }
            { MKFRAME(F); pg8::SchedDense S; S.A = (const char*)(F.ws + WS_HB); S.Bt = (const char*)(wl + LW_PG); S.tA = (size_t)256 * D * 2; S.tB = (size_t)256 * D * 2; S.so.init(T, D, F.G, F.bx);
              EpiPle E{(const float*)(F.ws + WS_H32), (const float*)(F.ws + WS_PPLE), args.in[I_PGB] + (size_t)L * D, (float*)(F.ws + WS_Y)};
              pg8::gemm_phase<EpiPle, pg8::SchedDense, false>(ring, F.tid, D, D, D / 64, D / 64, S, E); }
            SEAM(p0 + 5);
        }
        if (EN(6) && IN(p0 + 6)) {
            MKFRAME(F); build_tiles(F, L);
            const volatile LAS int* tab = (const volatile LAS int*)(F.lds + TILE_OFF);
            SchedGU S{(const char*)(F.ws + WS_XP), (const char*)(wl + LW_GU), tab, F.G, F.bx, __builtin_amdgcn_readfirstlane(tab[96])};
            EpiGU E{(bf16*)(F.ws + WS_HID), (const float*)(F.ws + WS_PW)};
            pg8::gemm_phase<EpiGU, SchedGU, true>(ring, F.tid, D, D, D / 64, D / 64, S, E);
            SEAM(p0 + 6);
        }
        if (EN(7) && IN(p0 + 7)) {
            MKFRAME(F); build_tiles(F, L);
            const volatile LAS int* tab = (const volatile LAS int*)(F.lds + TILE_OFF);
            SchedDown S{(const char*)(F.ws + WS_HID), (const char*)(wl + LW_D), tab, F.G, F.bx, __builtin_amdgcn_readfirstlane(tab[96])};
            EpiDown E{(float*)(F.ws + WS_Y), (const int*)(F.ws + WS_PTOK)};
            pg8::gemm_phase<EpiDown, SchedDown, false>(ring, F.tid, 1024, EH, 16, 8, S, E);
            SEAM(p0 + 7);
        }
        if (EN(8) && IN(p0 + 8)) {
            const bool lastL = (L == DEPTH - 1); MKFRAME(F);
            for (int m = F.gw; m < T; m += F.ngw) { f32x4 o[8];
                ln_row((const float*)(F.ws + WS_Y) + (size_t)m * D, args.in[I_LN2G] + (size_t)L * D, args.in[I_LN2B] + (size_t)L * D,
                       lastL ? args.out + (size_t)m * D : (float*)(F.ws + WS_H32) + (size_t)m * D, lastL ? (bf16*)nullptr : (bf16*)(F.ws + WS_HB) + (size_t)m * D, F.lane, o); }
            SEAM(p0 + 8);
        }
    }
#undef IN
#undef SEAM
}

extern "C" void kernel_launch(void* const* d_in, const int* in_sizes, int n_in, void* d_out, int out_size, void* d_ws, size_t ws_size, hipStream_t stream) {
    static int grid = 0;
    if (grid == 0) {
        if (n_in != 25 || ws_size < WS_END) { fprintf(stderr, "kernel_launch: unexpected n_in %d / ws %zu\n", n_in, ws_size); grid = -1; return; }
        int dev = 0, cus = 0;
        if (hipGetDevice(&dev) != hipSuccess || hipDeviceGetAttribute(&cus, hipDeviceAttributeMultiprocessorCount, dev) != hipSuccess) { grid = -1; return; }
        if (hipFuncSetAttribute((const void*)fwd, hipFuncAttributeMaxDynamicSharedMemorySize, LDS_BYTES) != hipSuccess) { fprintf(stderr, "kernel_launch: hipFuncSetAttribute failed\n"); grid = -1; return; }
        int per_cu = 0; (void)hipOccupancyMaxActiveBlocksPerMultiprocessor(&per_cu, (const void*)fwd, 512, LDS_BYTES); (void)hipGetLastError();
        grid = cus;
    }
    if (grid < 0) return;
    (void)hipMemsetAsync((char*)d_ws + WS_CTL, 0, CTL_ZERO_BYTES, stream);
    Args a{};
    for (int i = 0; i < 25; ++i) a.in[i] = (const float*)d_in[i];
    a.out = (float*)d_out; a.ws = (unsigned char*)d_ws;
#if MK_SINGLE
    a.ph_lo = 0; a.ph_hi = NPH;
    hipLaunchKernelGGL(fwd, dim3(grid), dim3(512), LDS_BYTES, stream, a);
#else
    for (int p = 0; p < NPH; ++p) { a.ph_lo = p; a.ph_hi = p + 1; hipLaunchKernelGGL(fwd, dim3(grid), dim3(512), LDS_BYTES, stream, a); }
#endif
}
```

```cpp
#include <hip/hip_runtime.h>
#include <cstdio>
#include <cstdint>

#ifndef MK_SINGLE
#define MK_SINGLE 1
#endif

namespace pg8 {
#define PG8_LAS __attribute__((address_space(3)))
typedef unsigned short bf16_t;
typedef short bf16x8 __attribute__((ext_vector_type(8)));
typedef float f32x4 __attribute__((ext_vector_type(4)));
typedef unsigned u32x4 __attribute__((ext_vector_type(4)));
constexpr int BM = 256, BK = 64, HALF = 128, HTB = HALF * BK * 2, STAGE_BYTES = 8 * HTB, NXCD = 8, WGM = 8;

__host__ __device__ __forceinline__ int lds_byte(int r, int c) { const int st = (r >> 4) * 2 + (c >> 5), rr = r & 15, cc = c & 31, ob = rr * 64 + cc * 2; return st * 1024 + (ob ^ (((ob >> 9) & 1) << 5)); }
__host__ __device__ __forceinline__ void stage_rc(int b, int& R, int& C) { const int st = b / 1024, sb = b % 1024, swz = sb ^ (((sb >> 9) & 1) << 5); R = (st >> 1) * 16 + swz / 64; C = (st & 1) * 32 + (swz % 64) / 2; }
__host__ __device__ __forceinline__ int perm32(int rho) { const int n = rho >> 4, i = rho & 15; return 8 * (i >> 2) + 4 * n + (i & 3); }

struct Unit { const char* A; const char* B; const char* B2; int pm, pn, aux; };

struct StaticOrder {
    int nM, nN, nwg, G, c;
    __device__ void init(int M, int N, int G_, int c_) { nM = M / BM; nN = N / BM; nwg = nM * nN; G = G_; c = c_; }
    __device__ bool next(int i, int& pm, int& pn) const {
        const long L = (long)i * G + c; if (L >= nwg) return false;
        int wgid = (int)L; { const int q = nwg / NXCD, r = nwg % NXCD, xcd = wgid % NXCD, off = wgid / NXCD; wgid = (xcd < r ? xcd * (q + 1) : r * (q + 1) + (xcd - r) * q) + off; }
        const int nig = WGM * nN, gid = wgid / nig, fm = gid * WGM, gsz = (nM - fm) < WGM ? (nM - fm) : WGM;
        pm = fm + ((wgid % nig) % gsz); pn = (wgid % nig) / gsz; return true;
    }
};
struct SchedDense {
    const char* A; const char* Bt; size_t tA, tB; StaticOrder so;
    __device__ __forceinline__ bool next(int i, Unit& u) const { int pm, pn; if (!so.next(i, pm, pn)) return false; u.pm = pm; u.pn = pn; u.aux = 0; u.A = A + (size_t)pm * tA; u.B = Bt + (size_t)pn * tB; u.B2 = u.B; return true; }
};

__device__ __forceinline__ unsigned cvt_pk_bf16(float lo, float hi) { unsigned r; asm volatile("v_cvt_pk_bf16_f32 %0, %1, %2" : "=v"(r) : "v"(lo), "v"(hi)); return r; }

template <class Epi, class Sched, bool ALIGN_EPI>
__device__ __forceinline__ void gemm_phase(PG8_LAS unsigned char* lds, const int tid_in, const int lda, const int ldb, const int nt, const int ksplit, const Sched& S, const Epi& E) {
    int tid_ = tid_in; asm volatile("" : "+v"(tid_));
    const int tid = tid_, wid = __builtin_amdgcn_readfirstlane(tid >> 6), lane = tid & 63, wr = wid >> 2, wc = wid & 3, fr = lane & 15, fq = lane >> 4;
    unsigned voffA[2], voffB[2];
#pragma unroll
    for (int i = 0; i < 2; ++i) { int R, C; stage_rc(tid * 16 + i * 8192, R, C); const int Rb = Epi::PERM ? ((R & ~31) + perm32(R & 31)) : R;
        voffA[i] = (unsigned)(R * lda + C) * 2u; voffB[i] = (unsigned)(Rb * ldb + C) * 2u; }
    const size_t kstep = (size_t)(BK * 2);
    const size_t hA = (size_t)HALF * lda * 2, hB = (size_t)HALF * ldb * 2;
    const unsigned ldsw = (unsigned)wid * 1024u;
    const int aoff = lds_byte(wr * 64 + fr, fq * 8), boff = lds_byte(wc * 32 + fr, fq * 8);
#define PG8_SA(b, h) (((b) * 2 + (h)) * HTB)
#define PG8_SB(b, h) ((4 + (b) * 2 + (h)) * HTB)
#define PG8_STAGE(bufoff, gbase, voff) do { _Pragma("unroll") for (int _i = 0; _i < 2; ++_i) \
        __builtin_amdgcn_global_load_lds((const unsigned*)((const char*)(gbase) + (voff)[_i]), (PG8_LAS unsigned*)(lds + (bufoff) + ldsw + _i * 8192), 16, 0, 0); } while (0)
#define PG8_LDA(dst, b, h) do { _Pragma("unroll") for (int m = 0; m < 4; ++m) _Pragma("unroll") for (int k = 0; k < 2; ++k) dst[m][k] = *(const PG8_LAS bf16x8*)(lds + PG8_SA(b, h) + aoff + m * 2048 + k * 1024); } while (0)
#define PG8_LDB(dst, b, h) do { _Pragma("unroll") for (int n = 0; n < 2; ++n) _Pragma("unroll") for (int k = 0; k < 2; ++k) dst[n][k] = *(const PG8_LAS bf16x8*)(lds + PG8_SB(b, h) + boff + n * 2048 + k * 1024); } while (0)
#define PG8_MMA(ai, bj, At, Bt) do { __builtin_amdgcn_s_setprio(1); _Pragma("unroll") for (int m = 0; m < 4; ++m) _Pragma("unroll") for (int n = 0; n < 2; ++n) _Pragma("unroll") for (int k = 0; k < 2; ++k) \
        acc[ai][bj][m][n] = __builtin_amdgcn_mfma_f32_16x16x32_bf16(Bt[n][k], At[m][k], acc[ai][bj][m][n], 0, 0, 0); __builtin_amdgcn_s_setprio(0); } while (0)
#define PG8_WAIT_V(n) asm volatile("s_waitcnt vmcnt(" #n ")" ::: "memory")
#define PG8_WAIT_L(n) asm volatile("s_waitcnt lgkmcnt(" #n ")" ::: "memory")
#define PG8_BAR __builtin_amdgcn_s_barrier()
#define PG8_SCHED __builtin_amdgcn_sched_barrier(0)
    Unit cur, nxt; int ui = 0;
    if (!S.next(0, cur)) return;
    f32x4 acc[2][2][4][2];
#pragma unroll
    for (int a = 0; a < 2; ++a)
#pragma unroll
        for (int b = 0; b < 2; ++b)
#pragma unroll
            for (int m = 0; m < 4; ++m)
#pragma unroll
                for (int n = 0; n < 2; ++n) acc[a][b][m][n] = (f32x4){0.f, 0.f, 0.f, 0.f};
    bf16x8 At[4][2], B0[2][2], B1[2][2];
    const char* cA = cur.A; const char* cB = cur.B; const char* cB2 = cur.B2;
    PG8_STAGE(PG8_SB(0, 0), cB, voffB); PG8_STAGE(PG8_SB(0, 1), cB + hB, voffB); PG8_STAGE(PG8_SA(0, 0), cA, voffA); PG8_STAGE(PG8_SA(0, 1), cA + hA, voffA);
    if (wr == 1) PG8_BAR;
    PG8_WAIT_V(2); PG8_BAR;
    PG8_STAGE(PG8_SB(1, 0), cB + kstep, voffB); PG8_STAGE(PG8_SA(1, 0), cA + kstep, voffA); PG8_STAGE(PG8_SB(1, 1), cB + hB + kstep, voffB);
    PG8_WAIT_V(6); PG8_BAR;
    for (;;) {
        const bool has_next = S.next(ui + 1, nxt);
        const char* nA = has_next ? nxt.A : cA; const char* nB = has_next ? nxt.B : cB;
        for (int t = 0; t < nt; t += 2) {
            const bool last = (t == nt - 2);
            const int t2 = t + 2;
            const char* a1 = cA + (size_t)(t + 1) * kstep;
            const char* a2 = last ? nA : cA + (size_t)t2 * kstep;
            const char* b2 = last ? nB : (t2 < ksplit ? cB + (size_t)t2 * kstep : cB2 + (size_t)(t2 - ksplit) * kstep);
            const char* a3 = a2 + kstep; const char* b3 = b2 + kstep;
            PG8_LDB(B0, 0, 0); PG8_LDB(B1, 0, 1); PG8_SCHED; PG8_LDA(At, 0, 0); PG8_STAGE(PG8_SA(1, 1), a1 + hA, voffA);
            PG8_WAIT_V(8); PG8_WAIT_L(0); PG8_BAR; PG8_MMA(0, 0, At, B0); PG8_MMA(0, 1, At, B1); PG8_BAR; PG8_SCHED;
            PG8_LDA(At, 0, 1); PG8_STAGE(PG8_SB(0, 0), b2, voffB); PG8_STAGE(PG8_SB(0, 1), b2 + hB, voffB); PG8_STAGE(PG8_SA(0, 0), a2, voffA);
            PG8_WAIT_V(8); PG8_WAIT_L(0); PG8_BAR; PG8_MMA(1, 0, At, B0); PG8_MMA(1, 1, At, B1); PG8_BAR; PG8_SCHED;
            PG8_LDB(B0, 1, 0); PG8_LDB(B1, 1, 1); PG8_SCHED; PG8_LDA(At, 1, 0); PG8_STAGE(PG8_SA(0, 1), a2 + hA, voffA);
            PG8_WAIT_V(8); PG8_WAIT_L(0); PG8_BAR; PG8_MMA(0, 0, At, B0); PG8_MMA(0, 1, At, B1); PG8_BAR; PG8_SCHED;
            PG8_LDA(At, 1, 1); PG8_STAGE(PG8_SB(1, 0), b3, voffB); PG8_STAGE(PG8_SB(1, 1), b3 + hB, voffB); PG8_STAGE(PG8_SA(1, 0), a3, voffA);
            PG8_WAIT_V(8); PG8_WAIT_L(0); PG8_BAR; PG8_MMA(1, 0, At, B0); PG8_MMA(1, 1, At, B1); PG8_BAR; PG8_SCHED;
        }
        if constexpr (ALIGN_EPI) { if (wr == 0) PG8_BAR; }
        E(acc, cur, wr, wc, fr, fq);
        if (!has_next) break;
#pragma unroll
        for (int a = 0; a < 2; ++a)
#pragma unroll
            for (int b = 0; b < 2; ++b)
#pragma unroll
                for (int m = 0; m < 4; ++m)
#pragma unroll
                    for (int n = 0; n < 2; ++n) acc[a][b][m][n] = (f32x4){0.f, 0.f, 0.f, 0.f};
        cur = nxt; cA = nA; cB = nB; cB2 = nxt.B2; ++ui;
        if constexpr (ALIGN_EPI) { if (wr == 1) PG8_BAR; }
    }
    PG8_WAIT_V(0);
    if constexpr (!ALIGN_EPI) { if (wr == 0) PG8_BAR; }
    PG8_BAR;
#undef PG8_SA
#undef PG8_SB
#undef PG8_STAGE
#undef PG8_LDA
#undef PG8_LDB
#undef PG8_MMA
#undef PG8_WAIT_V
#undef PG8_WAIT_L
#undef PG8_BAR
#undef PG8_SCHED
}
}

constexpr int BATCH = 2, SEQ = 4096, T = BATCH * SEQ, D = 2048, DEPTH = 4;
constexpr int ZP = 5888;
constexpr int MIXW = 1536;
constexpr int NEXP = 16, EH = 512, PLE = 256;
constexpr float LN_EPS = 1e-5f;
constexpr float ALPHA = 1.681792830507429f;
constexpr float SC2 = 0.125f * 1.4426950408889634f;
constexpr int QA = 0, KA = 512, VA = 1024, QB = 1536, KBC = 2304, VBC = 2496, KBS = 2688, VBS = 2880, KBW = 3072, VBW = 3264, QC = 3456, KC = 4224, VC = 4992, GB = 5760;
constexpr int MAXTILES = 56, TPAD = MAXTILES * 256;

constexpr size_t MiB = 1u << 20;
constexpr size_t WS_CTL = 0, CTL_ZERO_BYTES = 1 * MiB;
constexpr size_t WS_CS = 1 * MiB;
constexpr size_t WS_KMEAN = 2 * MiB;
constexpr size_t WS_KCMP = 3 * MiB;
constexpr size_t WS_VCMP = 4 * MiB;
constexpr size_t WS_TOKC = 5 * MiB;
constexpr size_t WS_TOKS = 5 * MiB + 64 * 1024;
constexpr size_t WS_TOKW = 5 * MiB + 128 * 1024;
constexpr size_t WS_PTOK = 6 * MiB;
constexpr size_t WS_PW = 6 * MiB + 128 * 1024;
constexpr size_t WS_W = 16 * MiB;
constexpr size_t LW_IN = 0, LW_OUT = LW_IN + (size_t)ZP * D * 2, LW_GU = LW_OUT + (size_t)D * MIXW * 2, LW_D = LW_GU + (size_t)NEXP * 1024 * D * 2,
                 LW_PG = LW_D + (size_t)NEXP * D * EH * 2, LW_PP = LW_PG + (size_t)D * D * 2, LW_C1 = LW_PP + (size_t)D * PLE * 2, LW_END = LW_C1 + (size_t)2 * 128 * 2048 * 2;
constexpr size_t LW_STRIDE = 136 * MiB;
static_assert(LW_END <= LW_STRIDE, "layer weights");
constexpr size_t WS_H32 = 560 * MiB, WS_HB = 624 * MiB, WS_Z = 656 * MiB, WS_Y = 748 * MiB, WS_MIX = 812 * MiB, WS_XP = 836 * MiB, WS_HID = 892 * MiB,
                 WS_PPLE = 920 * MiB, WS_PB = 984 * MiB, WS_END = 1000 * MiB;
static_assert(WS_W + 4 * LW_STRIDE <= WS_H32 && WS_Z + (size_t)T * ZP * 2 <= WS_Y && WS_XP + (size_t)TPAD * D * 2 <= WS_HID && WS_HID + (size_t)TPAD * 1024 * 2 <= WS_PPLE, "ws map");
constexpr int CW_BAR = 4096;
constexpr int CW_CNT = 16384;
constexpr int CW_Q = 20480;
constexpr size_t WS_DILO = WS_PPLE, WS_DILL = WS_PPLE + 32 * MiB;

constexpr int RING_BYTES = 131072, LDSCTL_OFF = RING_BYTES, MISC_OFF = LDSCTL_OFF + 320, TILE_OFF = LDSCTL_OFF + 1024;
constexpr int LDS_BYTES = 147456;

#define GAS __attribute__((address_space(1)))
#define LAS __attribute__((address_space(3)))
typedef unsigned short bf16;
typedef unsigned v4u __attribute__((ext_vector_type(4)));
typedef float f32x4 __attribute__((ext_vector_type(4)));
#define LDS_WAIT() asm volatile("s_waitcnt lgkmcnt(0)" ::: "memory")
__device__ __forceinline__ unsigned f2bf(float f) { unsigned u = __builtin_bit_cast(unsigned, f); return (u + 0x7fffu + ((u >> 16) & 1u)) >> 16; }
__device__ __forceinline__ unsigned pk2(float lo, float hi) { return f2bf(lo) | (f2bf(hi) << 16); }
__device__ __forceinline__ float bf_lo(unsigned u) { return __builtin_bit_cast(float, u << 16); }
__device__ __forceinline__ float bf_hi(unsigned u) { return __builtin_bit_cast(float, u & 0xffff0000u); }
__device__ __forceinline__ float bf1(bf16 u) { return __builtin_bit_cast(float, ((unsigned)u) << 16); }
__device__ __forceinline__ float ex2(float x) { return __builtin_amdgcn_exp2f(x); }

#define XB_TMO      128
#define XB_XCNT(j)  (256  + 64 * (j))
#define XB_XSUB(j)  (1280 + 64 * (j))
#define XB_XGEN(j)  (2304 + 64 * (j))
#define XB_TOP      3328
#define XB_TOPGEN   3392
#define XCD_BAR_WORDS 3456
#define XB_SPIN_CAP (1u << 18)
__device__ __forceinline__ unsigned xb_ld(unsigned* p)              { return __hip_atomic_load(p, __ATOMIC_RELAXED, __HIP_MEMORY_SCOPE_AGENT); }
__device__ __forceinline__ unsigned xb_add(unsigned* p, unsigned v) { return __hip_atomic_fetch_add(p, v, __ATOMIC_RELAXED, __HIP_MEMORY_SCOPE_AGENT); }
__device__ __forceinline__ unsigned xb_xcc_id() { return (unsigned)__builtin_amdgcn_s_getreg((3 << 11) | 20) & 0xFu; }
#define XB_SPIN(cond, bar) do { unsigned _sp = 0; while (cond) { __builtin_amdgcn_s_sleep(1); \
    if ((++_sp & 255u) == 0u) { if (xb_ld(&(bar)[XB_TMO])) break; if (_sp > XB_SPIN_CAP) { atomicAdd(&(bar)[XB_TMO], 1u); break; } } } } while (0)
struct XcdBarrier { unsigned* bar; unsigned x; volatile LAS unsigned* st; };
__device__ __forceinline__ XcdBarrier xcd_barrier_post(unsigned* bar, volatile LAS unsigned* st) {
    XcdBarrier b; b.bar = bar; b.x = xb_xcc_id(); b.st = st;
    if (threadIdx.x == 0) (void)xb_add(&bar[XB_XCNT(b.x)], 1u);
    return b;
}
__device__ __forceinline__ void xcd_barrier_complete(unsigned* bar, unsigned x, unsigned& nloc, unsigned& nx) {
    const unsigned G = gridDim.x * gridDim.y * gridDim.z;
    unsigned sum, cnt, mine, sp = 0u;
    for (;;) {
        sum = 0u; cnt = 0u; mine = 0u;
#pragma unroll
        for (unsigned j = 0; j < 16; ++j) { const unsigned c = xb_ld(&bar[XB_XCNT(j)]); sum += c; cnt += (c > 0u) ? 1u : 0u; mine = (j == x) ? c : mine; }
        if (sum == G) break;
        __builtin_amdgcn_s_sleep(1);
        if ((++sp & 255u) == 0u) { if (xb_ld(&bar[XB_TMO])) break; if (sp > XB_SPIN_CAP) { atomicAdd(&bar[XB_TMO], 1u); break; } }
    }
    nloc = mine > 0u ? mine : 1u; nx = cnt > 0u ? cnt : 1u;
}
__device__ __forceinline__ void xcd_barrier(const XcdBarrier& b, const int tid) {
    asm volatile("s_waitcnt vmcnt(0)" ::: "memory");
    __syncthreads();
    if (tid == 0) {
        unsigned* bar = b.bar;
        __builtin_amdgcn_s_waitcnt(0);
        unsigned nloc = b.st[0], nx = b.st[1];
        if (nloc == 0u) { xcd_barrier_complete(bar, b.x, nloc, nx); b.st[0] = nloc; b.st[1] = nx; }
        const unsigned old = xb_add(&bar[XB_XSUB(b.x)], 1u);
        const unsigned gen = old / nloc;
        if (old + 1u == (gen + 1u) * nloc) {
            __builtin_amdgcn_fence(__ATOMIC_RELEASE, "agent");
            asm volatile("s_waitcnt vmcnt(0)" ::: "memory");
            const unsigned og = xb_add(&bar[XB_TOP], 1u);
            const unsigned tg = og / nx;
            if (og + 1u == (tg + 1u) * nx) xb_add(&bar[XB_TOPGEN], 1u);
            else XB_SPIN(xb_ld(&bar[XB_TOPGEN]) == tg, bar);
            __builtin_amdgcn_fence(__ATOMIC_ACQUIRE, "agent");
            xb_add(&bar[XB_XGEN(b.x)], 1u);
            asm volatile("s_waitcnt vmcnt(0)" ::: "memory");
        } else {
            XB_SPIN(xb_ld(&bar[XB_XGEN(b.x)]) == gen, bar);
            __builtin_amdgcn_fence(__ATOMIC_ACQUIRE, "agent");
            asm volatile("s_waitcnt vmcnt(0)" ::: "memory");
        }
    }
    __syncthreads();
}

struct Args { const float* in[25]; float* out; unsigned char* ws; int ph_lo, ph_hi; };
enum { I_X = 0, I_P, I_POS, I_LNG, I_LNB, I_WIN, I_WOUT, I_CK1, I_CK2, I_PEK, I_CV1, I_CV2, I_PEV, I_LN1G, I_LN1B, I_RW, I_RB, I_WG, I_WU, I_WD, I_PP, I_PGW, I_PGB, I_LN2G, I_LN2B };

struct Frame {
    LAS unsigned char* lds;
    int tid, lane, wave, G, bx, gw, ngw;
    unsigned char* ws;
};

__device__ __forceinline__ float wave_sum(float v) {
#pragma unroll
    for (int o = 1; o < 64; o <<= 1) v += __shfl_xor(v, o);
    return v;
}
__device__ __forceinline__ float wave_max(float v) {
#pragma unroll
    for (int o = 1; o < 64; o <<= 1) v = fmaxf(v, __shfl_xor(v, o));
    return v;
}
template <int OFF> __device__ __forceinline__ void rs_step(float (&v)[64], int lane) {
    const bool up = (lane & OFF) != 0;
#pragma unroll
    for (int i = 0; i < OFF; ++i) { const float send = up ? v[i] : v[i + OFF]; const float keep = up ? v[i + OFF] : v[i]; v[i] = keep + __shfl_xor(send, OFF); }
}
__device__ __forceinline__ void reduce_scatter64(float (&v)[64], int lane) { rs_step<32>(v, lane); rs_step<16>(v, lane); rs_step<8>(v, lane); rs_step<4>(v, lane); rs_step<2>(v, lane); rs_step<1>(v, lane); }

template <int MAP>
__device__ __forceinline__ int rowmap(int n) {
    if (MAP == 1) return n < 3456 ? n : (n < 3492 ? n - 3456 + GB : n - 36);
    if (MAP == 2) return ((n >> 7) << 8) + (n & 127);
    if (MAP == 3) return ((n >> 7) << 8) + 128 + (n & 127);
    return n;
}
template <int MAP>
__device__ __forceinline__ void transpose_item(const float* W, int K, int N, bf16* WT, LAS float* scr, int item, int lane) {
    const int nblk = (N + 31) / 32, kb = item / nblk, nb = item % nblk, k0 = 64 * kb, n0 = 32 * nb;
    const int nn = n0 + (lane & 31); const bool okn = nn < N;
#pragma unroll 8
    for (int i = 0; i < 32; ++i) { const int kk = 2 * i + (lane >> 5); scr[kk * 33 + (lane & 31)] = okn ? W[(size_t)(k0 + kk) * N + nn] : 0.f; }
    LDS_WAIT(); asm volatile("" ::: "memory");
    const int c = lane & 7;
#pragma unroll
    for (int j = 0; j < 4; ++j) { const int n = (lane >> 3) + 8 * j; const LAS float* s = scr + (8 * c) * 33 + n;
        v4u o; o.x = pk2(s[0 * 33], s[1 * 33]); o.y = pk2(s[2 * 33], s[3 * 33]); o.z = pk2(s[4 * 33], s[5 * 33]); o.w = pk2(s[6 * 33], s[7 * 33]);
        if (n0 + n < N) *(v4u*)(WT + (size_t)rowmap<MAP>(n0 + n) * K + k0 + 8 * c) = o; }
    LDS_WAIT(); asm volatile("" ::: "memory");
}

__device__ __forceinline__ void ln_row(const float* src, const float* g, const float* b, float* dst32, bf16* dstb, int lane, f32x4 (&o)[8]) {
    const f32x4* xr = (const f32x4*)src + lane;
    f32x4 v[8]; float s = 0.f;
#pragma unroll
    for (int j = 0; j < 8; ++j) { v[j] = xr[64 * j]; s += (v[j].x + v[j].y) + (v[j].z + v[j].w); }
    const float mean = wave_sum(s) * (1.f / D); float s2 = 0.f;
#pragma unroll
    for (int j = 0; j < 8; ++j) { v[j] = v[j] - mean; s2 += (v[j].x * v[j].x + v[j].y * v[j].y) + (v[j].z * v[j].z + v[j].w * v[j].w); }
    const float rstd = 1.f / sqrtf(wave_sum(s2) * (1.f / D) + LN_EPS);
#pragma unroll
    for (int j = 0; j < 8; ++j) { const f32x4 gg = ((const f32x4*)g)[64 * j + lane], bb = ((const f32x4*)b)[64 * j + lane]; o[j] = v[j] * rstd * gg + bb; }
    if (dst32) {
#pragma unroll
        for (int j = 0; j < 8; ++j) ((f32x4*)dst32)[64 * j + lane] = o[j];
    }
    if (dstb) {
#pragma unroll
        for (int j = 0; j < 8; ++j) ((unsigned long long*)dstb)[64 * j + lane] = (unsigned long long)pk2(o[j].x, o[j].y) | ((unsigned long long)pk2(o[j].z, o[j].w) << 32);
    }
}

__device__ __forceinline__ void phase_prologue(Frame& F, const Args& a) {
    LAS float* scr = (LAS float*)(F.lds + F.wave * 16384);
    constexpr int N_IN = 32 * 182, N_OUT = 24 * 64, N_G1 = 32 * 16, N_D1 = 8 * 64, N_PG = 32 * 64, N_PP = 4 * 64;
    constexpr int N_C1 = 32 * 4;
    constexpr int PER_LAYER = N_IN + N_OUT + 16 * N_G1 * 2 + 16 * N_D1 + N_PG + N_PP + 2 * N_C1;
    for (int it = F.gw; it < DEPTH * PER_LAYER; it += F.ngw) {
        const int L = it / PER_LAYER; int r = it % PER_LAYER;
        unsigned char* wl = F.ws + WS_W + (size_t)L * LW_STRIDE;
        if (r < N_IN) { transpose_item<1>(a.in[I_WIN] + (size_t)L * D * 5796, D, 5796, (bf16*)(wl + LW_IN), scr, r, F.lane); continue; } r -= N_IN;
        if (r < N_OUT) { transpose_item<0>(a.in[I_WOUT] + (size_t)L * MIXW * D, MIXW, D, (bf16*)(wl + LW_OUT), scr, r, F.lane); continue; } r -= N_OUT;
        if (r < 16 * N_G1) { const int e = r / N_G1; transpose_item<2>(a.in[I_WG] + ((size_t)L * NEXP + e) * D * EH, D, EH, (bf16*)(wl + LW_GU) + (size_t)e * 1024 * D, scr, r % N_G1, F.lane); continue; } r -= 16 * N_G1;
        if (r < 16 * N_G1) { const int e = r / N_G1; transpose_item<3>(a.in[I_WU] + ((size_t)L * NEXP + e) * D * EH, D, EH, (bf16*)(wl + LW_GU) + (size_t)e * 1024 * D, scr, r % N_G1, F.lane); continue; } r -= 16 * N_G1;
        if (r < 16 * N_D1) { const int e = r / N_D1; transpose_item<0>(a.in[I_WD] + ((size_t)L * NEXP + e) * EH * D, EH, D, (bf16*)(wl + LW_D) + (size_t)e * D * EH, scr, r % N_D1, F.lane); continue; } r -= 16 * N_D1;
        if (r < N_PG) { transpose_item<0>(a.in[I_PGW] + (size_t)L * D * D, D, D, (bf16*)(wl + LW_PG), scr, r, F.lane); continue; } r -= N_PG;
        if (r < N_PP) { transpose_item<0>(a.in[I_PP] + (size_t)L * PLE * D, PLE, D, (bf16*)(wl + LW_PP), scr, r, F.lane); continue; } r -= N_PP;
        if (r < N_C1) { transpose_item<0>(a.in[I_CK1] + (size_t)L * 2048 * 128, 2048, 128, (bf16*)(wl + LW_C1), scr, r, F.lane); continue; } r -= N_C1;
        transpose_item<0>(a.in[I_CV1] + (size_t)L * 2048 * 128, 2048, 128, (bf16*)(wl + LW_C1) + 128 * 2048, scr, r, F.lane);
    }
    for (int i = F.gw * 64 + F.lane; i < DEPTH * 92 * (D / 8); i += F.ngw * 64) {
        const int L = i / (92 * (D / 8)), r = i % (92 * (D / 8));
        ((v4u*)(F.ws + WS_W + (size_t)L * LW_STRIDE + LW_IN + (size_t)5796 * D * 2))[r] = (v4u){0u, 0u, 0u, 0u};
    }
    { const f32x4* p4 = (const f32x4*)a.in[I_P]; unsigned long long* pb = (unsigned long long*)(F.ws + WS_PB);
      for (size_t i = (size_t)F.gw * 64 + F.lane; i < (size_t)DEPTH * T * PLE / 4; i += (size_t)F.ngw * 64) { const f32x4 v = p4[i]; pb[i] = (unsigned long long)pk2(v.x, v.y) | ((unsigned long long)pk2(v.z, v.w) << 32); } }
    { float* cs = (float*)(F.ws + WS_CS); const int* pos = (const int*)a.in[I_POS];
      for (int i = F.gw * 64 + F.lane; i < T * 8; i += F.ngw * 64) { const int t = i >> 3, j = i & 7;
          const float inv = expf((float)j * -1.6402954339981079f);
          const float ang = (float)pos[t] * inv;
          const double rev = (double)ang * 0.15915494309189535; const float fr = (float)(rev - floor(rev));
          cs[t * 16 + j] = __builtin_amdgcn_cosf(fr); cs[t * 16 + 8 + j] = __builtin_amdgcn_sinf(fr); } }
    for (int m = F.gw; m < T; m += F.ngw) { f32x4 o[8]; ln_row(a.in[I_X] + (size_t)m * D, a.in[I_LNG], a.in[I_LNB], (float*)(F.ws + WS_H32) + (size_t)m * D, (bf16*)(F.ws + WS_HB) + (size_t)m * D, F.lane, o); }
}

__device__ __forceinline__ bool rope_head(int hd) {
    const unsigned long long lo = 0xFFFFull | (0x7FFFull << 24) | (0x7ull << 42) | (0x7ull << 48) | (0x3FFull << 54), hi = 0x3FFFull;
    return hd < 64 ? ((lo >> hd) & 1ull) != 0ull : ((hi >> (hd - 64)) & 1ull) != 0ull;
}
struct EpiZ {
    static constexpr bool PERM = true;
    bf16* Z; const float* cs;
    __device__ __forceinline__ void operator()(const f32x4 (&acc)[2][2][4][2], const pg8::Unit& u, int wr, int wc, int fr, int fq) const {
        const int row0 = u.pm * 256 + wr * 64 + fr;
#pragma unroll
        for (int bj = 0; bj < 2; ++bj) {
            const int cb = u.pn * 256 + bj * 128 + wc * 32;
            const bool rp = ((wc & 1) == 0) && rope_head(cb >> 6);
#pragma unroll
            for (int ai = 0; ai < 2; ++ai)
#pragma unroll
                for (int m = 0; m < 4; ++m) {
                    const int row = row0 + ai * 128 + m * 16;
                    f32x4 v0 = acc[ai][bj][m][0], v1 = acc[ai][bj][m][1];
                    if (rp) {
                        f32x4 o0, o1;
#pragma unroll
                        for (int i = 0; i < 4; ++i) { o0[i] = __shfl_xor(v0[i], 16); o1[i] = __shfl_xor(v1[i], 16); }
                        const f32x4 c0 = *(const f32x4*)(cs + (size_t)row * 16), c1 = *(const f32x4*)(cs + (size_t)row * 16 + 4), s0 = *(const f32x4*)(cs + (size_t)row * 16 + 8), s1 = *(const f32x4*)(cs + (size_t)row * 16 + 12);
                        if (fq == 0) { v0 = v0 * c0 - o0 * s0; v1 = v1 * c1 - o1 * s1; }
                        else if (fq == 1) { v0 = v0 * c0 + o0 * s0; v1 = v1 * c1 + o1 * s1; }
                    }
                    v4u w; w.x = pg8::cvt_pk_bf16(v0[0], v0[1]); w.y = pg8::cvt_pk_bf16(v0[2], v0[3]); w.z = pg8::cvt_pk_bf16(v1[0], v1[1]); w.w = pg8::cvt_pk_bf16(v1[2], v1[3]);
                    *(v4u*)(Z + (size_t)row * ZP + cb + 8 * fq) = w;
                }
        }
    }
};
struct EpiRes {
    static constexpr bool PERM = false;
    const float* h; float* y;
    __device__ __forceinline__ void operator()(const f32x4 (&acc)[2][2][4][2], const pg8::Unit& u, int wr, int wc, int fr, int fq) const {
        const int row0 = u.pm * 256 + wr * 64 + fr, col0 = u.pn * 256 + wc * 32 + 4 * fq;
#pragma unroll
        for (int ai = 0; ai < 2; ++ai)
#pragma unroll
            for (int m = 0; m < 4; ++m) { const size_t off = (size_t)(row0 + ai * 128 + m * 16) * D + col0;
#pragma unroll
                for (int bj = 0; bj < 2; ++bj)
#pragma unroll
                    for (int n = 0; n < 2; ++n) { const size_t o = off + bj * 128 + n * 16; *(f32x4*)(y + o) = *(const f32x4*)(h + o) * ALPHA + acc[ai][bj][m][n]; } }
    }
};
struct EpiF32 {
    static constexpr bool PERM = false;
    float* C;
    __device__ __forceinline__ void operator()(const f32x4 (&acc)[2][2][4][2], const pg8::Unit& u, int wr, int wc, int fr, int fq) const {
        const int row0 = u.pm * 256 + wr * 64 + fr, col0 = u.pn * 256 + wc * 32 + 4 * fq;
#pragma unroll
        for (int ai = 0; ai < 2; ++ai)
#pragma unroll
            for (int m = 0; m < 4; ++m) { const size_t off = (size_t)(row0 + ai * 128 + m * 16) * D + col0;
#pragma unroll
                for (int bj = 0; bj < 2; ++bj)
#pragma unroll
                    for (int n = 0; n < 2; ++n) *(f32x4*)(C + off + bj * 128 + n * 16) = acc[ai][bj][m][n]; }
    }
};
struct EpiPle {
    static constexpr bool PERM = false;
    const float* h; const float* P; const float* bias; float* y2;
    __device__ __forceinline__ void operator()(const f32x4 (&acc)[2][2][4][2], const pg8::Unit& u, int wr, int wc, int fr, int fq) const {
        const int row0 = u.pm * 256 + wr * 64 + fr, col0 = u.pn * 256 + wc * 32 + 4 * fq;
#pragma unroll
        for (int bj = 0; bj < 2; ++bj)
#pragma unroll
            for (int n = 0; n < 2; ++n) { const f32x4 bv = *(const f32x4*)(bias + col0 + bj * 128 + n * 16);
#pragma unroll
                for (int ai = 0; ai < 2; ++ai)
#pragma unroll
                    for (int m = 0; m < 4; ++m) { const size_t o = (size_t)(row0 + ai * 128 + m * 16) * D + col0 + bj * 128 + n * 16;
                        const f32x4 x = acc[ai][bj][m][n] + bv; f32x4 sg;
#pragma unroll
                        for (int i = 0; i < 4; ++i) sg[i] = __builtin_amdgcn_rcpf(1.f + __expf(-x[i]));
                        *(f32x4*)(y2 + o) = *(const f32x4*)(h + o) * ALPHA + sg * *(const f32x4*)(P + o); } }
    }
};
struct EpiGU {
    static constexpr bool PERM = true;
    bf16* hid; const float* pw;
    __device__ __forceinline__ void operator()(const f32x4 (&acc)[2][2][4][2], const pg8::Unit& u, int wr, int wc, int fr, int fq) const {
        const int slot = u.aux, row0 = u.pm * 256 + wr * 64 + fr, cb = slot * 512 + u.pn * 128 + wc * 32 + 8 * fq;
#pragma unroll
        for (int ai = 0; ai < 2; ++ai)
#pragma unroll
            for (int m = 0; m < 4; ++m) { const int prow = row0 + ai * 128 + m * 16; const float w = pw[prow * 2 + slot];
                float r[8];
#pragma unroll
                for (int n = 0; n < 2; ++n)
#pragma unroll
                    for (int i = 0; i < 4; ++i) { const float g = acc[ai][0][m][n][i], up = acc[ai][1][m][n][i]; r[n * 4 + i] = g * __builtin_amdgcn_rcpf(1.f + __expf(-g)) * up * w; }
                v4u o; o.x = pg8::cvt_pk_bf16(r[0], r[1]); o.y = pg8::cvt_pk_bf16(r[2], r[3]); o.z = pg8::cvt_pk_bf16(r[4], r[5]); o.w = pg8::cvt_pk_bf16(r[6], r[7]);
                *(v4u*)(hid + (size_t)prow * 1024 + cb) = o; }
    }
};
struct EpiDown {
    static constexpr bool PERM = false;
    float* y2; const int* ptok;
    __device__ __forceinline__ void operator()(const f32x4 (&acc)[2][2][4][2], const pg8::Unit& u, int wr, int wc, int fr, int fq) const {
        const int row0 = u.pm * 256 + wr * 64 + fr, col0 = u.pn * 256 + wc * 32 + 4 * fq;
#pragma unroll
        for (int ai = 0; ai < 2; ++ai)
#pragma unroll
            for (int m = 0; m < 4; ++m) { const int tok = ptok[row0 + ai * 128 + m * 16];
                if (tok >= 0) { const size_t off = (size_t)tok * D + col0;
#pragma unroll
                    for (int bj = 0; bj < 2; ++bj)
#pragma unroll
                        for (int n = 0; n < 2; ++n) { float* p = y2 + off + bj * 128 + n * 16; *(f32x4*)p = *(const f32x4*)p + acc[ai][bj][m][n]; } } }
    }
};
struct SchedGU {
    const char* xp; const char* wgu; const volatile LAS int* tab; int G, c, ntiles;
    __device__ __forceinline__ bool next(int i, pg8::Unit& u) const {
        const int L = i * G + c; if (L >= ntiles * 8) return false;
        const int tile = L >> 3, pn = L & 7, cls = __builtin_amdgcn_readfirstlane(tab[tile]), g = cls / 6, pi = cls % 6;
        const int ea = 4 * g + (pi < 3 ? 0 : (pi < 5 ? 1 : 2)), eb = 4 * g + (pi == 0 ? 1 : ((pi == 1 || pi == 3) ? 2 : 3));
        const int slot = pn >> 2, j = pn & 3, e = slot ? eb : ea;
        u.pm = tile; u.pn = j; u.aux = slot; u.A = xp + (size_t)tile * 256 * D * 2; u.B = wgu + ((size_t)e * 1024 + (size_t)j * 256) * D * 2; u.B2 = u.B; return true;
    }
};
struct SchedDown {
    const char* hid; const char* wd; const volatile LAS int* tab; int G, c, ntiles;
    __device__ __forceinline__ bool next(int i, pg8::Unit& u) const {
        const int L = i * G + c; if (L >= ntiles * 8) return false;
        const int tile = L >> 3, pn = L & 7, cls = __builtin_amdgcn_readfirstlane(tab[tile]), g = cls / 6, pi = cls % 6;
        const int ea = 4 * g + (pi < 3 ? 0 : (pi < 5 ? 1 : 2)), eb = 4 * g + (pi == 0 ? 1 : ((pi == 1 || pi == 3) ? 2 : 3));
        u.pm = tile; u.pn = pn; u.aux = 0; u.A = hid + (size_t)tile * 256 * 1024 * 2;
        u.B = wd + ((size_t)ea * D + (size_t)pn * 256) * EH * 2; u.B2 = wd + ((size_t)eb * D + (size_t)pn * 256) * EH * 2; return true;
    }
};

__device__ __forceinline__ void load_row64(const bf16* p, float (&q)[64]) {
    const v4u* pp = (const v4u*)p;
#pragma unroll
    for (int c = 0; c < 8; ++c) { const v4u u = pp[c]; q[8 * c + 0] = bf_lo(u.x); q[8 * c + 1] = bf_hi(u.x); q[8 * c + 2] = bf_lo(u.y); q[8 * c + 3] = bf_hi(u.y);
        q[8 * c + 4] = bf_lo(u.z); q[8 * c + 5] = bf_hi(u.z); q[8 * c + 6] = bf_lo(u.w); q[8 * c + 7] = bf_hi(u.w); }
}
__device__ __forceinline__ float dot_row64(const float (&q)[64], const bf16* p) {
    const v4u* pp = (const v4u*)p; float s0 = 0.f, s1 = 0.f, s2 = 0.f, s3 = 0.f;
#pragma unroll
    for (int c = 0; c < 8; ++c) { const v4u u = pp[c];
        s0 += q[8 * c + 0] * bf_lo(u.x) + q[8 * c + 1] * bf_hi(u.x); s1 += q[8 * c + 2] * bf_lo(u.y) + q[8 * c + 3] * bf_hi(u.y);
        s2 += q[8 * c + 4] * bf_lo(u.z) + q[8 * c + 5] * bf_hi(u.z); s3 += q[8 * c + 6] * bf_lo(u.w) + q[8 * c + 7] * bf_hi(u.w); }
    return (s0 + s1) + (s2 + s3);
}
struct WAcc { float m, l; float a[64]; };
__device__ __forceinline__ void wacc_init(WAcc& A) { A.m = -1e30f; A.l = 0.f;
#pragma unroll
    for (int d = 0; d < 64; ++d) A.a[d] = 0.f; }
__device__ __forceinline__ void wacc_key(WAcc& A, float s2, const bf16* vrow) {
    const float mn = fmaxf(A.m, s2), f = ex2(A.m - mn), p = ex2(s2 - mn); A.m = mn; A.l = A.l * f + p;
    const v4u* pp = (const v4u*)vrow;
#pragma unroll
    for (int c = 0; c < 8; ++c) { const v4u u = pp[c];
        A.a[8 * c + 0] = A.a[8 * c + 0] * f + p * bf_lo(u.x); A.a[8 * c + 1] = A.a[8 * c + 1] * f + p * bf_hi(u.x);
        A.a[8 * c + 2] = A.a[8 * c + 2] * f + p * bf_lo(u.y); A.a[8 * c + 3] = A.a[8 * c + 3] * f + p * bf_hi(u.y);
        A.a[8 * c + 4] = A.a[8 * c + 4] * f + p * bf_lo(u.z); A.a[8 * c + 5] = A.a[8 * c + 5] * f + p * bf_hi(u.z);
        A.a[8 * c + 6] = A.a[8 * c + 6] * f + p * bf_lo(u.w); A.a[8 * c + 7] = A.a[8 * c + 7] * f + p * bf_hi(u.w); }
}
__device__ __forceinline__ float wacc_finish(WAcc& A, int lane, float& lse2) {
    const float M = wave_max(A.m), f = ex2(A.m - M), L = wave_sum(A.l * f);
#pragma unroll
    for (int d = 0; d < 64; ++d) A.a[d] *= f;
    reduce_scatter64(A.a, lane);
    lse2 = M + __log2f(L);
    return L > 0.f ? A.a[0] / L : 0.f;
}

__device__ __forceinline__ void phase_kmean(Frame& F) {
    const bf16* z = (const bf16*)(F.ws + WS_Z); float* km = (float*)(F.ws + WS_KMEAN); LAS float* red = (LAS float*)F.lds;
    for (int it = F.bx; it < 256; it += F.G) {
        const int b = it >> 7, h = (it >> 4) & 7, blk = it & 15, d = F.tid & 63, part = F.tid >> 6;
        const bf16* p = z + ((size_t)b * SEQ + blk * 256 + part * 32) * ZP + KA + h * 64 + d; float s = 0.f;
        bf16 kv_[32];
#pragma unroll
        for (int k = 0; k < 32; ++k) kv_[k] = p[(size_t)k * ZP];
#pragma unroll
        for (int k = 0; k < 32; ++k) s += bf1(kv_[k]);
        red[part * 64 + d] = s; __syncthreads();
        if (F.tid < 64) { float t = 0.f;
#pragma unroll
            for (int q = 0; q < 8; ++q) t += red[q * 64 + d];
            km[(size_t)it * 64 + d] = t * (1.f / 256.f); }
        __syncthreads();
    }
}
__device__ __forceinline__ float gelu_tanh(float x) { const float u = 0.7978845608028654f * (x + 0.044715f * x * x * x); const float e = __expf(2.f * u); const float th = 1.f - 2.f / (e + 1.f); return 0.5f * x * (1.f + th); }
__device__ __forceinline__ void unit_compress(Frame& F, const Args& a, int L, int uid) {
    typedef short bf16x8 __attribute__((ext_vector_type(8))); typedef float f32x16 __attribute__((ext_vector_type(16)));
    const int rb = uid & 7, bh = (uid >> 3) % 6, kv = uid / 48, b = bh / 3, hk = bh % 3, n0 = rb * 32;
    const int lane = F.lane, r32 = lane & 31, hi = lane >> 5, nt = F.wave & 3, kh = F.wave >> 2;
    const bf16* z = (const bf16*)(F.ws + WS_Z) + (size_t)b * SEQ * ZP + (kv ? VBC : KBC) + hk * 64;
    const bf16* w1t = (const bf16*)(F.ws + WS_W + (size_t)L * LW_STRIDE + LW_C1) + (size_t)kv * 128 * 2048;
    const float* pe = a.in[kv ? I_PEV : I_PEK] + (size_t)L * 2048; const float* W2 = a.in[kv ? I_CV2 : I_CK2] + (size_t)L * 128 * 64;
    LAS float* part = (LAS float*)F.lds;
    LAS float* w2s = (LAS float*)(F.lds + 32768);
    for (int i = F.tid; i < 2048; i += 512) ((LAS f32x4*)w2s)[i] = ((const f32x4*)W2)[i];
    const int n = (n0 + r32) < 255 ? (n0 + r32) : 254;
    const bf16* arow = z + (size_t)(16 * n) * ZP + hi * 8; const bf16* brow = w1t + (size_t)(nt * 32 + r32) * 2048 + hi * 8;
    f32x16 acc = f32x16{};
#pragma unroll 8
    for (int st = kh * 64; st < kh * 64 + 64; ++st) { const int j = st >> 2, d0 = st & 3;
        const v4u u = *(const v4u*)(arow + (size_t)j * ZP + d0 * 16); const f32x4 p0 = *(const f32x4*)(pe + j * 64 + d0 * 16 + hi * 8), p1 = *(const f32x4*)(pe + j * 64 + d0 * 16 + hi * 8 + 4);
        v4u av; av.x = pk2(bf_lo(u.x) + p0[0], bf_hi(u.x) + p0[1]); av.y = pk2(bf_lo(u.y) + p0[2], bf_hi(u.y) + p0[3]); av.z = pk2(bf_lo(u.z) + p1[0], bf_hi(u.z) + p1[1]); av.w = pk2(bf_lo(u.w) + p1[2], bf_hi(u.w) + p1[3]);
        const bf16x8 bv = *(const bf16x8*)(brow + st * 16);
        acc = __builtin_amdgcn_mfma_f32_32x32x16_bf16(__builtin_bit_cast(bf16x8, av), bv, acc, 0, 0, 0); }
#pragma unroll
    for (int r = 0; r < 16; ++r) part[(kh * 32 + (r & 3) + 8 * (r >> 2) + 4 * hi) * 128 + nt * 32 + r32] = acc[r];
    __syncthreads();
    for (int i = F.tid; i < 4096; i += 512) part[i] = gelu_tanh(part[i] + part[4096 + i]);
    __syncthreads();
    { const int row = F.tid >> 4, d4 = (F.tid & 15) * 4; f32x4 o = {0.f, 0.f, 0.f, 0.f};
#pragma unroll 8
      for (int c = 0; c < 128; ++c) { const float h = part[row * 128 + c]; const f32x4 w = *(const LAS f32x4*)(w2s + c * 64 + d4); o += w * h; }
      bf16* dst = (bf16*)(F.ws + (kv ? WS_VCMP : WS_KCMP)) + ((size_t)bh * 256 + n0 + row) * 64 + d4;
      if (n0 + row >= 255) o = (f32x4){0.f, 0.f, 0.f, 0.f};
      *(unsigned long long*)dst = (unsigned long long)pk2(o[0], o[1]) | ((unsigned long long)pk2(o[2], o[3]) << 32); }
    __syncthreads();
}
__device__ __forceinline__ void phase_dilated(Frame& F) {
    const bf16* z = (const bf16*)(F.ws + WS_Z); bf16* mix = (bf16*)(F.ws + WS_MIX); const int lane = F.lane;
    for (int it = F.gw; it < T * 4; it += F.ngw) {
        const int t = it >> 2, j = it & 3, b = t / SEQ, s = t % SEQ;
        float og[3], ls[3];
#pragma unroll
        for (int gi = 0; gi < 3; ++gi) {
            const int dil = gi == 0 ? 1 : (gi == 1 ? 4 : 16), head = gi * 4 + j;
            float q[64]; load_row64(z + (size_t)t * ZP + QC + head * 64, q);
            WAcc A; wacc_init(A);
            for (int k = lane; k <= 128; k += 64) { const int sk = s - k * dil;
                if (sk >= 0) { const bf16* kr = z + ((size_t)b * SEQ + sk) * ZP; const float sc = dot_row64(q, kr + KC + head * 64) * SC2; wacc_key(A, sc, kr + VC + head * 64); } }
            og[gi] = wacc_finish(A, lane, ls[gi]);
        }
        const float mx = fmaxf(ls[0], fmaxf(ls[1], ls[2])); const float w0 = ex2(ls[0] - mx), w1 = ex2(ls[1] - mx), w2 = ex2(ls[2] - mx);
        mix[(size_t)t * MIXW + 1280 + j * 64 + lane] = (bf16)f2bf((w0 * og[0] + w1 * og[1] + w2 * og[2]) / (w0 + w1 + w2));
    }
}
__device__ __forceinline__ void phase_moba(Frame& F) {
    const bf16* z = (const bf16*)(F.ws + WS_Z); bf16* mix = (bf16*)(F.ws + WS_MIX); const float* km = (const float*)(F.ws + WS_KMEAN); const int lane = F.lane;
    for (int it = F.gw; it < T * 8; it += F.ngw) {
        const int t = it >> 3, h = it & 7, b = t / SEQ, s = t % SEQ, cur = s >> 8;
        float q[64]; load_row64(z + (size_t)t * ZP + QA + h * 64, q);
        float gate = -1e30f;
        if (lane < cur) { const float* kmr = km + ((size_t)(b * 8 + h) * 16 + lane) * 64; float g = 0.f;
#pragma unroll
            for (int d = 0; d < 64; ++d) g += q[d] * kmr[d];
            gate = g; }
        int rank = 0;
        for (int jj = 0; jj < 16; ++jj) { const float gj = __shfl(gate, jj); rank += (gj > gate || (gj == gate && jj < lane)) ? 1 : 0; }
        const unsigned long long selm = __ballot(lane < cur && rank < 3);
        WAcc A; wacc_init(A);
        unsigned long long mm = selm;
        while (mm) { const int blk = __builtin_ctzll(mm); mm &= mm - 1;
            for (int i = 0; i < 4; ++i) { const bf16* kr = z + ((size_t)b * SEQ + blk * 256 + i * 64 + lane) * ZP; const float sc = dot_row64(q, kr + KA + h * 64) * SC2; wacc_key(A, sc, kr + VA + h * 64); } }
        for (int i = 0; i < 4; ++i) { const int sk = cur * 256 + i * 64 + lane;
            if (sk <= s) { const bf16* kr = z + ((size_t)b * SEQ + sk) * ZP; const float sc = dot_row64(q, kr + KA + h * 64) * SC2; wacc_key(A, sc, kr + VA + h * 64); } }
        float l2; const float o = wacc_finish(A, lane, l2);
        mix[(size_t)t * MIXW + h * 64 + lane] = (bf16)f2bf(o);
    }
}
__device__ __forceinline__ void phase_nsa(Frame& F) {
    const bf16* z = (const bf16*)(F.ws + WS_Z); bf16* mix = (bf16*)(F.ws + WS_MIX); const int lane = F.lane;
    LAS float* ps = (LAS float*)F.lds + F.wave * 320;
    for (int it = F.gw; it < T * 3; it += F.ngw) {
        const int t = it / 3, hk = it % 3, b = t / SEQ, s = t % SEQ, cur = s >> 6;
        const bf16* kc = (const bf16*)(F.ws + WS_KCMP) + ((size_t)(b * 3 + hk) * 256) * 64; const bf16* vc = (const bf16*)(F.ws + WS_VCMP) + ((size_t)(b * 3 + hk) * 256) * 64;
        const int ncv = s >= 31 ? ((s - 31) >> 4) + 1 : 0;
        float psum[4] = {0.f, 0.f, 0.f, 0.f}; float ocmp[4];
#pragma unroll
        for (int g = 0; g < 4; ++g) {
            float q[64]; load_row64(z + (size_t)t * ZP + QB + (hk * 4 + g) * 64, q);
            float sc[4]; float mx = -1e30f;
#pragma unroll
            for (int i = 0; i < 4; ++i) { const int n = lane + 64 * i; sc[i] = n < ncv ? dot_row64(q, kc + (size_t)n * 64) * SC2 : -1e30f; mx = fmaxf(mx, sc[i]); }
            mx = wave_max(mx); float p[4]; float ls = 0.f;
#pragma unroll
            for (int i = 0; i < 4; ++i) { const int n = lane + 64 * i; p[i] = n < ncv ? ex2(sc[i] - mx) : 0.f; ls += p[i]; }
            ls = wave_sum(ls); const float inv = ls > 0.f ? 1.f / ls : 0.f;
            float acc[64];
#pragma unroll
            for (int d = 0; d < 64; ++d) acc[d] = 0.f;
#pragma unroll
            for (int i = 0; i < 4; ++i) { const int n = lane + 64 * i; p[i] *= inv; psum[i] += p[i];
                if (n < ncv) { const v4u* pp = (const v4u*)(vc + (size_t)n * 64);
#pragma unroll
                    for (int c = 0; c < 8; ++c) { const v4u u = pp[c]; acc[8 * c + 0] += p[i] * bf_lo(u.x); acc[8 * c + 1] += p[i] * bf_hi(u.x); acc[8 * c + 2] += p[i] * bf_lo(u.y); acc[8 * c + 3] += p[i] * bf_hi(u.y);
                        acc[8 * c + 4] += p[i] * bf_lo(u.z); acc[8 * c + 5] += p[i] * bf_hi(u.z); acc[8 * c + 6] += p[i] * bf_lo(u.w); acc[8 * c + 7] += p[i] * bf_hi(u.w); } } }
            reduce_scatter64(acc, lane); ocmp[g] = acc[0];
        }
#pragma unroll
        for (int i = 0; i < 4; ++i) ps[lane + 64 * i] = (lane + 64 * i) < 255 ? psum[i] : 0.f;
        LDS_WAIT(); asm volatile("" ::: "memory");
        float imp = ps[4 * lane] + ps[4 * lane + 1] + ps[4 * lane + 2] + ps[4 * lane + 3]; if (lane > 0) imp += ps[4 * lane - 1];
        LDS_WAIT(); asm volatile("" ::: "memory");
        const bool valid = lane <= cur, forced = valid && (lane == 0 || lane > cur - 2);
        const float val = forced ? 1e30f : (valid ? imp : -1e30f);
        int rank = 0;
        for (int jj = 0; jj < 64; ++jj) { const float vj = __shfl(val, jj); rank += (vj > val || (vj == val && jj < lane)) ? 1 : 0; }
        const unsigned long long selm = __ballot(valid && rank < 16);
#pragma unroll
        for (int g = 0; g < 4; ++g) {
            const int head = hk * 4 + g;
            float q[64]; load_row64(z + (size_t)t * ZP + QB + head * 64, q);
            WAcc A; wacc_init(A);
            unsigned long long mm = selm;
            while (mm) { const int blk = __builtin_ctzll(mm); mm &= mm - 1; const int sk = blk * 64 + lane;
                if (sk <= s) { const bf16* kr = z + ((size_t)b * SEQ + sk) * ZP; const float scv = dot_row64(q, kr + KBS + hk * 64) * SC2; wacc_key(A, scv, kr + VBS + hk * 64); } }
            float l2; const float oslc = wacc_finish(A, lane, l2);
            wacc_init(A);
            for (int i = 0; i < 8; ++i) { const int sk = s - 511 + i * 64 + lane;
                if (sk >= 0) { const bf16* kr = z + ((size_t)b * SEQ + sk) * ZP; const float scv = dot_row64(q, kr + KBW + hk * 64) * SC2; wacc_key(A, scv, kr + VBW + hk * 64); } }
            const float owin = wacc_finish(A, lane, l2);
            const bf16* gp = z + (size_t)t * ZP + GB + head * 3;
            const float g0 = 1.f / (1.f + __expf(-bf1(gp[0]))), g1 = 1.f / (1.f + __expf(-bf1(gp[1]))), g2 = 1.f / (1.f + __expf(-bf1(gp[2])));
            mix[(size_t)t * MIXW + 512 + head * 64 + lane] = (bf16)f2bf(g0 * ocmp[g] + g1 * oslc + g2 * owin);
        }
    }
}

namespace fa {
typedef short bf16x8 __attribute__((ext_vector_type(8)));
typedef short s16x4 __attribute__((ext_vector_type(4)));
typedef float f32x16 __attribute__((ext_vector_type(16)));
typedef short v4i16_t __attribute__((ext_vector_type(4)));
constexpr int SLOTB = 8192, LDS_K = 0, LDS_V = 3 * SLOTB, LDS_WS = 6 * SLOTB, LDS_PS = LDS_WS + 8 * 256, LDS_SEL = LDS_PS + 8 * 8192, LDS_Q = LDS_SEL + 1024, LDS_END = LDS_Q + 64;
constexpr float THR = 8.f;
constexpr int NEGBIG = -(1 << 29);
#define FA_MFMA(a, b, c) __builtin_amdgcn_mfma_f32_32x32x16_bf16(a, b, c, 0, 0, 0)
typedef LAS const char* lcp;
__device__ __forceinline__ int crow(int r, int hi) { return (r & 3) + 8 * (r >> 2) + 4 * hi; }
__device__ __forceinline__ void glds16(const void* gsrc, unsigned lds_dst) { unsigned keep;
    asm volatile("s_mov_b32 %0, m0\n\ts_mov_b32 m0, %2\n\ts_nop 0\n\tglobal_load_lds_dwordx4 %1, off\n\ts_mov_b32 m0, %0" : "=&s"(keep) : "v"(gsrc), "s"(lds_dst) : "memory"); }
__device__ __forceinline__ s16x4 vtr(lcp p) { return __builtin_bit_cast(s16x4, __builtin_amdgcn_ds_read_tr16_b64_v4i16((LAS v4i16_t*)p)); }
__device__ __forceinline__ unsigned cvtpk(float lo, float hi) { typedef float f2 __attribute__((ext_vector_type(2))); typedef __bf16 b2 __attribute__((ext_vector_type(2))); f2 v = {lo, hi}; b2 b = __builtin_convertvector(v, b2); return __builtin_bit_cast(unsigned, b); }
__device__ __forceinline__ void half_pair(float v, float& x0, float& x1) { unsigned a = __builtin_bit_cast(unsigned, v), b = a;
    asm volatile("s_nop 1\n\tv_permlane32_swap_b32 %0, %1\n\ts_nop 1" : "+v"(a), "+v"(b));
    x0 = __builtin_bit_cast(float, a); x1 = __builtin_bit_cast(float, b); }
__device__ __forceinline__ float half_max(float v) { float x0, x1; half_pair(v, x0, x1); return fmaxf(x0, x1); }
__device__ __forceinline__ float half_sum(float v) { float x0, x1; half_pair(v, x0, x1); return x0 + x1; }
#define FA_WAIT_BAR(N) asm volatile("s_waitcnt vmcnt(" #N ") lgkmcnt(0)\n\ts_barrier" ::: "memory")

struct Rows { int qlo, qhi, lo_min, lo_max, hi_min, hi_max; };
struct St { float m, l; f32x16 o[2]; };
__device__ __forceinline__ void st_init(St& s) { s.m = -INFINITY; s.l = 0.f; s.o[0] = f32x16{}; s.o[1] = f32x16{}; }

__device__ __forceinline__ void qk_tile(f32x16& p0, f32x16& p1, lcp kslot, const bf16x8 (&qr)[4], int r32, int hi) {
    lcp kb = kslot + hi * 1024 + r32 * 16;
    p0 = f32x16{}; p1 = f32x16{};
#pragma unroll
    for (int d0 = 0; d0 < 4; ++d0) { const bf16x8 b0 = *(const LAS bf16x8*)(kb + d0 * 2048), b1 = *(const LAS bf16x8*)(kb + d0 * 2048 + 512);
        p0 = FA_MFMA(b0, qr[d0], p0); p1 = FA_MFMA(b1, qr[d0], p1); }
}
__device__ __forceinline__ void band_mask(f32x16& p0, f32x16& p1, int kb, int hi, int qlo, int qhi) {
#pragma unroll
    for (int r = 0; r < 16; ++r) { const int k = kb + (r & 3) + 8 * (r >> 2) + 4 * hi;
        if (k > qhi || k < qlo) p0[r] = -INFINITY; if (k + 32 > qhi || k + 32 < qlo) p1[r] = -INFINITY; }
}
__device__ __forceinline__ void flash_step(St& s, f32x16& p0, f32x16& p1, lcp vslot, LAS float* wsf, int lane, int r32, int hi) {
    float mx = fmaxf(p0[0], p1[0]);
#pragma unroll
    for (int r = 1; r < 16; ++r) mx = fmaxf(mx, fmaxf(p0[r], p1[r]));
    mx = half_max(mx);
    const float t2 = mx * SC2;
    if (__any(t2 > s.m + THR)) {
        const float mn = fmaxf(s.m, t2);
        const float alpha = (mn == -INFINITY) ? 1.f : ex2(s.m - mn);
        s.l *= alpha; s.m = mn;
        if (hi == 0) wsf[r32] = alpha;
#pragma unroll
        for (int r = 0; r < 16; ++r) { const float a = wsf[crow(r, hi)]; s.o[0][r] *= a; s.o[1][r] *= a; }
    }
    const float mu = (s.m == -INFINITY) ? 0.f : s.m;
    float ls = 0.f;
#pragma unroll
    for (int r = 0; r < 16; ++r) { p0[r] = ex2(__builtin_fmaf(p0[r], SC2, -mu)); p1[r] = ex2(__builtin_fmaf(p1[r], SC2, -mu)); ls += p0[r] + p1[r]; }
    s.l += ls;
    typedef unsigned u32x4 __attribute__((ext_vector_type(4)));
    const u32x4 w0 = {cvtpk(p0[0], p0[1]), cvtpk(p0[2], p0[3]), cvtpk(p0[4], p0[5]), cvtpk(p0[6], p0[7])}, w1 = {cvtpk(p0[8], p0[9]), cvtpk(p0[10], p0[11]), cvtpk(p0[12], p0[13]), cvtpk(p0[14], p0[15])};
    const u32x4 w2 = {cvtpk(p1[0], p1[1]), cvtpk(p1[2], p1[3]), cvtpk(p1[4], p1[5]), cvtpk(p1[6], p1[7])}, w3 = {cvtpk(p1[8], p1[9]), cvtpk(p1[10], p1[11]), cvtpk(p1[12], p1[13]), cvtpk(p1[14], p1[15])};
    const bf16x8 pa[4] = {__builtin_bit_cast(bf16x8, w0), __builtin_bit_cast(bf16x8, w1), __builtin_bit_cast(bf16x8, w2), __builtin_bit_cast(bf16x8, w3)};
    lcp vp = vslot + ((lane >> 4) & 1) * 32 + (lane & 3) * 8 + (4 * hi + ((lane & 15) >> 2)) * 64;
#pragma unroll
    for (int d0 = 0; d0 < 2; ++d0)
#pragma unroll
        for (int kg = 0; kg < 4; ++kg) { const s16x4 lo = vtr(vp + d0 * 4096 + kg * 1024), hh = vtr(vp + d0 * 4096 + kg * 1024 + 512);
            const bf16x8 vf = {lo[0], lo[1], lo[2], lo[3], hh[0], hh[1], hh[2], hh[3]};
            s.o[d0] = FA_MFMA(pa[kg], vf, s.o[d0]); }
}
template <bool USESEL>
__device__ __forceinline__ void stream_pv(LAS char* L, int wid, int lane, const bf16* Kb, size_t sK, const bf16* Vb, size_t sV, int t_lo, int t_hi,
                                          const bf16x8 (&qr)[4], const Rows& R, unsigned long long selm, int tpb_shift, int cur_blk, St& s) {
    const int r32 = lane & 31, hi = lane >> 5, n = t_hi - t_lo + 1;
    if (n <= 0) return;
    const unsigned lds0 = (unsigned)(uintptr_t)L;
    const bf16* ksrc = Kb + ((size_t)t_lo * 64 + lane) * sK + wid * 8;
    const bf16* vsrc = Vb + ((size_t)t_lo * 64 + 16 * (wid & 3) + (lane >> 2)) * sV + (wid >> 2) * 32 + (lane & 3) * 8;
    const unsigned kdst = lds0 + LDS_K + wid * 1024, vdst = lds0 + LDS_V + wid * 1024;
    LAS float* wsf = (LAS float*)(L + LDS_WS) + wid * 64;
#define FA_ISSUE(i, slot) do { glds16(ksrc + (size_t)(i) * 64 * sK, (unsigned)__builtin_amdgcn_readfirstlane(kdst + (slot) * SLOTB)); glds16(vsrc + (size_t)(i) * 64 * sV, (unsigned)__builtin_amdgcn_readfirstlane(vdst + (slot) * SLOTB)); } while (0)
    asm volatile("s_waitcnt vmcnt(0)" ::: "memory");
    FA_ISSUE(0, 0); if (n > 1) FA_ISSUE(1, 1);
    int slot = 0;
    for (int i = 0; i < n; ++i) {
        if (i + 1 < n) FA_WAIT_BAR(2); else FA_WAIT_BAR(0);
        if (i + 2 < n) { const int s2 = slot >= 1 ? slot - 1 : 2; FA_ISSUE(i + 2, s2); }
        const int t = t_lo + i, kb = t * 64;
        int mode; bool sel = true;
        if (USESEL && (t >> tpb_shift) < cur_blk) { sel = ((selm >> (t >> tpb_shift)) & 1ull) != 0ull; const unsigned long long bal = __ballot(sel); mode = bal == 0ull ? 0 : (bal == ~0ull ? 1 : 3); }
        else mode = (kb > R.hi_max || kb + 63 < R.lo_min) ? 0 : ((kb + 63 <= R.hi_min && kb >= R.lo_max) ? 1 : 2);
        if (mode != 0) {
            f32x16 p0, p1; qk_tile(p0, p1, (lcp)L + LDS_K + slot * SLOTB, qr, r32, hi);
            if (mode == 2) band_mask(p0, p1, kb, hi, R.qlo, R.qhi);
            if (mode == 3) {
#pragma unroll
                for (int r = 0; r < 16; ++r) { p0[r] = sel ? p0[r] : -INFINITY; p1[r] = sel ? p1[r] : -INFINITY; } }
            flash_step(s, p0, p1, (lcp)L + LDS_V + slot * SLOTB, wsf, lane, r32, hi);
        }
        slot = slot == 2 ? 0 : slot + 1;
    }
    asm volatile("s_waitcnt lgkmcnt(0)\n\ts_barrier" ::: "memory");
#undef FA_ISSUE
}
__device__ __forceinline__ float st_invl(const St& s, float& ltot) { ltot = half_sum(s.l); return ltot > 0.f ? 1.f / ltot : 0.f; }
template <bool ACCUM>
__device__ __forceinline__ void scale_rows(f32x16 (&dst)[2], const f32x16 (&o)[2], float fac, LAS float* wsf, int r32, int hi) {
    if (hi == 0) wsf[r32] = fac;
#pragma unroll
    for (int r = 0; r < 16; ++r) { const float a = wsf[crow(r, hi)]; if (ACCUM) { dst[0][r] += o[0][r] * a; dst[1][r] += o[1][r] * a; } else { dst[0][r] = o[0][r] * a; dst[1][r] = o[1][r] * a; } }
}

__device__ __forceinline__ void unit_dilated(LAS char* L, unsigned char* ws, int wid, int lane, int uid) {
    const int r32 = lane & 31, hi = lane >> 5;
    const int b = uid / 192, gi = (uid % 192) >> 6, x = uid & 63, j = x >> 4, y = x & 15;
    const int dil = gi == 0 ? 1 : (gi == 1 ? 4 : 16), res = gi == 0 ? 0 : (gi == 1 ? (y >> 2) : y), u = gi == 0 ? y : (gi == 1 ? (y & 3) : 0), head = gi * 4 + j;
    const bf16* z = (const bf16*)(ws + WS_Z);
    const bf16* base = z + ((size_t)b * SEQ + res) * ZP + head * 64;
    const size_t sr = (size_t)dil * ZP;
    const int i = 256 * u + 32 * wid + r32;
    bf16x8 qr[4];
#pragma unroll
    for (int d0 = 0; d0 < 4; ++d0) qr[d0] = *(const bf16x8*)(base + QC + (size_t)i * sr + d0 * 16 + hi * 8);
    asm volatile("s_waitcnt vmcnt(0)" : "+v"(qr[0]), "+v"(qr[1]), "+v"(qr[2]), "+v"(qr[3]) :: "memory");
    Rows R; R.qhi = i; R.qlo = i - 128; R.hi_min = 256 * u + 32 * wid; R.hi_max = R.hi_min + 31; R.lo_min = R.hi_min - 128; R.lo_max = R.hi_max - 128;
    St s; st_init(s);
    stream_pv<false>(L, wid, lane, base + KC, sr, base + VC, sr, (4 * u - 2) > 0 ? 4 * u - 2 : 0, 4 * u + 3, qr, R, 0ull, 0, 0, s);
    float ltot; const float inv = st_invl(s, ltot);
    LAS float* wsf = (LAS float*)(L + LDS_WS) + wid * 64;
    f32x16 out[2]; scale_rows<false>(out, s.o, inv, wsf, r32, hi);
    float* dout = (float*)(ws + WS_DILO) + (size_t)gi * T * 256; float* dlse = (float*)(ws + WS_DILL) + (size_t)gi * T * 4;
    if (hi == 0) dlse[((size_t)b * SEQ + (size_t)i * dil + res) * 4 + j] = s.m + __log2f(ltot);
#pragma unroll
    for (int r = 0; r < 16; ++r) { const int q = crow(r, hi); const size_t tok = (size_t)b * SEQ + (size_t)(256 * u + 32 * wid + q) * dil + res;
        dout[tok * 256 + j * 64 + r32] = out[0][r]; dout[tok * 256 + j * 64 + 32 + r32] = out[1][r]; }
}
__device__ __forceinline__ void unit_moba(LAS char* L, unsigned char* ws, int wid, int lane, int uid) {
    const int r32 = lane & 31, hi = lane >> 5, b = uid >> 7, h = (uid >> 4) & 7, qb = uid & 15;
    const bf16* z = (const bf16*)(ws + WS_Z) + (size_t)b * SEQ * ZP;
    const int s = 256 * qb + 32 * wid + r32;
    bf16x8 qr[4];
#pragma unroll
    for (int d0 = 0; d0 < 4; ++d0) qr[d0] = *(const bf16x8*)(z + (size_t)s * ZP + QA + h * 64 + d0 * 16 + hi * 8);
    asm volatile("s_waitcnt vmcnt(0)" : "+v"(qr[0]), "+v"(qr[1]), "+v"(qr[2]), "+v"(qr[3]) :: "memory");
    unsigned long long selm = 0ull;
    if (qb > 0) {
        const float* km = (const float*)(ws + WS_KMEAN) + ((size_t)(b * 8 + h) * 16) * 64;
        f32x16 g = f32x16{};
#pragma unroll
        for (int d0 = 0; d0 < 4; ++d0) {
            f32x4 a0 = {0.f, 0.f, 0.f, 0.f}, a1 = {0.f, 0.f, 0.f, 0.f};
            if (r32 < 16) { a0 = *(const f32x4*)(km + r32 * 64 + d0 * 16 + hi * 8); a1 = *(const f32x4*)(km + r32 * 64 + d0 * 16 + hi * 8 + 4); }
            const float v[8] = {a0[0], a0[1], a0[2], a0[3], a1[0], a1[1], a1[2], a1[3]};
            unsigned wh[4], wl[4];
#pragma unroll
            for (int e = 0; e < 4; ++e) { const unsigned h0 = f2bf(v[2 * e]), h1 = f2bf(v[2 * e + 1]); wh[e] = h0 | (h1 << 16);
                wl[e] = pk2(v[2 * e] - __builtin_bit_cast(float, h0 << 16), v[2 * e + 1] - __builtin_bit_cast(float, h1 << 16)); }
            typedef unsigned u32x4 __attribute__((ext_vector_type(4)));
            const u32x4 uh = {wh[0], wh[1], wh[2], wh[3]}, ul = {wl[0], wl[1], wl[2], wl[3]};
            g = FA_MFMA(__builtin_bit_cast(bf16x8, uh), qr[d0], g); g = FA_MFMA(__builtin_bit_cast(bf16x8, ul), qr[d0], g);
        }
        float gv[16];
#pragma unroll
        for (int r = 0; r < 8; ++r) { float x0, x1; half_pair(g[r], x0, x1); gv[8 * (r >> 2) + (r & 3)] = x0; gv[8 * (r >> 2) + 4 + (r & 3)] = x1; }
#pragma unroll
        for (int i = 0; i < 16; ++i) if (i >= qb) gv[i] = -INFINITY;
#pragma unroll
        for (int i = 0; i < 16; ++i) { int rank = 0;
#pragma unroll
            for (int jx = 0; jx < 16; ++jx) rank += (gv[jx] > gv[i] || (gv[jx] == gv[i] && jx < i)) ? 1 : 0;
            if (i < qb && rank < 3) selm |= (1ull << i); }
    }
    Rows R; R.qhi = s; R.qlo = NEGBIG; R.hi_min = 256 * qb + 32 * wid; R.hi_max = R.hi_min + 31; R.lo_min = NEGBIG; R.lo_max = NEGBIG;
    St st; st_init(st);
    stream_pv<true>(L, wid, lane, z + KA + h * 64, (size_t)ZP, z + VA + h * 64, (size_t)ZP, 0, 4 * qb + 3, qr, R, selm, 2, qb, st);
    float ltot; const float inv = st_invl(st, ltot);
    LAS float* wsf = (LAS float*)(L + LDS_WS) + wid * 64;
    f32x16 out[2]; scale_rows<false>(out, st.o, inv, wsf, r32, hi);
    bf16* mix = (bf16*)(ws + WS_MIX) + ((size_t)b * SEQ + 256 * qb + 32 * wid) * MIXW + h * 64;
#pragma unroll
    for (int r = 0; r < 16; ++r) { const int q = crow(r, hi); mix[(size_t)q * MIXW + r32] = (bf16)f2bf(out[0][r]); mix[(size_t)q * MIXW + 32 + r32] = (bf16)f2bf(out[1][r]); }
}
__device__ __forceinline__ void unit_nsa(LAS char* L, unsigned char* ws, int wid, int lane, int uid) {
    const int r32 = lane & 31, hi = lane >> 5, bh = uid >> 6, b = bh / 3, hk = bh % 3, tb = uid & 63;
    const int jt = r32 & 7, g = r32 >> 3, head = hk * 4 + g, s = 64 * tb + 8 * wid + jt, smin = 64 * tb + 8 * wid, smax = smin + 7;
    const bf16* z = (const bf16*)(ws + WS_Z) + (size_t)b * SEQ * ZP;
    LAS float* wsf = (LAS float*)(L + LDS_WS) + wid * 64;
    bf16x8 qr[4];
#pragma unroll
    for (int d0 = 0; d0 < 4; ++d0) qr[d0] = *(const bf16x8*)(z + (size_t)s * ZP + QB + head * 64 + d0 * 16 + hi * 8);
    asm volatile("s_waitcnt vmcnt(0)" : "+v"(qr[0]), "+v"(qr[1]), "+v"(qr[2]), "+v"(qr[3]) :: "memory");
    const bf16* gp = z + (size_t)s * ZP + GB + head * 3;
    const float g0 = 1.f / (1.f + __expf(-bf1(gp[0]))), g1 = 1.f / (1.f + __expf(-bf1(gp[1]))), g2 = 1.f / (1.f + __expf(-bf1(gp[2])));
    f32x16 fin[2];
    const bf16* kc = (const bf16*)(ws + WS_KCMP) + ((size_t)(b * 3 + hk) * 256) * 64; const bf16* vc = (const bf16*)(ws + WS_VCMP) + ((size_t)(b * 3 + hk) * 256) * 64;
    const int ncv = s >= 31 ? ((s - 31) >> 4) + 1 : 0, ncv_lo = smin >= 31 ? ((smin - 31) >> 4) + 1 : 0, ncv_hi = smax >= 31 ? ((smax - 31) >> 4) + 1 : 0;
    const int ncv_blk = ((64 * tb + 63 - 31) >> 4) + 1, ct_hi = (ncv_blk - 1) >> 6;
    Rows Rc; Rc.qhi = ncv - 1; Rc.qlo = NEGBIG; Rc.hi_min = ncv_lo - 1; Rc.hi_max = ncv_hi - 1; Rc.lo_min = NEGBIG; Rc.lo_max = NEGBIG;
    St st; st_init(st);
    stream_pv<false>(L, wid, lane, kc, (size_t)64, vc, (size_t)64, 0, ct_hi, qr, Rc, 0ull, 0, 0, st);
    float ltot; const float invc = st_invl(st, ltot);
    scale_rows<false>(fin, st.o, invc * g0, wsf, r32, hi);
    {
        LAS float* ps = (LAS float*)(L + LDS_PS) + wid * 2048;
        for (int i = lane; i < 2048; i += 64) ps[i] = 0.f;
        const float mu = (st.m == -INFINITY) ? 0.f : st.m;
        const unsigned lds0 = (unsigned)(uintptr_t)L; const bf16* ksrc = kc + (size_t)lane * 64 + wid * 8; const unsigned kdst = lds0 + LDS_K + wid * 1024;
        const int n = ct_hi + 1;
        asm volatile("s_waitcnt vmcnt(0)" ::: "memory");
        glds16(ksrc, (unsigned)__builtin_amdgcn_readfirstlane(kdst)); if (n > 1) glds16(ksrc + 64 * 64, (unsigned)__builtin_amdgcn_readfirstlane(kdst + SLOTB));
        int slot = 0;
        for (int i = 0; i < n; ++i) {
            if (i + 1 < n) FA_WAIT_BAR(1); else FA_WAIT_BAR(0);
            if (i + 2 < n) { const int s2 = slot >= 1 ? slot - 1 : 2; glds16(ksrc + (size_t)(i + 2) * 64 * 64, (unsigned)__builtin_amdgcn_readfirstlane(kdst + s2 * SLOTB)); }
            const int kb = i * 64;
            if (kb <= Rc.hi_max) {
                f32x16 p0, p1; qk_tile(p0, p1, (lcp)L + LDS_K + slot * SLOTB, qr, r32, hi);
#pragma unroll
                for (int r = 0; r < 16; ++r) { const int k = kb + crow(r, hi);
                    float a = (k <= Rc.qhi) ? ex2(__builtin_fmaf(p0[r], SC2, -mu)) * invc : 0.f, c = (k + 32 <= Rc.qhi) ? ex2(__builtin_fmaf(p1[r], SC2, -mu)) * invc : 0.f;
                    a += __shfl_xor(a, 8); a += __shfl_xor(a, 16); c += __shfl_xor(c, 8); c += __shfl_xor(c, 16);
                    if (r32 < 8) { ps[r32 * 256 + k] = a; ps[r32 * 256 + k + 32] = c; } }
            }
            slot = slot == 2 ? 0 : slot + 1;
        }
        asm volatile("s_waitcnt lgkmcnt(0)\n\ts_barrier" ::: "memory");
    }
    unsigned long long selm = 0ull;
    {
        const LAS float* ps = (const LAS float*)(L + LDS_PS) + wid * 2048;
#pragma unroll 1
        for (int j = 0; j < 8; ++j) {
            const LAS float* pj = ps + j * 256;
            float imp = (pj[4 * lane] + pj[4 * lane + 1]) + (pj[4 * lane + 2] + (lane < 63 ? pj[4 * lane + 3] : 0.f)); if (lane > 0) imp += pj[4 * lane - 1];
            const bool valid = lane <= tb, forced = valid && (lane == 0 || lane > tb - 2);
            const float val = forced ? 1e30f : (valid ? imp : -1e30f);
            int rank = 0;
            for (int jj = 0; jj < 64; ++jj) { const float vj = __shfl(val, jj); rank += (vj > val || (vj == val && jj < lane)) ? 1 : 0; }
            const unsigned long long mk = __ballot(valid && rank < 16);
            if (jt == j) selm = mk;
        }
    }
    Rows Rs; Rs.qhi = s; Rs.qlo = NEGBIG; Rs.hi_min = smin; Rs.hi_max = smax; Rs.lo_min = NEGBIG; Rs.lo_max = NEGBIG;
    st_init(st);
    stream_pv<true>(L, wid, lane, z + KBS + hk * 64, (size_t)ZP, z + VBS + hk * 64, (size_t)ZP, 0, tb, qr, Rs, selm, 0, tb, st);
    { const float inv = st_invl(st, ltot); scale_rows<true>(fin, st.o, inv * g1, wsf, r32, hi); }
    Rows Rw; Rw.qhi = s; Rw.qlo = s - 511; Rw.hi_min = smin; Rw.hi_max = smax; Rw.lo_min = smin - 511; Rw.lo_max = smax - 511;
    st_init(st);
    stream_pv<false>(L, wid, lane, z + KBW + hk * 64, (size_t)ZP, z + VBW + hk * 64, (size_t)ZP, (tb - 8) > 0 ? tb - 8 : 0, tb, qr, Rw, 0ull, 0, 0, st);
    { const float inv = st_invl(st, ltot); scale_rows<true>(fin, st.o, inv * g2, wsf, r32, hi); }
    bf16* mix = (bf16*)(ws + WS_MIX) + ((size_t)b * SEQ + 64 * tb + 8 * wid) * MIXW + 512 + hk * 256;
#pragma unroll
    for (int r = 0; r < 16; ++r) { const int q = crow(r, hi); bf16* o = mix + (size_t)(q & 7) * MIXW + (q >> 3) * 64;
        o[r32] = (bf16)f2bf(fin[0][r]); o[32 + r32] = (bf16)f2bf(fin[1][r]); }
}
#undef FA_MFMA
}
__device__ const unsigned short P2_ORDER[640] = {63,127,191,255,319,383,62,126,190,254,318,382,61,125,189,253,317,381,60,124,188,252,316,380,59,123,187,251,315,379,58,122,186,250,314,378,57,121,185,249,313,377,56,120,184,248,312,376,55,119,183,247,311,375,54,118,182,246,310,374,53,117,181,245,309,373,52,116,180,244,308,372,51,115,179,243,307,371,50,114,178,242,306,370,49,113,177,241,305,369,48,112,176,240,304,368,47,111,175,239,303,367,46,110,174,238,302,366,399,415,431,447,463,479,495,511,527,543,559,575,591,607,623,639,45,109,173,237,301,365,44,108,172,236,300,364,43,107,171,235,299,363,42,106,170,234,298,362,398,414,430,446,462,478,494,510,526,542,558,574,590,606,622,638,41,105,169,233,297,361,40,104,168,232,296,360,39,103,167,231,295,359,38,102,166,230,294,358,397,413,429,445,461,477,493,509,525,541,557,573,589,605,621,637,37,101,165,229,293,357,36,100,164,228,292,356,35,99,163,227,291,355,34,98,162,226,290,354,396,412,428,444,460,476,492,508,524,540,556,572,588,604,620,636,33,97,161,225,289,353,32,96,160,224,288,352,395,411,427,443,459,475,491,507,523,539,555,571,587,603,619,635,31,95,159,223,287,351,30,94,158,222,286,350,29,93,157,221,285,349,28,92,156,220,284,348,394,410,426,442,458,474,490,506,522,538,554,570,586,602,618,634,27,91,155,219,283,347,26,90,154,218,282,346,25,89,153,217,281,345,24,88,152,216,280,344,393,409,425,441,457,473,489,505,521,537,553,569,585,601,617,633,23,87,151,215,279,343,22,86,150,214,278,342,21,85,149,213,277,341,20,84,148,212,276,340,392,408,424,440,456,472,488,504,520,536,552,568,584,600,616,632,19,83,147,211,275,339,18,82,146,210,274,338,17,81,145,209,273,337,16,80,144,208,272,336,391,407,423,439,455,471,487,503,519,535,551,567,583,599,615,631,15,79,143,207,271,335,14,78,142,206,270,334,390,406,422,438,454,470,486,502,518,534,550,566,582,598,614,630,13,77,141,205,269,333,12,76,140,204,268,332,11,75,139,203,267,331,10,74,138,202,266,330,389,405,421,437,453,469,485,501,517,533,549,565,581,597,613,629,9,73,137,201,265,329,8,72,136,200,264,328,7,71,135,199,263,327,388,404,420,436,452,468,484,500,516,532,548,564,580,596,612,628,6,70,134,198,262,326,5,69,133,197,261,325,387,403,419,435,451,467,483,499,515,531,547,563,579,595,611,627,4,68,132,196,260,324,3,67,131,195,259,323,386,402,418,434,450,466,482,498,514,530,546,562,578,594,610,626,2,66,130,194,258,322,1,65,129,193,257,321,385,401,417,433,449,465,481,497,513,529,545,561,577,593,609,625,0,64,128,192,256,320,384,400,416,432,448,464,480,496,512,528,544,560,576,592,608,624};

__device__ __forceinline__ int dequeue(unsigned* ctr, volatile LAS int* w, int tid) {
    if (tid == 0) *w = (int)__hip_atomic_fetch_add(ctr, 1u, __ATOMIC_RELAXED, __HIP_MEMORY_SCOPE_AGENT);
    __syncthreads(); const int v = *w; __syncthreads(); return __builtin_amdgcn_readfirstlane(v);
}
__device__ __forceinline__ void dil_combine(Frame& F) {
    const float* dout = (const float*)(F.ws + WS_DILO); const float* dlse = (const float*)(F.ws + WS_DILL); bf16* mix = (bf16*)(F.ws + WS_MIX);
    for (int i = F.gw * 64 + F.lane; i < T * 256; i += F.ngw * 64) { const int t = i >> 8, c = i & 255, j = c >> 6;
        const float l0 = dlse[(size_t)t * 4 + j], l1 = dlse[(size_t)T * 4 + (size_t)t * 4 + j], l2 = dlse[(size_t)2 * T * 4 + (size_t)t * 4 + j];
        const float mx = fmaxf(l0, fmaxf(l1, l2)), w0 = ex2(l0 - mx), w1 = ex2(l1 - mx), w2 = ex2(l2 - mx);
        const float o = w0 * dout[i] + w1 * dout[(size_t)T * 256 + i] + w2 * dout[(size_t)2 * T * 256 + i];
        mix[(size_t)t * MIXW + 1280 + c] = (bf16)f2bf(o / (w0 + w1 + w2)); }
}
__device__ __forceinline__ void load_router(Frame& F, const float* rw) {
    LAS float* rwt = (LAS float*)F.lds;
    for (int i = F.tid; i < 8192; i += 512) { const f32x4 v = ((const f32x4*)rw)[i]; const int k = i >> 2, e0 = (i & 3) * 4; rwt[(e0 + 0) * 2048 + k] = v.x; rwt[(e0 + 1) * 2048 + k] = v.y; rwt[(e0 + 2) * 2048 + k] = v.z; rwt[(e0 + 3) * 2048 + k] = v.w; }
    __syncthreads();
}
__device__ __forceinline__ void phase_ln1_router(Frame& F, const Args& a, int L) {
    load_router(F, a.in[I_RW]);
    const LAS f32x4* rwt4 = (const LAS f32x4*)F.lds; const int lane = F.lane;
    const float* y = (const float*)(F.ws + WS_Y); float* h32 = (float*)(F.ws + WS_H32); bf16* hb = (bf16*)(F.ws + WS_HB);
    int* tokc = (int*)(F.ws + WS_TOKC); int* toks = (int*)(F.ws + WS_TOKS); float* tokw = (float*)(F.ws + WS_TOKW);
    unsigned* cnt = (unsigned*)(F.ws + WS_CTL) + CW_CNT + L * 32;
    for (int m = F.gw; m < T; m += F.ngw) {
        f32x4 o[8]; ln_row(y + (size_t)m * D, a.in[I_LN1G] + (size_t)L * D, a.in[I_LN1B] + (size_t)L * D, h32 + (size_t)m * D, hb + (size_t)m * D, lane, o);
        float myl = 0.f;
#pragma unroll 1
        for (int e = 0; e < 16; ++e) { float s = 0.f;
#pragma unroll
            for (int j = 0; j < 8; ++j) { const f32x4 w = rwt4[e * 512 + j * 64 + lane]; s += (o[j].x * w.x + o[j].y * w.y) + (o[j].z * w.z + o[j].w * w.w); }
            s = wave_sum(s); if (lane == e) myl = s; }
        if (lane < 16) myl += a.in[I_RB][lane];
        float pe[16]; float mx = -1e30f;
#pragma unroll
        for (int e = 0; e < 16; ++e) { pe[e] = __shfl(myl, e); mx = fmaxf(mx, pe[e]); }
#pragma unroll
        for (int e = 0; e < 16; ++e) pe[e] = expf(pe[e] - mx);
        int gsel = 0; float gbest = -1.f; int i1s = 0, i2s = 1; float p1s = 0.f, p2s = 0.f;
#pragma unroll
        for (int g = 0; g < 4; ++g) {
            int i1 = 0; float p1 = pe[4 * g];
#pragma unroll
            for (int i = 1; i < 4; ++i) if (pe[4 * g + i] > p1) { p1 = pe[4 * g + i]; i1 = i; }
            int i2 = -1; float p2 = -1.f;
#pragma unroll
            for (int i = 0; i < 4; ++i) if (i != i1 && pe[4 * g + i] > p2) { p2 = pe[4 * g + i]; i2 = i; }
            const float sg = p1 + p2;
            if (sg > gbest) { gbest = sg; gsel = g; i1s = i1; i2s = i2; p1s = p1; p2s = p2; }
        }
        const int lo = i1s < i2s ? i1s : i2s, hi = i1s < i2s ? i2s : i1s;
        const float wlo = (i1s < i2s ? p1s : p2s) / (p1s + p2s), whi = (i1s < i2s ? p2s : p1s) / (p1s + p2s);
        const int pi = lo == 0 ? hi - 1 : (lo == 1 ? hi + 1 : 5);
        const int cls = gsel * 6 + pi;
        if (lane == 0) { const unsigned slot = __hip_atomic_fetch_add(cnt + cls, 1u, __ATOMIC_RELAXED, __HIP_MEMORY_SCOPE_AGENT); tokc[m] = cls; toks[m] = (int)slot; tokw[2 * m] = wlo; tokw[2 * m + 1] = whi; }
    }
    __syncthreads();
}
__device__ __forceinline__ void build_tiles(Frame& F, int L) {
    volatile LAS int* tab = (volatile LAS int*)(F.lds + TILE_OFF);
    if (F.tid == 0) { const unsigned* cnt = (const unsigned*)(F.ws + WS_CTL) + CW_CNT + L * 32; int off = 0, nt = 0;
        for (int c = 0; c < 24; ++c) { const int n = (int)cnt[c]; tab[64 + c] = off; const int k = (n + 255) >> 8; for (int i = 0; i < k && nt < MAXTILES; ++i) tab[nt++] = c; off += k * 256; }
        tab[64 + 24] = off; tab[96] = nt; }
    __syncthreads();
}
__device__ __forceinline__ void phase_gather(Frame& F, int L) {
    volatile LAS int* tab = (volatile LAS int*)(F.lds + TILE_OFF);
    const int* tokc = (const int*)(F.ws + WS_TOKC); const int* toks = (const int*)(F.ws + WS_TOKS); const float* tokw = (const float*)(F.ws + WS_TOKW);
    int* ptok = (int*)(F.ws + WS_PTOK); float* pw = (float*)(F.ws + WS_PW); const v4u* hb = (const v4u*)(F.ws + WS_HB); v4u* xp = (v4u*)(F.ws + WS_XP);
    const unsigned* cnt = (const unsigned*)(F.ws + WS_CTL) + CW_CNT + L * 32;
    if (F.bx < 24) { const int c = F.bx; const int lo = tab[64 + c] + (int)cnt[c], hi = tab[64 + c + 1]; for (int r = lo + F.tid; r < hi; r += 512) ptok[r] = -1; }
    for (int t = F.gw; t < T; t += F.ngw) {
        const int pos = tab[64 + tokc[t]] + toks[t];
#pragma unroll
        for (int j = 0; j < 4; ++j) xp[(size_t)pos * 256 + j * 64 + F.lane] = hb[(size_t)t * 256 + j * 64 + F.lane];
        if (F.lane == 0) { ptok[pos] = t; pw[2 * pos] = tokw[2 * t]; pw[2 * pos + 1] = tokw[2 * t + 1]; }
    }
}

constexpr int NPH_LAYER = 9, NPH = 1 + DEPTH * NPH_LAYER;
__global__ void __launch_bounds__(512, 2) fwd(Args args) {
    extern __shared__ __attribute__((aligned(16))) unsigned char lds[];
    const int wave0 = __builtin_amdgcn_readfirstlane(threadIdx.x >> 6);
#define MKFRAME(F) Frame F; { int w_ = wave0; asm volatile("" : "+s"(w_)); int l_; asm volatile("v_mbcnt_lo_u32_b32 %0, -1, 0\n\tv_mbcnt_hi_u32_b32 %0, -1, %0" : "=v"(l_)); int t_ = w_ * 64 + l_; F.lds = (LAS unsigned char*)lds; F.tid = t_; F.lane = t_ & 63; F.wave = __builtin_amdgcn_readfirstlane(t_ >> 6); \
    int g_ = gridDim.x, b_ = blockIdx.x; asm volatile("" : "+s"(g_), "+s"(b_)); F.G = g_; F.bx = b_; F.gw = b_ * 8 + F.wave; F.ngw = g_ * 8; F.ws = args.ws; }
    MKFRAME(F);
    for (int u = F.tid; u < (LDS_BYTES - LDSCTL_OFF) / 4; u += 512) ((LAS unsigned*)(F.lds + LDSCTL_OFF))[u] = 0u;
    __syncthreads();
    volatile LAS unsigned* MISC = (volatile LAS unsigned*)(F.lds + MISC_OFF);
    XcdBarrier bar; bar.bar = (unsigned*)(F.ws + WS_CTL) + CW_BAR; bar.x = xb_xcc_id(); bar.st = MISC + 8;
    const int lo = args.ph_lo, hi = args.ph_hi;
    if (hi - lo > 1 && F.tid == 0) (void)xb_add(&bar.bar[XB_XCNT(bar.x)], 1u);
#ifndef PH_MASK
#define PH_MASK 0x3ff
#endif
#define IN(k) (lo <= (k) && (k) < hi)
#define EN(b) ((PH_MASK >> (b)) & 1)
#define SEAM(k) do { if (IN((k) + 1)) { MKFRAME(Fb_); xcd_barrier(bar, Fb_.tid); } } while (0)
    PG8_LAS unsigned char* ring = (PG8_LAS unsigned char*)lds;

    if (EN(9) && IN(0)) { MKFRAME(F0); phase_prologue(F0, args); SEAM(0); }

    for (int L = 0; L < DEPTH; ++L) {
        const int p0 = 1 + L * NPH_LAYER;
        unsigned char* wl = args.ws + WS_W + (size_t)L * LW_STRIDE;
        if (EN(0) && IN(p0 + 0)) {
            MKFRAME(F);
            pg8::SchedDense S; S.A = (const char*)(F.ws + WS_HB); S.Bt = (const char*)(wl + LW_IN); S.tA = (size_t)256 * D * 2; S.tB = (size_t)256 * D * 2; S.so.init(T, ZP, F.G, F.bx);
            EpiZ E{(bf16*)(F.ws + WS_Z), (const float*)(F.ws + WS_CS)};
            pg8::gemm_phase<EpiZ, pg8::SchedDense, true>(ring, F.tid, D, D, D / 64, D / 64, S, E);
            SEAM(p0 + 0);
        }
        if (EN(1) && IN(p0 + 1)) {
            { MKFRAME(F1); for (int u = F1.bx; u < 384; u += F1.G) { MKFRAME(Fu); fa::unit_dilated((LAS char*)Fu.lds, Fu.ws, Fu.wave, Fu.lane, u); } }
            { MKFRAME(F1); phase_kmean(F1); } { MKFRAME(F1); for (int u = (F1.bx + F1.G - 128) % F1.G; u < 96; u += F1.G) unit_compress(F1, args, L, u); }
            SEAM(p0 + 1); }
        if (EN(2) && IN(p0 + 2)) {
            { MKFRAME(F2); unsigned* qh = (unsigned*)(F2.ws + WS_CTL) + CW_Q + (L * 2) * 64; volatile LAS int* qw = (volatile LAS int*)(F2.lds + MISC_OFF + 64);
              for (;;) { const int k = dequeue(qh, qw, F2.tid); if (k >= 640) break; const int uid = P2_ORDER[k];
                  if (uid < 384) { MKFRAME(Fu); fa::unit_nsa((LAS char*)Fu.lds, Fu.ws, Fu.wave, Fu.lane, uid); } else { MKFRAME(Fu); fa::unit_moba((LAS char*)Fu.lds, Fu.ws, Fu.wave, Fu.lane, uid - 384); } } }
            { MKFRAME(F2); dil_combine(F2); }
            SEAM(p0 + 2); }
        if (EN(3) && IN(p0 + 3)) {
            MKFRAME(F);
            pg8::SchedDense S; S.A = (const char*)(F.ws + WS_MIX); S.Bt = (const char*)(wl + LW_OUT); S.tA = (size_t)256 * MIXW * 2; S.tB = (size_t)256 * MIXW * 2; S.so.init(T, D, F.G, F.bx);
            EpiRes E{(const float*)(F.ws + WS_H32), (float*)(F.ws + WS_Y)};
            pg8::gemm_phase<EpiRes, pg8::SchedDense, false>(ring, F.tid, MIXW, MIXW, MIXW / 64, MIXW / 64, S, E);
            SEAM(p0 + 3);
        }
        if (EN(4) && IN(p0 + 4)) { MKFRAME(F4); phase_ln1_router(F4, args, L); SEAM(p0 + 4); }
        if (EN(5) && IN(p0 + 5)) {
            { MKFRAME(F5); build_tiles(F5, L); phase_gather(F5, L); } __syncthreads();
            { MKFRAME(F); pg8::SchedDense S; S.A = (const char*)(F.ws + WS_PB) + (size_t)L * T * PLE * 2; S.Bt = (const char*)(wl + LW_PP); S.tA = (size_t)256 * PLE * 2; S.tB = (size_t)256 * PLE * 2; S.so.init(T, D, F.G, F.bx);
              EpiF32 E{(float*)(F.ws + WS_PPLE)};
              pg8::gemm_phase<EpiF32, pg8::SchedDense, false>(ring, F.tid, PLE, PLE, PLE / 64, PLE / 64, S, E); }
            { MKFRAME(F); pg8::SchedDense S; S.A = (const char*)(F.ws + WS_HB); S.Bt = (const char*)(wl + LW_PG); S.tA = (size_t)256 * D * 2; S.tB = (size_t)256 * D * 2; S.so.init(T, D, F.G, F.bx);
              EpiPle E{(const float*)(F.ws + WS_H32), (const float*)(F.ws + WS_PPLE), args.in[I_PGB] + (size_t)L * D, (float*)(F.ws + WS_Y)};
              pg8::gemm_phase<EpiPle, pg8::SchedDense, false>(ring, F.tid, D, D, D / 64, D / 64, S, E); }
            SEAM(p0 + 5);
        }
        if (EN(6) && IN(p0 + 6)) {
            MKFRAME(F); build_tiles(F, L);
            const volatile LAS int* tab = (const volatile LAS int*)(F.lds + TILE_OFF);
            SchedGU S{(const char*)(F.ws + WS_XP), (const char*)(wl + LW_GU), tab, F.G, F.bx, __builtin_amdgcn_readfirstlane(tab[96])};
            EpiGU E{(bf16*)(F.ws + WS_HID), (const float*)(F.ws + WS_PW)};
            pg8::gemm_phase<EpiGU, SchedGU, true>(ring, F.tid, D, D, D / 64, D / 64, S, E);
            SEAM(p0 + 6);
        }
        if (EN(7) && IN(p0 + 7)) {
            MKFRAME(F); build_tiles(F, L);
            const volatile LAS int* tab = (const volatile LAS int*)(F.lds + TILE_OFF);
            SchedDown S{(const char*)(F.ws + WS_HID), (const char*)(wl + LW_D), tab, F.G, F.bx, __builtin_amdgcn_readfirstlane(tab[96])};
            EpiDown E{(float*)(F.ws + WS_Y), (const int*)(F.ws + WS_PTOK)};
            pg8::gemm_phase<EpiDown, SchedDown, false>(ring, F.tid, 1024, EH, 16, 8, S, E);
            SEAM(p0 + 7);
        }
        if (EN(8) && IN(p0 + 8)) {
            const bool lastL = (L == DEPTH - 1); MKFRAME(F);
            for (int m = F.gw; m < T; m += F.ngw) { f32x4 o[8];
                ln_row((const float*)(F.ws + WS_Y) + (size_t)m * D, args.in[I_LN2G] + (size_t)L * D, args.in[I_LN2B] + (size_t)L * D,
                       lastL ? args.out + (size_t)m * D : (float*)(F.ws + WS_H32) + (size_t)m * D, lastL ? (bf16*)nullptr : (bf16*)(F.ws + WS_HB) + (size_t)m * D, F.lane, o); }
            SEAM(p0 + 8);
        }
    }
#undef IN
#undef SEAM
}

extern "C" void kernel_launch(void* const* d_in, const int* in_sizes, int n_in, void* d_out, int out_size, void* d_ws, size_t ws_size, hipStream_t stream) {
    static int grid = 0;
    if (grid == 0) {
        if (n_in != 25 || ws_size < WS_END) { fprintf(stderr, "kernel_launch: unexpected n_in %d / ws %zu\n", n_in, ws_size); grid = -1; return; }
        int dev = 0, cus = 0;
        if (hipGetDevice(&dev) != hipSuccess || hipDeviceGetAttribute(&cus, hipDeviceAttributeMultiprocessorCount, dev) != hipSuccess) { grid = -1; return; }
        if (hipFuncSetAttribute((const void*)fwd, hipFuncAttributeMaxDynamicSharedMemorySize, LDS_BYTES) != hipSuccess) { fprintf(stderr, "kernel_launch: hipFuncSetAttribute failed\n"); grid = -1; return; }
        int per_cu = 0; (void)hipOccupancyMaxActiveBlocksPerMultiprocessor(&per_cu, (const void*)fwd, 512, LDS_BYTES); (void)hipGetLastError();
        grid = cus;
    }
    if (grid < 0) return;
    (void)hipMemsetAsync((char*)d_ws + WS_CTL, 0, CTL_ZERO_BYTES, stream);
    Args a{};
    for (int i = 0; i < 25; ++i) a.in[i] = (const float*)d_in[i];
    a.out = (float*)d_out; a.ws = (unsigned char*)d_ws;
#if MK_SINGLE
    a.ph_lo = 0; a.ph_hi = NPH;
    hipLaunchKernelGGL(fwd, dim3(grid), dim3(512), LDS_BYTES, stream, a);
#else
    for (int p = 0; p < NPH; ++p) { a.ph_lo = p; a.ph_hi = p + 1; hipLaunchKernelGGL(fwd, dim3(grid), dim3(512), LDS_BYTES, stream, a); }
#endif
}
```

```cpp
#include <hip/hip_runtime.h>
#include <cstdio>
#include <cstdint>

#ifndef PDBL
#define PDBL -1
#endif
#ifndef HOSTDBL
#define HOSTDBL -2
#endif
#ifndef MK_SINGLE
#define MK_SINGLE 1
#endif

namespace pg8 {
#define PG8_LAS __attribute__((address_space(3)))
typedef unsigned short bf16_t;
typedef short bf16x8 __attribute__((ext_vector_type(8)));
typedef float f32x4 __attribute__((ext_vector_type(4)));
typedef unsigned u32x4 __attribute__((ext_vector_type(4)));
constexpr int BM = 256, BK = 64, HALF = 128, HTB = HALF * BK * 2, STAGE_BYTES = 8 * HTB, NXCD = 8, WGM = 8;

__host__ __device__ __forceinline__ int lds_byte(int r, int c) { const int st = (r >> 4) * 2 + (c >> 5), rr = r & 15, cc = c & 31, ob = rr * 64 + cc * 2; return st * 1024 + (ob ^ (((ob >> 9) & 1) << 5)); }
__host__ __device__ __forceinline__ void stage_rc(int b, int& R, int& C) { const int st = b / 1024, sb = b % 1024, swz = sb ^ (((sb >> 9) & 1) << 5); R = (st >> 1) * 16 + swz / 64; C = (st & 1) * 32 + (swz % 64) / 2; }
__host__ __device__ __forceinline__ int perm32(int rho) { const int n = rho >> 4, i = rho & 15; return 8 * (i >> 2) + 4 * n + (i & 3); }

struct Unit { const char* A; const char* B; const char* B2; int pm, pn, aux; };

struct StaticOrder {
    int nM, nN, nwg, G, c;
    __device__ void init(int M, int N, int G_, int c_) { nM = M / BM; nN = N / BM; nwg = nM * nN; G = G_; c = c_; }
    __device__ bool next(int i, int& pm, int& pn) const {
        const long L = (long)i * G + c; if (L >= nwg) return false;
        int wgid = (int)L; { const int q = nwg / NXCD, r = nwg % NXCD, xcd = wgid % NXCD, off = wgid / NXCD; wgid = (xcd < r ? xcd * (q + 1) : r * (q + 1) + (xcd - r) * q) + off; }
        const int nig = WGM * nN, gid = wgid / nig, fm = gid * WGM, gsz = (nM - fm) < WGM ? (nM - fm) : WGM;
        pm = fm + ((wgid % nig) % gsz); pn = (wgid % nig) / gsz; return true;
    }
};
struct SchedDense {
    const char* A; const char* Bt; size_t tA, tB; StaticOrder so;
    __device__ __forceinline__ bool next(int i, Unit& u) const { int pm, pn; if (!so.next(i, pm, pn)) return false; u.pm = pm; u.pn = pn; u.aux = 0; u.A = A + (size_t)pm * tA; u.B = Bt + (size_t)pn * tB; u.B2 = u.B; return true; }
};

__device__ __forceinline__ unsigned cvt_pk_bf16(float lo, float hi) { unsigned r; asm volatile("v_cvt_pk_bf16_f32 %0, %1, %2" : "=v"(r) : "v"(lo), "v"(hi)); return r; }

template <class Epi, class Sched, bool ALIGN_EPI>
__device__ __forceinline__ void gemm_phase(PG8_LAS unsigned char* lds, const int tid_in, const int lda, const int ldb, const int nt, const int ksplit, const Sched& S, const Epi& E) {
    int tid_ = tid_in; asm volatile("" : "+v"(tid_));
    const int tid = tid_, wid = __builtin_amdgcn_readfirstlane(tid >> 6), lane = tid & 63, wr = wid >> 2, wc = wid & 3, fr = lane & 15, fq = lane >> 4;
    unsigned voffA[2], voffB[2];
#pragma unroll
    for (int i = 0; i < 2; ++i) { int R, C; stage_rc(tid * 16 + i * 8192, R, C); const int Rb = Epi::PERM ? ((R & ~31) + perm32(R & 31)) : R;
        voffA[i] = (unsigned)(R * lda + C) * 2u; voffB[i] = (unsigned)(Rb * ldb + C) * 2u; }
    const size_t kstep = (size_t)(BK * 2);
    const size_t hA = (size_t)HALF * lda * 2, hB = (size_t)HALF * ldb * 2;
    const unsigned ldsw = (unsigned)wid * 1024u;
    const int aoff = lds_byte(wr * 64 + fr, fq * 8), boff = lds_byte(wc * 32 + fr, fq * 8);
#define PG8_SA(b, h) (((b) * 2 + (h)) * HTB)
#define PG8_SB(b, h) ((4 + (b) * 2 + (h)) * HTB)
#define PG8_STAGE(bufoff, gbase, voff) do { _Pragma("unroll") for (int _i = 0; _i < 2; ++_i) \
        __builtin_amdgcn_global_load_lds((const unsigned*)((const char*)(gbase) + (voff)[_i]), (PG8_LAS unsigned*)(lds + (bufoff) + ldsw + _i * 8192), 16, 0, 0); } while (0)
#define PG8_LDA(dst, b, h) do { _Pragma("unroll") for (int m = 0; m < 4; ++m) _Pragma("unroll") for (int k = 0; k < 2; ++k) dst[m][k] = *(const PG8_LAS bf16x8*)(lds + PG8_SA(b, h) + aoff + m * 2048 + k * 1024); } while (0)
#define PG8_LDB(dst, b, h) do { _Pragma("unroll") for (int n = 0; n < 2; ++n) _Pragma("unroll") for (int k = 0; k < 2; ++k) dst[n][k] = *(const PG8_LAS bf16x8*)(lds + PG8_SB(b, h) + boff + n * 2048 + k * 1024); } while (0)
#define PG8_MMA(ai, bj, At, Bt) do { __builtin_amdgcn_s_setprio(1); _Pragma("unroll") for (int m = 0; m < 4; ++m) _Pragma("unroll") for (int n = 0; n < 2; ++n) _Pragma("unroll") for (int k = 0; k < 2; ++k) \
        acc[ai][bj][m][n] = __builtin_amdgcn_mfma_f32_16x16x32_bf16(Bt[n][k], At[m][k], acc[ai][bj][m][n], 0, 0, 0); __builtin_amdgcn_s_setprio(0); } while (0)
#define PG8_WAIT_V(n) asm volatile("s_waitcnt vmcnt(" #n ")" ::: "memory")
#define PG8_WAIT_L(n) asm volatile("s_waitcnt lgkmcnt(" #n ")" ::: "memory")
#define PG8_BAR __builtin_amdgcn_s_barrier()
#define PG8_SCHED __builtin_amdgcn_sched_barrier(0)
    Unit cur, nxt; int ui = 0;
    if (!S.next(0, cur)) return;
    f32x4 acc[2][2][4][2];
#pragma unroll
    for (int a = 0; a < 2; ++a)
#pragma unroll
        for (int b = 0; b < 2; ++b)
#pragma unroll
            for (int m = 0; m < 4; ++m)
#pragma unroll
                for (int n = 0; n < 2; ++n) acc[a][b][m][n] = (f32x4){0.f, 0.f, 0.f, 0.f};
    bf16x8 At[4][2], B0[2][2], B1[2][2];
    const char* cA = cur.A; const char* cB = cur.B; const char* cB2 = cur.B2;
    PG8_STAGE(PG8_SB(0, 0), cB, voffB); PG8_STAGE(PG8_SB(0, 1), cB + hB, voffB); PG8_STAGE(PG8_SA(0, 0), cA, voffA); PG8_STAGE(PG8_SA(0, 1), cA + hA, voffA);
    if (wr == 1) PG8_BAR;
    PG8_WAIT_V(2); PG8_BAR;
    PG8_STAGE(PG8_SB(1, 0), cB + kstep, voffB); PG8_STAGE(PG8_SA(1, 0), cA + kstep, voffA); PG8_STAGE(PG8_SB(1, 1), cB + hB + kstep, voffB);
    PG8_WAIT_V(6); PG8_BAR;
    for (;;) {
        const bool has_next = S.next(ui + 1, nxt);
        const char* nA = has_next ? nxt.A : cA; const char* nB = has_next ? nxt.B : cB;
        for (int t = 0; t < nt; t += 2) {
            const bool last = (t == nt - 2);
            const int t2 = t + 2;
            const char* a1 = cA + (size_t)(t + 1) * kstep;
            const char* a2 = last ? nA : cA + (size_t)t2 * kstep;
            const char* b2 = last ? nB : (t2 < ksplit ? cB + (size_t)t2 * kstep : cB2 + (size_t)(t2 - ksplit) * kstep);
            const char* a3 = a2 + kstep; const char* b3 = b2 + kstep;
            PG8_LDB(B0, 0, 0); PG8_LDB(B1, 0, 1); PG8_SCHED; PG8_LDA(At, 0, 0); PG8_STAGE(PG8_SA(1, 1), a1 + hA, voffA);
            PG8_WAIT_V(8); PG8_WAIT_L(0); PG8_BAR; PG8_MMA(0, 0, At, B0); PG8_MMA(0, 1, At, B1); PG8_BAR; PG8_SCHED;
            PG8_LDA(At, 0, 1); PG8_STAGE(PG8_SB(0, 0), b2, voffB); PG8_STAGE(PG8_SB(0, 1), b2 + hB, voffB); PG8_STAGE(PG8_SA(0, 0), a2, voffA);
            PG8_WAIT_V(8); PG8_WAIT_L(0); PG8_BAR; PG8_MMA(1, 0, At, B0); PG8_MMA(1, 1, At, B1); PG8_BAR; PG8_SCHED;
            PG8_LDB(B0, 1, 0); PG8_LDB(B1, 1, 1); PG8_SCHED; PG8_LDA(At, 1, 0); PG8_STAGE(PG8_SA(0, 1), a2 + hA, voffA);
            PG8_WAIT_V(8); PG8_WAIT_L(0); PG8_BAR; PG8_MMA(0, 0, At, B0); PG8_MMA(0, 1, At, B1); PG8_BAR; PG8_SCHED;
            PG8_LDA(At, 1, 1); PG8_STAGE(PG8_SB(1, 0), b3, voffB); PG8_STAGE(PG8_SB(1, 1), b3 + hB, voffB); PG8_STAGE(PG8_SA(1, 0), a3, voffA);
            PG8_WAIT_V(8); PG8_WAIT_L(0); PG8_BAR; PG8_MMA(1, 0, At, B0); PG8_MMA(1, 1, At, B1); PG8_BAR; PG8_SCHED;
        }
        if constexpr (ALIGN_EPI) { if (wr == 0) PG8_BAR; }
        E(acc, cur, wr, wc, fr, fq);
        if (!has_next) break;
#pragma unroll
        for (int a = 0; a < 2; ++a)
#pragma unroll
            for (int b = 0; b < 2; ++b)
#pragma unroll
                for (int m = 0; m < 4; ++m)
#pragma unroll
                    for (int n = 0; n < 2; ++n) acc[a][b][m][n] = (f32x4){0.f, 0.f, 0.f, 0.f};
        cur = nxt; cA = nA; cB = nB; cB2 = nxt.B2; ++ui;
        if constexpr (ALIGN_EPI) { if (wr == 1) PG8_BAR; }
    }
    PG8_WAIT_V(0);
    if constexpr (!ALIGN_EPI) { if (wr == 0) PG8_BAR; }
    PG8_BAR;
#undef PG8_SA
#undef PG8_SB
#undef PG8_STAGE
#undef PG8_LDA
#undef PG8_LDB
#undef PG8_MMA
#undef PG8_WAIT_V
#undef PG8_WAIT_L
#undef PG8_BAR
#undef PG8_SCHED
}
}

constexpr int BATCH = 2, SEQ = 4096, T = BATCH * SEQ, D = 2048, DEPTH = 4;
constexpr int ZP = 5888;
constexpr int MIXW = 1536;
constexpr int NEXP = 16, EH = 512, PLE = 256;
constexpr float LN_EPS = 1e-5f;
constexpr float ALPHA = 1.681792830507429f;
constexpr float SC2 = 0.125f * 1.4426950408889634f;
constexpr int QA = 0, KA = 512, VA = 1024, QB = 1536, KBC = 2304, VBC = 2496, KBS = 2688, VBS = 2880, KBW = 3072, VBW = 3264, QC = 3456, KC = 4224, VC = 4992, GB = 5760;
constexpr int MAXTILES = 56, TPAD = MAXTILES * 256;

constexpr size_t MiB = 1u << 20;
constexpr size_t WS_CTL = 0, CTL_ZERO_BYTES = 1 * MiB;
constexpr size_t WS_CS = 1 * MiB;
constexpr size_t WS_KMEAN = 2 * MiB;
constexpr size_t WS_KCMP = 3 * MiB;
constexpr size_t WS_VCMP = 4 * MiB;
constexpr size_t WS_TOKC = 5 * MiB;
constexpr size_t WS_TOKS = 5 * MiB + 64 * 1024;
constexpr size_t WS_TOKW = 5 * MiB + 128 * 1024;
constexpr size_t WS_CNTB = 5 * MiB + 256 * 1024;
constexpr size_t WS_PTOK = 6 * MiB;
constexpr size_t WS_PW = 6 * MiB + 128 * 1024;
constexpr size_t WS_W = 16 * MiB;
constexpr size_t LW_IN = 0, LW_OUT = LW_IN + (size_t)ZP * D * 2, LW_GU = LW_OUT + (size_t)D * MIXW * 2, LW_D = LW_GU + (size_t)NEXP * 1024 * D * 2,
                 LW_PG = LW_D + (size_t)NEXP * D * EH * 2, LW_PP = LW_PG + (size_t)D * D * 2, LW_C1 = LW_PP + (size_t)D * PLE * 2, LW_END = LW_C1 + (size_t)2 * 128 * 2048 * 2;
constexpr size_t LW_STRIDE = 136 * MiB;
static_assert(LW_END <= LW_STRIDE, "layer weights");
constexpr size_t WS_H32 = 560 * MiB, WS_HB = 624 * MiB, WS_Z = 656 * MiB, WS_Y = 748 * MiB, WS_MIX = 812 * MiB, WS_XP = 836 * MiB, WS_HID = 892 * MiB,
                 WS_PPLE = 920 * MiB, WS_PB = 984 * MiB, WS_END = 1000 * MiB;
static_assert(WS_W + 4 * LW_STRIDE <= WS_H32 && WS_Z + (size_t)T * ZP * 2 <= WS_Y && WS_XP + (size_t)TPAD * D * 2 <= WS_HID && WS_HID + (size_t)TPAD * 1024 * 2 <= WS_PPLE, "ws map");
constexpr int CW_BAR = 4096;
constexpr int CW_CNT = 16384;
constexpr int CW_Q = 20480;
constexpr size_t WS_DILO = WS_PPLE, WS_DILL = WS_PPLE + 32 * MiB;

constexpr int RING_BYTES = 131072, LDSCTL_OFF = RING_BYTES, MISC_OFF = LDSCTL_OFF + 320, TILE_OFF = LDSCTL_OFF + 1024;
constexpr int LDS_BYTES = 147456;

#define GAS __attribute__((address_space(1)))
#define LAS __attribute__((address_space(3)))
typedef unsigned short bf16;
typedef unsigned v4u __attribute__((ext_vector_type(4)));
typedef float f32x4 __attribute__((ext_vector_type(4)));
#define LDS_WAIT() asm volatile("s_waitcnt lgkmcnt(0)" ::: "memory")
__device__ __forceinline__ unsigned f2bf(float f) { unsigned u = __builtin_bit_cast(unsigned, f); return (u + 0x7fffu + ((u >> 16) & 1u)) >> 16; }
__device__ __forceinline__ unsigned pk2(float lo, float hi) { return f2bf(lo) | (f2bf(hi) << 16); }
__device__ __forceinline__ float bf_lo(unsigned u) { return __builtin_bit_cast(float, u << 16); }
__device__ __forceinline__ float bf_hi(unsigned u) { return __builtin_bit_cast(float, u & 0xffff0000u); }
__device__ __forceinline__ float bf1(bf16 u) { return __builtin_bit_cast(float, ((unsigned)u) << 16); }
__device__ __forceinline__ float ex2(float x) { return __builtin_amdgcn_exp2f(x); }

#define XB_TMO      128
#define XB_XCNT(j)  (256  + 64 * (j))
#define XB_XSUB(j)  (1280 + 64 * (j))
#define XB_XGEN(j)  (2304 + 64 * (j))
#define XB_TOP      3328
#define XB_TOPGEN   3392
#define XCD_BAR_WORDS 3456
#define XB_SPIN_CAP (1u << 18)
__device__ __forceinline__ unsigned xb_ld(unsigned* p)              { return __hip_atomic_load(p, __ATOMIC_RELAXED, __HIP_MEMORY_SCOPE_AGENT); }
__device__ __forceinline__ unsigned xb_add(unsigned* p, unsigned v) { return __hip_atomic_fetch_add(p, v, __ATOMIC_RELAXED, __HIP_MEMORY_SCOPE_AGENT); }
__device__ __forceinline__ unsigned xb_xcc_id() { return (unsigned)__builtin_amdgcn_s_getreg((3 << 11) | 20) & 0xFu; }
#define XB_SPIN(cond, bar) do { unsigned _sp = 0; while (cond) { __builtin_amdgcn_s_sleep(1); \
    if ((++_sp & 255u) == 0u) { if (xb_ld(&(bar)[XB_TMO])) break; if (_sp > XB_SPIN_CAP) { atomicAdd(&(bar)[XB_TMO], 1u); break; } } } } while (0)
struct XcdBarrier { unsigned* bar; unsigned x; volatile LAS unsigned* st; };
__device__ __forceinline__ XcdBarrier xcd_barrier_post(unsigned* bar, volatile LAS unsigned* st) {
    XcdBarrier b; b.bar = bar; b.x = xb_xcc_id(); b.st = st;
    if (threadIdx.x == 0) (void)xb_add(&bar[XB_XCNT(b.x)], 1u);
    return b;
}
__device__ __forceinline__ void xcd_barrier_complete(unsigned* bar, unsigned x, unsigned& nloc, unsigned& nx) {
    const unsigned G = gridDim.x * gridDim.y * gridDim.z;
    unsigned sum, cnt, mine, sp = 0u;
    for (;;) {
        sum = 0u; cnt = 0u; mine = 0u;
#pragma unroll
        for (unsigned j = 0; j < 16; ++j) { const unsigned c = xb_ld(&bar[XB_XCNT(j)]); sum += c; cnt += (c > 0u) ? 1u : 0u; mine = (j == x) ? c : mine; }
        if (sum == G) break;
        __builtin_amdgcn_s_sleep(1);
        if ((++sp & 255u) == 0u) { if (xb_ld(&bar[XB_TMO])) break; if (sp > XB_SPIN_CAP) { atomicAdd(&bar[XB_TMO], 1u); break; } }
    }
    nloc = mine > 0u ? mine : 1u; nx = cnt > 0u ? cnt : 1u;
}
__device__ __forceinline__ void xcd_barrier(const XcdBarrier& b, const int tid) {
    asm volatile("s_waitcnt vmcnt(0)" ::: "memory");
    __syncthreads();
    if (tid == 0) {
        unsigned* bar = b.bar;
        __builtin_amdgcn_s_waitcnt(0);
        unsigned nloc = b.st[0], nx = b.st[1];
        if (nloc == 0u) { xcd_barrier_complete(bar, b.x, nloc, nx); b.st[0] = nloc; b.st[1] = nx; }
        const unsigned old = xb_add(&bar[XB_XSUB(b.x)], 1u);
        const unsigned gen = old / nloc;
        if (old + 1u == (gen + 1u) * nloc) {
            __builtin_amdgcn_fence(__ATOMIC_RELEASE, "agent");
            asm volatile("s_waitcnt vmcnt(0)" ::: "memory");
            const unsigned og = xb_add(&bar[XB_TOP], 1u);
            const unsigned tg = og / nx;
            if (og + 1u == (tg + 1u) * nx) xb_add(&bar[XB_TOPGEN], 1u);
            else XB_SPIN(xb_ld(&bar[XB_TOPGEN]) == tg, bar);
            __builtin_amdgcn_fence(__ATOMIC_ACQUIRE, "agent");
            xb_add(&bar[XB_XGEN(b.x)], 1u);
            asm volatile("s_waitcnt vmcnt(0)" ::: "memory");
        } else {
            XB_SPIN(xb_ld(&bar[XB_XGEN(b.x)]) == gen, bar);
            __builtin_amdgcn_fence(__ATOMIC_ACQUIRE, "agent");
            asm volatile("s_waitcnt vmcnt(0)" ::: "memory");
        }
    }
    __syncthreads();
}

struct Args { const float* in[25]; float* out; unsigned char* ws; int ph_lo, ph_hi; };
enum { I_X = 0, I_P, I_POS, I_LNG, I_LNB, I_WIN, I_WOUT, I_CK1, I_CK2, I_PEK, I_CV1, I_CV2, I_PEV, I_LN1G, I_LN1B, I_RW, I_RB, I_WG, I_WU, I_WD, I_PP, I_PGW, I_PGB, I_LN2G, I_LN2B };

struct Frame {
    LAS unsigned char* lds;
    int tid, lane, wave, G, bx, gw, ngw;
    unsigned char* ws;
};

__device__ __forceinline__ float wave_sum(float v) {
#pragma unroll
    for (int o = 1; o < 64; o <<= 1) v += __shfl_xor(v, o);
    return v;
}
__device__ __forceinline__ float wave_max(float v) {
#pragma unroll
    for (int o = 1; o < 64; o <<= 1) v = fmaxf(v, __shfl_xor(v, o));
    return v;
}
template <int OFF> __device__ __forceinline__ void rs_step(float (&v)[64], int lane) {
    const bool up = (lane & OFF) != 0;
#pragma unroll
    for (int i = 0; i < OFF; ++i) { const float send = up ? v[i] : v[i + OFF]; const float keep = up ? v[i + OFF] : v[i]; v[i] = keep + __shfl_xor(send, OFF); }
}
__device__ __forceinline__ void reduce_scatter64(float (&v)[64], int lane) { rs_step<32>(v, lane); rs_step<16>(v, lane); rs_step<8>(v, lane); rs_step<4>(v, lane); rs_step<2>(v, lane); rs_step<1>(v, lane); }

template <int MAP>
__device__ __forceinline__ int rowmap(int n) {
    if (MAP == 1) return n < 3456 ? n : (n < 3492 ? n - 3456 + GB : n - 36);
    if (MAP == 2) return ((n >> 7) << 8) + (n & 127);
    if (MAP == 3) return ((n >> 7) << 8) + 128 + (n & 127);
    return n;
}
template <int MAP>
__device__ __forceinline__ void transpose_item(const float* W, int K, int N, bf16* WT, LAS float* scr, int item, int lane) {
    const int nblk = (N + 31) / 32, kb = item / nblk, nb = item % nblk, k0 = 64 * kb, n0 = 32 * nb;
    const int nn = n0 + (lane & 31); const bool okn = nn < N;
#pragma unroll 8
    for (int i = 0; i < 32; ++i) { const int kk = 2 * i + (lane >> 5); scr[kk * 33 + (lane & 31)] = okn ? W[(size_t)(k0 + kk) * N + nn] : 0.f; }
    LDS_WAIT(); asm volatile("" ::: "memory");
    const int c = lane & 7;
#pragma unroll
    for (int j = 0; j < 4; ++j) { const int n = (lane >> 3) + 8 * j; const LAS float* s = scr + (8 * c) * 33 + n;
        v4u o; o.x = pk2(s[0 * 33], s[1 * 33]); o.y = pk2(s[2 * 33], s[3 * 33]); o.z = pk2(s[4 * 33], s[5 * 33]); o.w = pk2(s[6 * 33], s[7 * 33]);
        if (n0 + n < N) *(v4u*)(WT + (size_t)rowmap<MAP>(n0 + n) * K + k0 + 8 * c) = o; }
    LDS_WAIT(); asm volatile("" ::: "memory");
}

__device__ __forceinline__ void ln_row(const float* src, const bf16* addb, const float* g, const float* b, float* dst32, bf16* dstb, int lane, f32x4 (&o)[8]) {
    const f32x4* xr = (const f32x4*)src + lane;
    f32x4 v[8]; float s = 0.f;
#pragma unroll
    for (int j = 0; j < 8; ++j) { v[j] = xr[64 * j];
        if (addb) { const unsigned long long u = ((const unsigned long long*)addb)[64 * j + lane]; v[j].x += bf_lo((unsigned)u); v[j].y += bf_hi((unsigned)u); v[j].z += bf_lo((unsigned)(u >> 32)); v[j].w += bf_hi((unsigned)(u >> 32)); }
        s += (v[j].x + v[j].y) + (v[j].z + v[j].w); }
    const float mean = wave_sum(s) * (1.f / D); float s2 = 0.f;
#pragma unroll
    for (int j = 0; j < 8; ++j) { v[j] = v[j] - mean; s2 += (v[j].x * v[j].x + v[j].y * v[j].y) + (v[j].z * v[j].z + v[j].w * v[j].w); }
    const float rstd = 1.f / sqrtf(wave_sum(s2) * (1.f / D) + LN_EPS);
#pragma unroll
    for (int j = 0; j < 8; ++j) { const f32x4 gg = ((const f32x4*)g)[64 * j + lane], bb = ((const f32x4*)b)[64 * j + lane]; o[j] = v[j] * rstd * gg + bb; }
    if (dst32) {
#pragma unroll
        for (int j = 0; j < 8; ++j) ((f32x4*)dst32)[64 * j + lane] = o[j];
    }
    if (dstb) {
#pragma unroll
        for (int j = 0; j < 8; ++j) ((unsigned long long*)dstb)[64 * j + lane] = (unsigned long long)pk2(o[j].x, o[j].y) | ((unsigned long long)pk2(o[j].z, o[j].w) << 32);
    }
}

__device__ __forceinline__ void phase_prologue(Frame& F, const Args& a) {
    LAS float* scr = (LAS float*)(F.lds + F.wave * 16384);
    constexpr int N_IN = 32 * 182, N_OUT = 24 * 64, N_G1 = 32 * 16, N_D1 = 8 * 64, N_PG = 32 * 64, N_PP = 4 * 64;
    constexpr int N_C1 = 32 * 4;
    constexpr int PER_LAYER = N_IN + N_OUT + 16 * N_G1 * 2 + 16 * N_D1 + N_PG + N_PP + 2 * N_C1;
    for (int it = F.gw; it < DEPTH * PER_LAYER; it += F.ngw) {
        const int L = it / PER_LAYER; int r = it % PER_LAYER;
        unsigned char* wl = F.ws + WS_W + (size_t)L * LW_STRIDE;
        if (r < N_IN) { transpose_item<1>(a.in[I_WIN] + (size_t)L * D * 5796, D, 5796, (bf16*)(wl + LW_IN), scr, r, F.lane); continue; } r -= N_IN;
        if (r < N_OUT) { transpose_item<0>(a.in[I_WOUT] + (size_t)L * MIXW * D, MIXW, D, (bf16*)(wl + LW_OUT), scr, r, F.lane); continue; } r -= N_OUT;
        if (r < 16 * N_G1) { const int e = r / N_G1; transpose_item<2>(a.in[I_WG] + ((size_t)L * NEXP + e) * D * EH, D, EH, (bf16*)(wl + LW_GU) + (size_t)e * 1024 * D, scr, r % N_G1, F.lane); continue; } r -= 16 * N_G1;
        if (r < 16 * N_G1) { const int e = r / N_G1; transpose_item<3>(a.in[I_WU] + ((size_t)L * NEXP + e) * D * EH, D, EH, (bf16*)(wl + LW_GU) + (size_t)e * 1024 * D, scr, r % N_G1, F.lane); continue; } r -= 16 * N_G1;
        if (r < 16 * N_D1) { const int e = r / N_D1; transpose_item<0>(a.in[I_WD] + ((size_t)L * NEXP + e) * EH * D, EH, D, (bf16*)(wl + LW_D) + (size_t)e * D * EH, scr, r % N_D1, F.lane); continue; } r -= 16 * N_D1;
        if (r < N_PG) { transpose_item<0>(a.in[I_PGW] + (size_t)L * D * D, D, D, (bf16*)(wl + LW_PG), scr, r, F.lane); continue; } r -= N_PG;
        if (r < N_PP) { transpose_item<0>(a.in[I_PP] + (size_t)L * PLE * D, PLE, D, (bf16*)(wl + LW_PP), scr, r, F.lane); continue; } r -= N_PP;
        if (r < N_C1) { transpose_item<0>(a.in[I_CK1] + (size_t)L * 2048 * 128, 2048, 128, (bf16*)(wl + LW_C1), scr, r, F.lane); continue; } r -= N_C1;
        transpose_item<0>(a.in[I_CV1] + (size_t)L * 2048 * 128, 2048, 128, (bf16*)(wl + LW_C1) + 128 * 2048, scr, r, F.lane);
    }
    for (int i = F.gw * 64 + F.lane; i < DEPTH * 92 * (D / 8); i += F.ngw * 64) {
        const int L = i / (92 * (D / 8)), r = i % (92 * (D / 8));
        ((v4u*)(F.ws + WS_W + (size_t)L * LW_STRIDE + LW_IN + (size_t)5796 * D * 2))[r] = (v4u){0u, 0u, 0u, 0u};
    }
    { const f32x4* p4 = (const f32x4*)a.in[I_P]; unsigned long long* pb = (unsigned long long*)(F.ws + WS_PB);
      for (size_t i = (size_t)F.gw * 64 + F.lane; i < (size_t)DEPTH * T * PLE / 4; i += (size_t)F.ngw * 64) { const f32x4 v = p4[i]; pb[i] = (unsigned long long)pk2(v.x, v.y) | ((unsigned long long)pk2(v.z, v.w) << 32); } }
    { float* cs = (float*)(F.ws + WS_CS); const int* pos = (const int*)a.in[I_POS];
      for (int i = F.gw * 64 + F.lane; i < T * 8; i += F.ngw * 64) { const int t = i >> 3, j = i & 7;
          const float inv = expf((float)j * -1.6402954339981079f);
          const float ang = (float)pos[t] * inv;
          const double rev = (double)ang * 0.15915494309189535; const float fr = (float)(rev - floor(rev));
          cs[t * 16 + j] = __builtin_amdgcn_cosf(fr); cs[t * 16 + 8 + j] = __builtin_amdgcn_sinf(fr); } }
    for (int m = F.gw; m < T; m += F.ngw) { f32x4 o[8]; ln_row(a.in[I_X] + (size_t)m * D, nullptr, a.in[I_LNG], a.in[I_LNB], (float*)nullptr, (bf16*)(F.ws + WS_HB) + (size_t)m * D, F.lane, o); }
}

__device__ __forceinline__ bool rope_head(int hd) {
    const unsigned long long lo = 0xFFFFull | (0x7FFFull << 24) | (0x7ull << 42) | (0x7ull << 48) | (0x3FFull << 54), hi = 0x3FFFull;
    return hd < 64 ? ((lo >> hd) & 1ull) != 0ull : ((hi >> (hd - 64)) & 1ull) != 0ull;
}
struct EpiZ {
    static constexpr bool PERM = true;
    bf16* Z; const float* cs;
    __device__ __forceinline__ void operator()(const f32x4 (&acc)[2][2][4][2], const pg8::Unit& u, int wr, int wc, int fr, int fq) const {
        const int row0 = u.pm * 256 + wr * 64 + fr;
#pragma unroll
        for (int bj = 0; bj < 2; ++bj) {
            const int cb = u.pn * 256 + bj * 128 + wc * 32;
            const bool rp = ((wc & 1) == 0) && rope_head(cb >> 6);
#pragma unroll
            for (int ai = 0; ai < 2; ++ai)
#pragma unroll
                for (int m = 0; m < 4; ++m) {
                    const int row = row0 + ai * 128 + m * 16;
                    f32x4 v0 = acc[ai][bj][m][0], v1 = acc[ai][bj][m][1];
                    if (rp) {
                        f32x4 o0, o1;
#pragma unroll
                        for (int i = 0; i < 4; ++i) { o0[i] = __shfl_xor(v0[i], 16); o1[i] = __shfl_xor(v1[i], 16); }
                        const f32x4 c0 = *(const f32x4*)(cs + (size_t)row * 16), c1 = *(const f32x4*)(cs + (size_t)row * 16 + 4), s0 = *(const f32x4*)(cs + (size_t)row * 16 + 8), s1 = *(const f32x4*)(cs + (size_t)row * 16 + 12);
                        if (fq == 0) { v0 = v0 * c0 - o0 * s0; v1 = v1 * c1 - o1 * s1; }
                        else if (fq == 1) { v0 = v0 * c0 + o0 * s0; v1 = v1 * c1 + o1 * s1; }
                    }
                    v4u w; w.x = pg8::cvt_pk_bf16(v0[0], v0[1]); w.y = pg8::cvt_pk_bf16(v0[2], v0[3]); w.z = pg8::cvt_pk_bf16(v1[0], v1[1]); w.w = pg8::cvt_pk_bf16(v1[2], v1[3]);
                    *(v4u*)(Z + (size_t)row * ZP + cb + 8 * fq) = w;
                }
        }
    }
};
struct EpiRes {
    static constexpr bool PERM = false;
    const bf16* h; float* y;
    __device__ __forceinline__ void operator()(const f32x4 (&acc)[2][2][4][2], const pg8::Unit& u, int wr, int wc, int fr, int fq) const {
        const int row0 = u.pm * 256 + wr * 64 + fr, col0 = u.pn * 256 + wc * 32 + 4 * fq;
#pragma unroll
        for (int ai = 0; ai < 2; ++ai)
#pragma unroll
            for (int m = 0; m < 4; ++m) { const size_t off = (size_t)(row0 + ai * 128 + m * 16) * D + col0;
#pragma unroll
                for (int bj = 0; bj < 2; ++bj)
#pragma unroll
                    for (int n = 0; n < 2; ++n) { const size_t o = off + bj * 128 + n * 16; const unsigned long long hv = *(const unsigned long long*)(h + o);
                        const f32x4 hf = {bf_lo((unsigned)hv), bf_hi((unsigned)hv), bf_lo((unsigned)(hv >> 32)), bf_hi((unsigned)(hv >> 32))}; *(f32x4*)(y + o) = hf * ALPHA + acc[ai][bj][m][n]; } }
    }
};
struct EpiF32 {
    static constexpr bool PERM = false;
    float* C;
    __device__ __forceinline__ void operator()(const f32x4 (&acc)[2][2][4][2], const pg8::Unit& u, int wr, int wc, int fr, int fq) const {
        const int row0 = u.pm * 256 + wr * 64 + fr, col0 = u.pn * 256 + wc * 32 + 4 * fq;
#pragma unroll
        for (int ai = 0; ai < 2; ++ai)
#pragma unroll
            for (int m = 0; m < 4; ++m) { const size_t off = (size_t)(row0 + ai * 128 + m * 16) * D + col0;
#pragma unroll
                for (int bj = 0; bj < 2; ++bj)
#pragma unroll
                    for (int n = 0; n < 2; ++n) *(f32x4*)(C + off + bj * 128 + n * 16) = acc[ai][bj][m][n]; }
    }
};
struct EpiPle {
    static constexpr bool PERM = false;
    const bf16* h; const float* P; const float* bias; float* y2;
    __device__ __forceinline__ void operator()(const f32x4 (&acc)[2][2][4][2], const pg8::Unit& u, int wr, int wc, int fr, int fq) const {
        const int row0 = u.pm * 256 + wr * 64 + fr, col0 = u.pn * 256 + wc * 32 + 4 * fq;
#pragma unroll
        for (int bj = 0; bj < 2; ++bj)
#pragma unroll
            for (int n = 0; n < 2; ++n) { const f32x4 bv = *(const f32x4*)(bias + col0 + bj * 128 + n * 16);
#pragma unroll
                for (int ai = 0; ai < 2; ++ai)
#pragma unroll
                    for (int m = 0; m < 4; ++m) { const size_t o = (size_t)(row0 + ai * 128 + m * 16) * D + col0 + bj * 128 + n * 16;
                        const f32x4 x = acc[ai][bj][m][n] + bv; f32x4 sg;
#pragma unroll
                        for (int i = 0; i < 4; ++i) sg[i] = __builtin_amdgcn_rcpf(1.f + __expf(-x[i]));
                        const unsigned long long hv = *(const unsigned long long*)(h + o); const f32x4 hf = {bf_lo((unsigned)hv), bf_hi((unsigned)hv), bf_lo((unsigned)(hv >> 32)), bf_hi((unsigned)(hv >> 32))};
                        *(f32x4*)(y2 + o) = hf * ALPHA + sg * *(const f32x4*)(P + o); } }
    }
};
struct EpiGU {
    static constexpr bool PERM = true;
    bf16* hid; const float* pw;
    __device__ __forceinline__ void operator()(const f32x4 (&acc)[2][2][4][2], const pg8::Unit& u, int wr, int wc, int fr, int fq) const {
        const int slot = u.aux, row0 = u.pm * 256 + wr * 64 + fr, cb = slot * 512 + u.pn * 128 + wc * 32 + 8 * fq;
#pragma unroll
        for (int ai = 0; ai < 2; ++ai)
#pragma unroll
            for (int m = 0; m < 4; ++m) { const int prow = row0 + ai * 128 + m * 16; const float w = pw[prow * 2 + slot];
                float r[8];
#pragma unroll
                for (int n = 0; n < 2; ++n)
#pragma unroll
                    for (int i = 0; i < 4; ++i) { const float g = acc[ai][0][m][n][i], up = acc[ai][1][m][n][i]; r[n * 4 + i] = g * __builtin_amdgcn_rcpf(1.f + __expf(-g)) * up * w; }
                v4u o; o.x = pg8::cvt_pk_bf16(r[0], r[1]); o.y = pg8::cvt_pk_bf16(r[2], r[3]); o.z = pg8::cvt_pk_bf16(r[4], r[5]); o.w = pg8::cvt_pk_bf16(r[6], r[7]);
                *(v4u*)(hid + (size_t)prow * 1024 + cb) = o; }
    }
};
struct EpiDown {
    static constexpr bool PERM = true;
    bf16* ffn;
    __device__ __forceinline__ void operator()(const f32x4 (&acc)[2][2][4][2], const pg8::Unit& u, int wr, int wc, int fr, int fq) const {
        const int row0 = u.pm * 256 + wr * 64 + fr, cb = u.pn * 256 + wc * 32 + 8 * fq;
#pragma unroll
        for (int ai = 0; ai < 2; ++ai)
#pragma unroll
            for (int m = 0; m < 4; ++m) { bf16* rowp = ffn + (size_t)(row0 + ai * 128 + m * 16) * D + cb;
#pragma unroll
                for (int bj = 0; bj < 2; ++bj) { const f32x4 v0 = acc[ai][bj][m][0], v1 = acc[ai][bj][m][1];
                    v4u w; w.x = pg8::cvt_pk_bf16(v0[0], v0[1]); w.y = pg8::cvt_pk_bf16(v0[2], v0[3]); w.z = pg8::cvt_pk_bf16(v1[0], v1[1]); w.w = pg8::cvt_pk_bf16(v1[2], v1[3]);
                    *(v4u*)(rowp + bj * 128) = w; } }
    }
};
struct SchedGU {
    const char* xp; const char* wgu; const volatile LAS int* tab; int G, c, ntiles;
    __device__ __forceinline__ bool next(int i, pg8::Unit& u) const {
        const int L = i * G + c; if (L >= ntiles * 8) return false;
        const int tile = L >> 3, pn = L & 7, cls = __builtin_amdgcn_readfirstlane(tab[tile]), g = cls / 6, pi = cls % 6;
        const int ea = 4 * g + (pi < 3 ? 0 : (pi < 5 ? 1 : 2)), eb = 4 * g + (pi == 0 ? 1 : ((pi == 1 || pi == 3) ? 2 : 3));
        const int slot = pn >> 2, j = pn & 3, e = slot ? eb : ea;
        u.pm = tile; u.pn = j; u.aux = slot; u.A = xp + (size_t)tile * 256 * D * 2; u.B = wgu + ((size_t)e * 1024 + (size_t)j * 256) * D * 2; u.B2 = u.B; return true;
    }
};
struct SchedDown {
    const char* hid; const char* wd; const volatile LAS int* tab; int G, c, ntiles;
    __device__ __forceinline__ bool next(int i, pg8::Unit& u) const {
        const int L = i * G + c; if (L >= ntiles * 8) return false;
        const int tile = L >> 3, pn = L & 7, cls = __builtin_amdgcn_readfirstlane(tab[tile]), g = cls / 6, pi = cls % 6;
        const int ea = 4 * g + (pi < 3 ? 0 : (pi < 5 ? 1 : 2)), eb = 4 * g + (pi == 0 ? 1 : ((pi == 1 || pi == 3) ? 2 : 3));
        u.pm = tile; u.pn = pn; u.aux = 0; u.A = hid + (size_t)tile * 256 * 1024 * 2;
        u.B = wd + ((size_t)ea * D + (size_t)pn * 256) * EH * 2; u.B2 = wd + ((size_t)eb * D + (size_t)pn * 256) * EH * 2; return true;
    }
};

__device__ __forceinline__ void load_row64(const bf16* p, float (&q)[64]) {
    const v4u* pp = (const v4u*)p;
#pragma unroll
    for (int c = 0; c < 8; ++c) { const v4u u = pp[c]; q[8 * c + 0] = bf_lo(u.x); q[8 * c + 1] = bf_hi(u.x); q[8 * c + 2] = bf_lo(u.y); q[8 * c + 3] = bf_hi(u.y);
        q[8 * c + 4] = bf_lo(u.z); q[8 * c + 5] = bf_hi(u.z); q[8 * c + 6] = bf_lo(u.w); q[8 * c + 7] = bf_hi(u.w); }
}
__device__ __forceinline__ float dot_row64(const float (&q)[64], const bf16* p) {
    const v4u* pp = (const v4u*)p; float s0 = 0.f, s1 = 0.f, s2 = 0.f, s3 = 0.f;
#pragma unroll
    for (int c = 0; c < 8; ++c) { const v4u u = pp[c];
        s0 += q[8 * c + 0] * bf_lo(u.x) + q[8 * c + 1] * bf_hi(u.x); s1 += q[8 * c + 2] * bf_lo(u.y) + q[8 * c + 3] * bf_hi(u.y);
        s2 += q[8 * c + 4] * bf_lo(u.z) + q[8 * c + 5] * bf_hi(u.z); s3 += q[8 * c + 6] * bf_lo(u.w) + q[8 * c + 7] * bf_hi(u.w); }
    return (s0 + s1) + (s2 + s3);
}
struct WAcc { float m, l; float a[64]; };
__device__ __forceinline__ void wacc_init(WAcc& A) { A.m = -1e30f; A.l = 0.f;
#pragma unroll
    for (int d = 0; d < 64; ++d) A.a[d] = 0.f; }
__device__ __forceinline__ void wacc_key(WAcc& A, float s2, const bf16* vrow) {
    const float mn = fmaxf(A.m, s2), f = ex2(A.m - mn), p = ex2(s2 - mn); A.m = mn; A.l = A.l * f + p;
    const v4u* pp = (const v4u*)vrow;
#pragma unroll
    for (int c = 0; c < 8; ++c) { const v4u u = pp[c];
        A.a[8 * c + 0] = A.a[8 * c + 0] * f + p * bf_lo(u.x); A.a[8 * c + 1] = A.a[8 * c + 1] * f + p * bf_hi(u.x);
        A.a[8 * c + 2] = A.a[8 * c + 2] * f + p * bf_lo(u.y); A.a[8 * c + 3] = A.a[8 * c + 3] * f + p * bf_hi(u.y);
        A.a[8 * c + 4] = A.a[8 * c + 4] * f + p * bf_lo(u.z); A.a[8 * c + 5] = A.a[8 * c + 5] * f + p * bf_hi(u.z);
        A.a[8 * c + 6] = A.a[8 * c + 6] * f + p * bf_lo(u.w); A.a[8 * c + 7] = A.a[8 * c + 7] * f + p * bf_hi(u.w); }
}
__device__ __forceinline__ float wacc_finish(WAcc& A, int lane, float& lse2) {
    const float M = wave_max(A.m), f = ex2(A.m - M), L = wave_sum(A.l * f);
#pragma unroll
    for (int d = 0; d < 64; ++d) A.a[d] *= f;
    reduce_scatter64(A.a, lane);
    lse2 = M + __log2f(L);
    return L > 0.f ? A.a[0] / L : 0.f;
}

__device__ __forceinline__ void phase_kmean(Frame& F) {
    const bf16* z = (const bf16*)(F.ws + WS_Z); float* km = (float*)(F.ws + WS_KMEAN); LAS float* red = (LAS float*)F.lds;
    for (int it = F.bx; it < 256; it += F.G) {
        const int b = it >> 7, h = (it >> 4) & 7, blk = it & 15, d = F.tid & 63, part = F.tid >> 6;
        const bf16* p = z + ((size_t)b * SEQ + blk * 256 + part * 32) * ZP + KA + h * 64 + d; float s = 0.f;
        bf16 kv_[32];
#pragma unroll
        for (int k = 0; k < 32; ++k) kv_[k] = p[(size_t)k * ZP];
#pragma unroll
        for (int k = 0; k < 32; ++k) s += bf1(kv_[k]);
        red[part * 64 + d] = s; __syncthreads();
        if (F.tid < 64) { float t = 0.f;
#pragma unroll
            for (int q = 0; q < 8; ++q) t += red[q * 64 + d];
            km[(size_t)it * 64 + d] = t * (1.f / 256.f); }
        __syncthreads();
    }
}
__device__ __forceinline__ float gelu_tanh(float x) { const float u = 0.7978845608028654f * (x + 0.044715f * x * x * x); const float e = __expf(2.f * u); const float th = 1.f - 2.f / (e + 1.f); return 0.5f * x * (1.f + th); }
__device__ __forceinline__ void unit_compress(Frame& F, const Args& a, int L, int uid) {
    typedef short bf16x8 __attribute__((ext_vector_type(8))); typedef float f32x16 __attribute__((ext_vector_type(16)));
    const int rb = uid & 7, bh = (uid >> 3) % 6, kv = uid / 48, b = bh / 3, hk = bh % 3, n0 = rb * 32;
    const int lane = F.lane, r32 = lane & 31, hi = lane >> 5, nt = F.wave & 3, kh = F.wave >> 2;
    const bf16* z = (const bf16*)(F.ws + WS_Z) + (size_t)b * SEQ * ZP + (kv ? VBC : KBC) + hk * 64;
    const bf16* w1t = (const bf16*)(F.ws + WS_W + (size_t)L * LW_STRIDE + LW_C1) + (size_t)kv * 128 * 2048;
    const float* pe = a.in[kv ? I_PEV : I_PEK] + (size_t)L * 2048; const float* W2 = a.in[kv ? I_CV2 : I_CK2] + (size_t)L * 128 * 64;
    LAS float* part = (LAS float*)F.lds;
    LAS float* w2s = (LAS float*)(F.lds + 32768);
    for (int i = F.tid; i < 2048; i += 512) ((LAS f32x4*)w2s)[i] = ((const f32x4*)W2)[i];
    const int n = (n0 + r32) < 255 ? (n0 + r32) : 254;
    const bf16* arow = z + (size_t)(16 * n) * ZP + hi * 8; const bf16* brow = w1t + (size_t)(nt * 32 + r32) * 2048 + hi * 8;
    f32x16 acc = f32x16{};
#pragma unroll 8
    for (int st = kh * 64; st < kh * 64 + 64; ++st) { const int j = st >> 2, d0 = st & 3;
        const v4u u = *(const v4u*)(arow + (size_t)j * ZP + d0 * 16); const f32x4 p0 = *(const f32x4*)(pe + j * 64 + d0 * 16 + hi * 8), p1 = *(const f32x4*)(pe + j * 64 + d0 * 16 + hi * 8 + 4);
        v4u av; av.x = pk2(bf_lo(u.x) + p0[0], bf_hi(u.x) + p0[1]); av.y = pk2(bf_lo(u.y) + p0[2], bf_hi(u.y) + p0[3]); av.z = pk2(bf_lo(u.z) + p1[0], bf_hi(u.z) + p1[1]); av.w = pk2(bf_lo(u.w) + p1[2], bf_hi(u.w) + p1[3]);
        const bf16x8 bv = *(const bf16x8*)(brow + st * 16);
        acc = __builtin_amdgcn_mfma_f32_32x32x16_bf16(__builtin_bit_cast(bf16x8, av), bv, acc, 0, 0, 0); }
#pragma unroll
    for (int r = 0; r < 16; ++r) part[(kh * 32 + (r & 3) + 8 * (r >> 2) + 4 * hi) * 128 + nt * 32 + r32] = acc[r];
    __syncthreads();
    for (int i = F.tid; i < 4096; i += 512) part[i] = gelu_tanh(part[i] + part[4096 + i]);
    __syncthreads();
    { const int row = F.tid >> 4, d4 = (F.tid & 15) * 4; f32x4 o = {0.f, 0.f, 0.f, 0.f};
#pragma unroll 8
      for (int c = 0; c < 128; ++c) { const float h = part[row * 128 + c]; const f32x4 w = *(const LAS f32x4*)(w2s + c * 64 + d4); o += w * h; }
      bf16* dst = (bf16*)(F.ws + (kv ? WS_VCMP : WS_KCMP)) + ((size_t)bh * 256 + n0 + row) * 64 + d4;
      if (n0 + row >= 255) o = (f32x4){0.f, 0.f, 0.f, 0.f};
      *(unsigned long long*)dst = (unsigned long long)pk2(o[0], o[1]) | ((unsigned long long)pk2(o[2], o[3]) << 32); }
    __syncthreads();
}
__device__ __forceinline__ void phase_dilated(Frame& F) {
    const bf16* z = (const bf16*)(F.ws + WS_Z); bf16* mix = (bf16*)(F.ws + WS_MIX); const int lane = F.lane;
    for (int it = F.gw; it < T * 4; it += F.ngw) {
        const int t = it >> 2, j = it & 3, b = t / SEQ, s = t % SEQ;
        float og[3], ls[3];
#pragma unroll
        for (int gi = 0; gi < 3; ++gi) {
            const int dil = gi == 0 ? 1 : (gi == 1 ? 4 : 16), head = gi * 4 + j;
            float q[64]; load_row64(z + (size_t)t * ZP + QC + head * 64, q);
            WAcc A; wacc_init(A);
            for (int k = lane; k <= 128; k += 64) { const int sk = s - k * dil;
                if (sk >= 0) { const bf16* kr = z + ((size_t)b * SEQ + sk) * ZP; const float sc = dot_row64(q, kr + KC + head * 64) * SC2; wacc_key(A, sc, kr + VC + head * 64); } }
            og[gi] = wacc_finish(A, lane, ls[gi]);
        }
        const float mx = fmaxf(ls[0], fmaxf(ls[1], ls[2])); const float w0 = ex2(ls[0] - mx), w1 = ex2(ls[1] - mx), w2 = ex2(ls[2] - mx);
        mix[(size_t)t * MIXW + 1280 + j * 64 + lane] = (bf16)f2bf((w0 * og[0] + w1 * og[1] + w2 * og[2]) / (w0 + w1 + w2));
    }
}
__device__ __forceinline__ void phase_moba(Frame& F) {
    const bf16* z = (const bf16*)(F.ws + WS_Z); bf16* mix = (bf16*)(F.ws + WS_MIX); const float* km = (const float*)(F.ws + WS_KMEAN); const int lane = F.lane;
    for (int it = F.gw; it < T * 8; it += F.ngw) {
        const int t = it >> 3, h = it & 7, b = t / SEQ, s = t % SEQ, cur = s >> 8;
        float q[64]; load_row64(z + (size_t)t * ZP + QA + h * 64, q);
        float gate = -1e30f;
        if (lane < cur) { const float* kmr = km + ((size_t)(b * 8 + h) * 16 + lane) * 64; float g = 0.f;
#pragma unroll
            for (int d = 0; d < 64; ++d) g += q[d] * kmr[d];
            gate = g; }
        int rank = 0;
        for (int jj = 0; jj < 16; ++jj) { const float gj = __shfl(gate, jj); rank += (gj > gate || (gj == gate && jj < lane)) ? 1 : 0; }
        const unsigned long long selm = __ballot(lane < cur && rank < 3);
        WAcc A; wacc_init(A);
        unsigned long long mm = selm;
        while (mm) { const int blk = __builtin_ctzll(mm); mm &= mm - 1;
            for (int i = 0; i < 4; ++i) { const bf16* kr = z + ((size_t)b * SEQ + blk * 256 + i * 64 + lane) * ZP; const float sc = dot_row64(q, kr + KA + h * 64) * SC2; wacc_key(A, sc, kr + VA + h * 64); } }
        for (int i = 0; i < 4; ++i) { const int sk = cur * 256 + i * 64 + lane;
            if (sk <= s) { const bf16* kr = z + ((size_t)b * SEQ + sk) * ZP; const float sc = dot_row64(q, kr + KA + h * 64) * SC2; wacc_key(A, sc, kr + VA + h * 64); } }
        float l2; const float o = wacc_finish(A, lane, l2);
        mix[(size_t)t * MIXW + h * 64 + lane] = (bf16)f2bf(o);
    }
}
__device__ __forceinline__ void phase_nsa(Frame& F) {
    const bf16* z = (const bf16*)(F.ws + WS_Z); bf16* mix = (bf16*)(F.ws + WS_MIX); const int lane = F.lane;
    LAS float* ps = (LAS float*)F.lds + F.wave * 320;
    for (int it = F.gw; it < T * 3; it += F.ngw) {
        const int t = it / 3, hk = it % 3, b = t / SEQ, s = t % SEQ, cur = s >> 6;
        const bf16* kc = (const bf16*)(F.ws + WS_KCMP) + ((size_t)(b * 3 + hk) * 256) * 64; const bf16* vc = (const bf16*)(F.ws + WS_VCMP) + ((size_t)(b * 3 + hk) * 256) * 64;
        const int ncv = s >= 31 ? ((s - 31) >> 4) + 1 : 0;
        float psum[4] = {0.f, 0.f, 0.f, 0.f}; float ocmp[4];
#pragma unroll
        for (int g = 0; g < 4; ++g) {
            float q[64]; load_row64(z + (size_t)t * ZP + QB + (hk * 4 + g) * 64, q);
            float sc[4]; float mx = -1e30f;
#pragma unroll
            for (int i = 0; i < 4; ++i) { const int n = lane + 64 * i; sc[i] = n < ncv ? dot_row64(q, kc + (size_t)n * 64) * SC2 : -1e30f; mx = fmaxf(mx, sc[i]); }
            mx = wave_max(mx); float p[4]; float ls = 0.f;
#pragma unroll
            for (int i = 0; i < 4; ++i) { const int n = lane + 64 * i; p[i] = n < ncv ? ex2(sc[i] - mx) : 0.f; ls += p[i]; }
            ls = wave_sum(ls); const float inv = ls > 0.f ? 1.f / ls : 0.f;
            float acc[64];
#pragma unroll
            for (int d = 0; d < 64; ++d) acc[d] = 0.f;
#pragma unroll
            for (int i = 0; i < 4; ++i) { const int n = lane + 64 * i; p[i] *= inv; psum[i] += p[i];
                if (n < ncv) { const v4u* pp = (const v4u*)(vc + (size_t)n * 64);
#pragma unroll
                    for (int c = 0; c < 8; ++c) { const v4u u = pp[c]; acc[8 * c + 0] += p[i] * bf_lo(u.x); acc[8 * c + 1] += p[i] * bf_hi(u.x); acc[8 * c + 2] += p[i] * bf_lo(u.y); acc[8 * c + 3] += p[i] * bf_hi(u.y);
                        acc[8 * c + 4] += p[i] * bf_lo(u.z); acc[8 * c + 5] += p[i] * bf_hi(u.z); acc[8 * c + 6] += p[i] * bf_lo(u.w); acc[8 * c + 7] += p[i] * bf_hi(u.w); } } }
            reduce_scatter64(acc, lane); ocmp[g] = acc[0];
        }
#pragma unroll
        for (int i = 0; i < 4; ++i) ps[lane + 64 * i] = (lane + 64 * i) < 255 ? psum[i] : 0.f;
        LDS_WAIT(); asm volatile("" ::: "memory");
        float imp = ps[4 * lane] + ps[4 * lane + 1] + ps[4 * lane + 2] + ps[4 * lane + 3]; if (lane > 0) imp += ps[4 * lane - 1];
        LDS_WAIT(); asm volatile("" ::: "memory");
        const bool valid = lane <= cur, forced = valid && (lane == 0 || lane > cur - 2);
        const float val = forced ? 1e30f : (valid ? imp : -1e30f);
        int rank = 0;
        for (int jj = 0; jj < 64; ++jj) { const float vj = __shfl(val, jj); rank += (vj > val || (vj == val && jj < lane)) ? 1 : 0; }
        const unsigned long long selm = __ballot(valid && rank < 16);
#pragma unroll
        for (int g = 0; g < 4; ++g) {
            const int head = hk * 4 + g;
            float q[64]; load_row64(z + (size_t)t * ZP + QB + head * 64, q);
            WAcc A; wacc_init(A);
            unsigned long long mm = selm;
            while (mm) { const int blk = __builtin_ctzll(mm); mm &= mm - 1; const int sk = blk * 64 + lane;
                if (sk <= s) { const bf16* kr = z + ((size_t)b * SEQ + sk) * ZP; const float scv = dot_row64(q, kr + KBS + hk * 64) * SC2; wacc_key(A, scv, kr + VBS + hk * 64); } }
            float l2; const float oslc = wacc_finish(A, lane, l2);
            wacc_init(A);
            for (int i = 0; i < 8; ++i) { const int sk = s - 511 + i * 64 + lane;
                if (sk >= 0) { const bf16* kr = z + ((size_t)b * SEQ + sk) * ZP; const float scv = dot_row64(q, kr + KBW + hk * 64) * SC2; wacc_key(A, scv, kr + VBW + hk * 64); } }
            const float owin = wacc_finish(A, lane, l2);
            const bf16* gp = z + (size_t)t * ZP + GB + head * 3;
            const float g0 = 1.f / (1.f + __expf(-bf1(gp[0]))), g1 = 1.f / (1.f + __expf(-bf1(gp[1]))), g2 = 1.f / (1.f + __expf(-bf1(gp[2])));
            mix[(size_t)t * MIXW + 512 + head * 64 + lane] = (bf16)f2bf(g0 * ocmp[g] + g1 * oslc + g2 * owin);
        }
    }
}

namespace fa {
typedef short bf16x8 __attribute__((ext_vector_type(8)));
typedef short s16x4 __attribute__((ext_vector_type(4)));
typedef float f32x16 __attribute__((ext_vector_type(16)));
typedef short v4i16_t __attribute__((ext_vector_type(4)));
constexpr int SLOTB = 8192, LDS_K = 0, LDS_V = 3 * SLOTB, LDS_WS = 6 * SLOTB, LDS_PS = LDS_WS + 8 * 256, LDS_SEL = LDS_PS + 8 * 8192, LDS_Q = LDS_SEL + 1024, LDS_END = LDS_Q + 64;
constexpr float THR = 8.f;
constexpr int NEGBIG = -(1 << 29);
#define FA_MFMA(a, b, c) __builtin_amdgcn_mfma_f32_32x32x16_bf16(a, b, c, 0, 0, 0)
typedef LAS const char* lcp;
__device__ __forceinline__ int crow(int r, int hi) { return (r & 3) + 8 * (r >> 2) + 4 * hi; }
__device__ __forceinline__ void glds16(const void* gsrc, unsigned lds_dst) { unsigned keep;
    asm volatile("s_mov_b32 %0, m0\n\ts_mov_b32 m0, %2\n\ts_nop 0\n\tglobal_load_lds_dwordx4 %1, off\n\ts_mov_b32 m0, %0" : "=&s"(keep) : "v"(gsrc), "s"(lds_dst) : "memory"); }
__device__ __forceinline__ s16x4 vtr(lcp p) { return __builtin_bit_cast(s16x4, __builtin_amdgcn_ds_read_tr16_b64_v4i16((LAS v4i16_t*)p)); }
__device__ __forceinline__ unsigned cvtpk(float lo, float hi) { typedef float f2 __attribute__((ext_vector_type(2))); typedef __bf16 b2 __attribute__((ext_vector_type(2))); f2 v = {lo, hi}; b2 b = __builtin_convertvector(v, b2); return __builtin_bit_cast(unsigned, b); }
__device__ __forceinline__ void half_pair(float v, float& x0, float& x1) { unsigned a = __builtin_bit_cast(unsigned, v), b = a;
    asm volatile("s_nop 1\n\tv_permlane32_swap_b32 %0, %1\n\ts_nop 1" : "+v"(a), "+v"(b));
    x0 = __builtin_bit_cast(float, a); x1 = __builtin_bit_cast(float, b); }
__device__ __forceinline__ float half_max(float v) { float x0, x1; half_pair(v, x0, x1); return fmaxf(x0, x1); }
__device__ __forceinline__ float half_sum(float v) { float x0, x1; half_pair(v, x0, x1); return x0 + x1; }
#define FA_WAIT_BAR(N) asm volatile("s_waitcnt vmcnt(" #N ") lgkmcnt(0)\n\ts_barrier" ::: "memory")

struct Rows { int qlo, qhi, lo_min, lo_max, hi_min, hi_max; };
struct St { float m, l; f32x16 o[2]; };
__device__ __forceinline__ void st_init(St& s) { s.m = -INFINITY; s.l = 0.f; s.o[0] = f32x16{}; s.o[1] = f32x16{}; }

__device__ __forceinline__ void qk_tile(f32x16& p0, f32x16& p1, lcp kslot, const bf16x8 (&qr)[4], int r32, int hi) {
    lcp kb = kslot + hi * 1024 + r32 * 16;
    p0 = f32x16{}; p1 = f32x16{};
#pragma unroll
    for (int d0 = 0; d0 < 4; ++d0) { const bf16x8 b0 = *(const LAS bf16x8*)(kb + d0 * 2048), b1 = *(const LAS bf16x8*)(kb + d0 * 2048 + 512);
        p0 = FA_MFMA(b0, qr[d0], p0); p1 = FA_MFMA(b1, qr[d0], p1); }
}
__device__ __forceinline__ void band_mask(f32x16& p0, f32x16& p1, int kb, int hi, int qlo, int qhi) {
#pragma unroll
    for (int r = 0; r < 16; ++r) { const int k = kb + (r & 3) + 8 * (r >> 2) + 4 * hi;
        if (k > qhi || k < qlo) p0[r] = -INFINITY; if (k + 32 > qhi || k + 32 < qlo) p1[r] = -INFINITY; }
}
__device__ __forceinline__ void flash_step(St& s, f32x16& p0, f32x16& p1, lcp vslot, LAS float* wsf, int lane, int r32, int hi) {
    float mx = fmaxf(p0[0], p1[0]);
#pragma unroll
    for (int r = 1; r < 16; ++r) mx = fmaxf(mx, fmaxf(p0[r], p1[r]));
    mx = half_max(mx);
    const float t2 = mx * SC2;
    if (__any(t2 > s.m + THR)) {
        const float mn = fmaxf(s.m, t2);
        const float alpha = (mn == -INFINITY) ? 1.f : ex2(s.m - mn);
        s.l *= alpha; s.m = mn;
        if (hi == 0) wsf[r32] = alpha;
#pragma unroll
        for (int r = 0; r < 16; ++r) { const float a = wsf[crow(r, hi)]; s.o[0][r] *= a; s.o[1][r] *= a; }
    }
    const float mu = (s.m == -INFINITY) ? 0.f : s.m;
    float ls = 0.f;
#pragma unroll
    for (int r = 0; r < 16; ++r) { p0[r] = ex2(__builtin_fmaf(p0[r], SC2, -mu)); p1[r] = ex2(__builtin_fmaf(p1[r], SC2, -mu)); ls += p0[r] + p1[r]; }
    s.l += ls;
    typedef unsigned u32x4 __attribute__((ext_vector_type(4)));
    const u32x4 w0 = {cvtpk(p0[0], p0[1]), cvtpk(p0[2], p0[3]), cvtpk(p0[4], p0[5]), cvtpk(p0[6], p0[7])}, w1 = {cvtpk(p0[8], p0[9]), cvtpk(p0[10], p0[11]), cvtpk(p0[12], p0[13]), cvtpk(p0[14], p0[15])};
    const u32x4 w2 = {cvtpk(p1[0], p1[1]), cvtpk(p1[2], p1[3]), cvtpk(p1[4], p1[5]), cvtpk(p1[6], p1[7])}, w3 = {cvtpk(p1[8], p1[9]), cvtpk(p1[10], p1[11]), cvtpk(p1[12], p1[13]), cvtpk(p1[14], p1[15])};
    const bf16x8 pa[4] = {__builtin_bit_cast(bf16x8, w0), __builtin_bit_cast(bf16x8, w1), __builtin_bit_cast(bf16x8, w2), __builtin_bit_cast(bf16x8, w3)};
    lcp vp = vslot + ((lane >> 4) & 1) * 32 + (lane & 3) * 8 + (4 * hi + ((lane & 15) >> 2)) * 64;
#pragma unroll
    for (int d0 = 0; d0 < 2; ++d0)
#pragma unroll
        for (int kg = 0; kg < 4; ++kg) { const s16x4 lo = vtr(vp + d0 * 4096 + kg * 1024), hh = vtr(vp + d0 * 4096 + kg * 1024 + 512);
            const bf16x8 vf = {lo[0], lo[1], lo[2], lo[3], hh[0], hh[1], hh[2], hh[3]};
            s.o[d0] = FA_MFMA(pa[kg], vf, s.o[d0]); }
}
template <bool USESEL, class SelT>
__device__ __forceinline__ void stream_pv(LAS char* L, int wid, int lane, const bf16* Kb, size_t sK, const bf16* Vb, size_t sV, int t_lo, int t_hi,
                                          const bf16x8 (&qr)[4], const Rows& R, SelT selm, int tpb_shift, int cur_blk, St& s) {
    const int r32 = lane & 31, hi = lane >> 5, n = t_hi - t_lo + 1;
    if (n <= 0) return;
    const unsigned lds0 = (unsigned)(uintptr_t)L;
    const bf16* ksrc = Kb + ((size_t)t_lo * 64 + lane) * sK + wid * 8;
    const bf16* vsrc = Vb + ((size_t)t_lo * 64 + 16 * (wid & 3) + (lane >> 2)) * sV + (wid >> 2) * 32 + (lane & 3) * 8;
    const unsigned kdst = lds0 + LDS_K + wid * 1024, vdst = lds0 + LDS_V + wid * 1024;
    LAS float* wsf = (LAS float*)(L + LDS_WS) + wid * 64;
#define FA_ISSUE(i, slot) do { glds16(ksrc + (size_t)(i) * 64 * sK, (unsigned)__builtin_amdgcn_readfirstlane(kdst + (slot) * SLOTB)); glds16(vsrc + (size_t)(i) * 64 * sV, (unsigned)__builtin_amdgcn_readfirstlane(vdst + (slot) * SLOTB)); } while (0)
    asm volatile("s_waitcnt vmcnt(0)" ::: "memory");
    FA_ISSUE(0, 0); if (n > 1) FA_ISSUE(1, 1);
    int slot = 0;
    for (int i = 0; i < n; ++i) {
        if (i + 1 < n) FA_WAIT_BAR(2); else FA_WAIT_BAR(0);
        if (i + 2 < n) { const int s2 = slot >= 1 ? slot - 1 : 2; FA_ISSUE(i + 2, s2); }
        const int t = t_lo + i, kb = t * 64;
        int mode; bool sel = true;
        if (USESEL && (t >> tpb_shift) < cur_blk) { sel = ((selm >> (t >> tpb_shift)) & (SelT)1) != (SelT)0; const unsigned long long bal = __ballot(sel); mode = bal == 0ull ? 0 : (bal == ~0ull ? 1 : 3); }
        else mode = (kb > R.hi_max || kb + 63 < R.lo_min) ? 0 : ((kb + 63 <= R.hi_min && kb >= R.lo_max) ? 1 : 2);
        if (mode != 0) {
            f32x16 p0, p1; qk_tile(p0, p1, (lcp)L + LDS_K + slot * SLOTB, qr, r32, hi);
            if (mode == 2) band_mask(p0, p1, kb, hi, R.qlo, R.qhi);
            if (mode == 3) {
#pragma unroll
                for (int r = 0; r < 16; ++r) { p0[r] = sel ? p0[r] : -INFINITY; p1[r] = sel ? p1[r] : -INFINITY; } }
            flash_step(s, p0, p1, (lcp)L + LDS_V + slot * SLOTB, wsf, lane, r32, hi);
        }
        slot = slot == 2 ? 0 : slot + 1;
    }
    asm volatile("s_waitcnt lgkmcnt(0)\n\ts_barrier" ::: "memory");
#undef FA_ISSUE
}
__device__ __forceinline__ float st_invl(const St& s, float& ltot) { ltot = half_sum(s.l); return ltot > 0.f ? 1.f / ltot : 0.f; }
template <bool ACCUM>
__device__ __forceinline__ void scale_rows(f32x16 (&dst)[2], const f32x16 (&o)[2], float fac, LAS float* wsf, int r32, int hi) {
    if (hi == 0) wsf[r32] = fac;
#pragma unroll
    for (int r = 0; r < 16; ++r) { const float a = wsf[crow(r, hi)]; if (ACCUM) { dst[0][r] += o[0][r] * a; dst[1][r] += o[1][r] * a; } else { dst[0][r] = o[0][r] * a; dst[1][r] = o[1][r] * a; } }
}

__device__ __forceinline__ void unit_dilated(LAS char* L, unsigned char* ws, int wid, int lane, int uid) {
    const int r32 = lane & 31, hi = lane >> 5;
    const int b = uid / 192, gi = (uid % 192) >> 6, x = uid & 63, j = x >> 4, y = x & 15;
    const int dil = gi == 0 ? 1 : (gi == 1 ? 4 : 16), res = gi == 0 ? 0 : (gi == 1 ? (y >> 2) : y), u = gi == 0 ? y : (gi == 1 ? (y & 3) : 0), head = gi * 4 + j;
    const bf16* z = (const bf16*)(ws + WS_Z);
    const bf16* base = z + ((size_t)b * SEQ + res) * ZP + head * 64;
    const size_t sr = (size_t)dil * ZP;
    const int i = 256 * u + 32 * wid + r32;
    bf16x8 qr[4];
#pragma unroll
    for (int d0 = 0; d0 < 4; ++d0) qr[d0] = *(const bf16x8*)(base + QC + (size_t)i * sr + d0 * 16 + hi * 8);
    asm volatile("s_waitcnt vmcnt(0)" : "+v"(qr[0]), "+v"(qr[1]), "+v"(qr[2]), "+v"(qr[3]) :: "memory");
    Rows R; R.qhi = i; R.qlo = i - 128; R.hi_min = 256 * u + 32 * wid; R.hi_max = R.hi_min + 31; R.lo_min = R.hi_min - 128; R.lo_max = R.hi_max - 128;
    St s; st_init(s);
    stream_pv<false, unsigned>(L, wid, lane, base + KC, sr, base + VC, sr, (4 * u - 2) > 0 ? 4 * u - 2 : 0, 4 * u + 3, qr, R, 0u, 0, 0, s);
    float ltot; const float inv = st_invl(s, ltot);
    LAS float* wsf = (LAS float*)(L + LDS_WS) + wid * 64;
    f32x16 out[2]; scale_rows<false>(out, s.o, inv, wsf, r32, hi);
    float* dout = (float*)(ws + WS_DILO) + (size_t)gi * T * 256; float* dlse = (float*)(ws + WS_DILL) + (size_t)gi * T * 4;
    if (hi == 0) dlse[((size_t)b * SEQ + (size_t)i * dil + res) * 4 + j] = s.m + __log2f(ltot);
#pragma unroll
    for (int r = 0; r < 16; ++r) { const int q = crow(r, hi); const size_t tok = (size_t)b * SEQ + (size_t)(256 * u + 32 * wid + q) * dil + res;
        dout[tok * 256 + j * 64 + r32] = out[0][r]; dout[tok * 256 + j * 64 + 32 + r32] = out[1][r]; }
}
__device__ __forceinline__ void unit_moba(LAS char* L, unsigned char* ws, int wid, int lane, int uid) {
    const int r32 = lane & 31, hi = lane >> 5, b = uid >> 7, h = (uid >> 4) & 7, qb = uid & 15;
    const bf16* z = (const bf16*)(ws + WS_Z) + (size_t)b * SEQ * ZP;
    const int s = 256 * qb + 32 * wid + r32;
    bf16x8 qr[4];
#pragma unroll
    for (int d0 = 0; d0 < 4; ++d0) qr[d0] = *(const bf16x8*)(z + (size_t)s * ZP + QA + h * 64 + d0 * 16 + hi * 8);
    asm volatile("s_waitcnt vmcnt(0)" : "+v"(qr[0]), "+v"(qr[1]), "+v"(qr[2]), "+v"(qr[3]) :: "memory");
    unsigned selm = 0u;
    if (qb > 0) {
        const float* km = (const float*)(ws + WS_KMEAN) + ((size_t)(b * 8 + h) * 16) * 64;
        f32x16 g = f32x16{};
#pragma unroll
        for (int d0 = 0; d0 < 4; ++d0) {
            f32x4 a0 = {0.f, 0.f, 0.f, 0.f}, a1 = {0.f, 0.f, 0.f, 0.f};
            if (r32 < 16) { a0 = *(const f32x4*)(km + r32 * 64 + d0 * 16 + hi * 8); a1 = *(const f32x4*)(km + r32 * 64 + d0 * 16 + hi * 8 + 4); }
            const float v[8] = {a0[0], a0[1], a0[2], a0[3], a1[0], a1[1], a1[2], a1[3]};
            unsigned wh[4], wl[4];
#pragma unroll
            for (int e = 0; e < 4; ++e) { const unsigned h0 = f2bf(v[2 * e]), h1 = f2bf(v[2 * e + 1]); wh[e] = h0 | (h1 << 16);
                wl[e] = pk2(v[2 * e] - __builtin_bit_cast(float, h0 << 16), v[2 * e + 1] - __builtin_bit_cast(float, h1 << 16)); }
            typedef unsigned u32x4 __attribute__((ext_vector_type(4)));
            const u32x4 uh = {wh[0], wh[1], wh[2], wh[3]}, ul = {wl[0], wl[1], wl[2], wl[3]};
            g = FA_MFMA(__builtin_bit_cast(bf16x8, uh), qr[d0], g); g = FA_MFMA(__builtin_bit_cast(bf16x8, ul), qr[d0], g);
        }
        float gv[16];
#pragma unroll
        for (int r = 0; r < 8; ++r) { float x0, x1; half_pair(g[r], x0, x1); gv[8 * (r >> 2) + (r & 3)] = x0; gv[8 * (r >> 2) + 4 + (r & 3)] = x1; }
#pragma unroll
        for (int i = 0; i < 16; ++i) if (i >= qb) gv[i] = -INFINITY;
#pragma unroll
        for (int i = 0; i < 16; ++i) { int rank = 0;
#pragma unroll
            for (int jx = 0; jx < 16; ++jx) rank += (gv[jx] > gv[i] || (gv[jx] == gv[i] && jx < i)) ? 1 : 0;
            if (i < qb && rank < 3) selm |= (1u << i); }
    }
    Rows R; R.qhi = s; R.qlo = NEGBIG; R.hi_min = 256 * qb + 32 * wid; R.hi_max = R.hi_min + 31; R.lo_min = NEGBIG; R.lo_max = NEGBIG;
    St st; st_init(st);
    stream_pv<true, unsigned>(L, wid, lane, z + KA + h * 64, (size_t)ZP, z + VA + h * 64, (size_t)ZP, 0, 4 * qb + 3, qr, R, selm, 2, qb, st);
    float ltot; const float inv = st_invl(st, ltot);
    LAS float* wsf = (LAS float*)(L + LDS_WS) + wid * 64;
    f32x16 out[2]; scale_rows<false>(out, st.o, inv, wsf, r32, hi);
    bf16* mix = (bf16*)(ws + WS_MIX) + ((size_t)b * SEQ + 256 * qb + 32 * wid) * MIXW + h * 64;
#pragma unroll
    for (int r = 0; r < 16; ++r) { const int q = crow(r, hi); mix[(size_t)q * MIXW + r32] = (bf16)f2bf(out[0][r]); mix[(size_t)q * MIXW + 32 + r32] = (bf16)f2bf(out[1][r]); }
}
__device__ __forceinline__ void unit_nsa(LAS char* L, unsigned char* ws, int wid, int lane, int uid) {
    const int r32 = lane & 31, hi = lane >> 5, bh = uid >> 6, b = bh / 3, hk = bh % 3, tb = uid & 63;
    const int jt = r32 & 7, g = r32 >> 3, head = hk * 4 + g, s = 64 * tb + 8 * wid + jt, smin = 64 * tb + 8 * wid, smax = smin + 7;
    const bf16* z = (const bf16*)(ws + WS_Z) + (size_t)b * SEQ * ZP;
    LAS float* wsf = (LAS float*)(L + LDS_WS) + wid * 64;
    bf16x8 qr[4];
#pragma unroll
    for (int d0 = 0; d0 < 4; ++d0) qr[d0] = *(const bf16x8*)(z + (size_t)s * ZP + QB + head * 64 + d0 * 16 + hi * 8);
    asm volatile("s_waitcnt vmcnt(0)" : "+v"(qr[0]), "+v"(qr[1]), "+v"(qr[2]), "+v"(qr[3]) :: "memory");
    const bf16* gp = z + (size_t)s * ZP + GB + head * 3;
    const float g0 = 1.f / (1.f + __expf(-bf1(gp[0]))), g1 = 1.f / (1.f + __expf(-bf1(gp[1]))), g2 = 1.f / (1.f + __expf(-bf1(gp[2])));
    f32x16 fin[2];
    const bf16* kc = (const bf16*)(ws + WS_KCMP) + ((size_t)(b * 3 + hk) * 256) * 64; const bf16* vc = (const bf16*)(ws + WS_VCMP) + ((size_t)(b * 3 + hk) * 256) * 64;
    const int ncv = s >= 31 ? ((s - 31) >> 4) + 1 : 0, ncv_lo = smin >= 31 ? ((smin - 31) >> 4) + 1 : 0, ncv_hi = smax >= 31 ? ((smax - 31) >> 4) + 1 : 0;
    const int ncv_blk = ((64 * tb + 63 - 31) >> 4) + 1, ct_hi = (ncv_blk - 1) >> 6;
    Rows Rc; Rc.qhi = ncv - 1; Rc.qlo = NEGBIG; Rc.hi_min = ncv_lo - 1; Rc.hi_max = ncv_hi - 1; Rc.lo_min = NEGBIG; Rc.lo_max = NEGBIG;
    St st; st_init(st);
    stream_pv<false, unsigned>(L, wid, lane, kc, (size_t)64, vc, (size_t)64, 0, ct_hi, qr, Rc, 0u, 0, 0, st);
    float ltot; const float invc = st_invl(st, ltot);
    scale_rows<false>(fin, st.o, invc * g0, wsf, r32, hi);
    {
        LAS float* ps = (LAS float*)(L + LDS_PS) + wid * 2048;
        for (int i = lane; i < 2048; i += 64) ps[i] = 0.f;
        const float mu = (st.m == -INFINITY) ? 0.f : st.m;
        const unsigned lds0 = (unsigned)(uintptr_t)L; const bf16* ksrc = kc + (size_t)lane * 64 + wid * 8; const unsigned kdst = lds0 + LDS_K + wid * 1024;
        const int n = ct_hi + 1;
        asm volatile("s_waitcnt vmcnt(0)" ::: "memory");
        glds16(ksrc, (unsigned)__builtin_amdgcn_readfirstlane(kdst)); if (n > 1) glds16(ksrc + 64 * 64, (unsigned)__builtin_amdgcn_readfirstlane(kdst + SLOTB));
        int slot = 0;
        for (int i = 0; i < n; ++i) {
            if (i + 1 < n) FA_WAIT_BAR(1); else FA_WAIT_BAR(0);
            if (i + 2 < n) { const int s2 = slot >= 1 ? slot - 1 : 2; glds16(ksrc + (size_t)(i + 2) * 64 * 64, (unsigned)__builtin_amdgcn_readfirstlane(kdst + s2 * SLOTB)); }
            const int kb = i * 64;
            if (kb <= Rc.hi_max) {
                f32x16 p0, p1; qk_tile(p0, p1, (lcp)L + LDS_K + slot * SLOTB, qr, r32, hi);
#pragma unroll
                for (int r = 0; r < 16; ++r) { const int k = kb + crow(r, hi);
                    float a = (k <= Rc.qhi) ? ex2(__builtin_fmaf(p0[r], SC2, -mu)) * invc : 0.f, c = (k + 32 <= Rc.qhi) ? ex2(__builtin_fmaf(p1[r], SC2, -mu)) * invc : 0.f;
                    a += __shfl_xor(a, 8); a += __shfl_xor(a, 16); c += __shfl_xor(c, 8); c += __shfl_xor(c, 16);
                    if (r32 < 8) { ps[r32 * 256 + k] = a; ps[r32 * 256 + k + 32] = c; } }
            }
            slot = slot == 2 ? 0 : slot + 1;
        }
        asm volatile("s_waitcnt lgkmcnt(0)\n\ts_barrier" ::: "memory");
    }
    unsigned long long selm = 0ull;
    {
        const LAS float* ps = (const LAS float*)(L + LDS_PS) + wid * 2048;
#pragma unroll 1
        for (int j = 0; j < 8; ++j) {
            const LAS float* pj = ps + j * 256;
            float imp = (pj[4 * lane] + pj[4 * lane + 1]) + (pj[4 * lane + 2] + (lane < 63 ? pj[4 * lane + 3] : 0.f)); if (lane > 0) imp += pj[4 * lane - 1];
            const bool valid = lane <= tb, forced = valid && (lane == 0 || lane > tb - 2);
            const float val = forced ? 1e30f : (valid ? imp : -1e30f);
            int rank = 0;
            for (int jj = 0; jj < 64; ++jj) { const float vj = __shfl(val, jj); rank += (vj > val || (vj == val && jj < lane)) ? 1 : 0; }
            const unsigned long long mk = __ballot(valid && rank < 16);
            if (jt == j) selm = mk;
        }
    }
    Rows Rs; Rs.qhi = s; Rs.qlo = NEGBIG; Rs.hi_min = smin; Rs.hi_max = smax; Rs.lo_min = NEGBIG; Rs.lo_max = NEGBIG;
    st_init(st);
    stream_pv<true, unsigned long long>(L, wid, lane, z + KBS + hk * 64, (size_t)ZP, z + VBS + hk * 64, (size_t)ZP, 0, tb, qr, Rs, selm, 0, tb, st);
    { const float inv = st_invl(st, ltot); scale_rows<true>(fin, st.o, inv * g1, wsf, r32, hi); }
    Rows Rw; Rw.qhi = s; Rw.qlo = s - 511; Rw.hi_min = smin; Rw.hi_max = smax; Rw.lo_min = smin - 511; Rw.lo_max = smax - 511;
    st_init(st);
    stream_pv<false, unsigned>(L, wid, lane, z + KBW + hk * 64, (size_t)ZP, z + VBW + hk * 64, (size_t)ZP, (tb - 8) > 0 ? tb - 8 : 0, tb, qr, Rw, 0u, 0, 0, st);
    { const float inv = st_invl(st, ltot); scale_rows<true>(fin, st.o, inv * g2, wsf, r32, hi); }
    bf16* mix = (bf16*)(ws + WS_MIX) + ((size_t)b * SEQ + 64 * tb + 8 * wid) * MIXW + 512 + hk * 256;
#pragma unroll
    for (int r = 0; r < 16; ++r) { const int q = crow(r, hi); bf16* o = mix + (size_t)(q & 7) * MIXW + (q >> 3) * 64;
        o[r32] = (bf16)f2bf(fin[0][r]); o[32 + r32] = (bf16)f2bf(fin[1][r]); }
}
#undef FA_MFMA
}
__device__ const unsigned short P2_ORDER[640] = {63,127,191,255,319,383,62,126,190,254,318,382,61,125,189,253,317,381,60,124,188,252,316,380,59,123,187,251,315,379,58,122,186,250,314,378,57,121,185,249,313,377,56,120,184,248,312,376,55,119,183,247,311,375,54,118,182,246,310,374,53,117,181,245,309,373,52,116,180,244,308,372,51,115,179,243,307,371,50,114,178,242,306,370,49,113,177,241,305,369,48,112,176,240,304,368,47,111,175,239,303,367,46,110,174,238,302,366,399,415,431,447,463,479,495,511,527,543,559,575,591,607,623,639,45,109,173,237,301,365,44,108,172,236,300,364,43,107,171,235,299,363,42,106,170,234,298,362,398,414,430,446,462,478,494,510,526,542,558,574,590,606,622,638,41,105,169,233,297,361,40,104,168,232,296,360,39,103,167,231,295,359,38,102,166,230,294,358,397,413,429,445,461,477,493,509,525,541,557,573,589,605,621,637,37,101,165,229,293,357,36,100,164,228,292,356,35,99,163,227,291,355,34,98,162,226,290,354,396,412,428,444,460,476,492,508,524,540,556,572,588,604,620,636,33,97,161,225,289,353,32,96,160,224,288,352,395,411,427,443,459,475,491,507,523,539,555,571,587,603,619,635,31,95,159,223,287,351,30,94,158,222,286,350,29,93,157,221,285,349,28,92,156,220,284,348,394,410,426,442,458,474,490,506,522,538,554,570,586,602,618,634,27,91,155,219,283,347,26,90,154,218,282,346,25,89,153,217,281,345,24,88,152,216,280,344,393,409,425,441,457,473,489,505,521,537,553,569,585,601,617,633,23,87,151,215,279,343,22,86,150,214,278,342,21,85,149,213,277,341,20,84,148,212,276,340,392,408,424,440,456,472,488,504,520,536,552,568,584,600,616,632,19,83,147,211,275,339,18,82,146,210,274,338,17,81,145,209,273,337,16,80,144,208,272,336,391,407,423,439,455,471,487,503,519,535,551,567,583,599,615,631,15,79,143,207,271,335,14,78,142,206,270,334,390,406,422,438,454,470,486,502,518,534,550,566,582,598,614,630,13,77,141,205,269,333,12,76,140,204,268,332,11,75,139,203,267,331,10,74,138,202,266,330,389,405,421,437,453,469,485,501,517,533,549,565,581,597,613,629,9,73,137,201,265,329,8,72,136,200,264,328,7,71,135,199,263,327,388,404,420,436,452,468,484,500,516,532,548,564,580,596,612,628,6,70,134,198,262,326,5,69,133,197,261,325,387,403,419,435,451,467,483,499,515,531,547,563,579,595,611,627,4,68,132,196,260,324,3,67,131,195,259,323,386,402,418,434,450,466,482,498,514,530,546,562,578,594,610,626,2,66,130,194,258,322,1,65,129,193,257,321,385,401,417,433,449,465,481,497,513,529,545,561,577,593,609,625,0,64,128,192,256,320,384,400,416,432,448,464,480,496,512,528,544,560,576,592,608,624};

__device__ __forceinline__ int dequeue(unsigned* ctr, volatile LAS int* w, int tid) {
    if (tid == 0) *w = (int)__hip_atomic_fetch_add(ctr, 1u, __ATOMIC_RELAXED, __HIP_MEMORY_SCOPE_AGENT);
    __syncthreads(); const int v = *w; __syncthreads(); return __builtin_amdgcn_readfirstlane(v);
}
__device__ __forceinline__ void dil_combine(Frame& F) {
    const float* dout = (const float*)(F.ws + WS_DILO); const float* dlse = (const float*)(F.ws + WS_DILL); bf16* mix = (bf16*)(F.ws + WS_MIX);
    for (int i = F.gw * 64 + F.lane; i < T * 256; i += F.ngw * 64) { const int t = i >> 8, c = i & 255, j = c >> 6;
        const float l0 = dlse[(size_t)t * 4 + j], l1 = dlse[(size_t)T * 4 + (size_t)t * 4 + j], l2 = dlse[(size_t)2 * T * 4 + (size_t)t * 4 + j];
        const float mx = fmaxf(l0, fmaxf(l1, l2)), w0 = ex2(l0 - mx), w1 = ex2(l1 - mx), w2 = ex2(l2 - mx);
        const float o = w0 * dout[i] + w1 * dout[(size_t)T * 256 + i] + w2 * dout[(size_t)2 * T * 256 + i];
        mix[(size_t)t * MIXW + 1280 + c] = (bf16)f2bf(o / (w0 + w1 + w2)); }
}
__device__ __forceinline__ void load_router(Frame& F, const float* rw) {
    LAS float* rwt = (LAS float*)F.lds;
    for (int i = F.tid; i < 8192; i += 512) { const f32x4 v = ((const f32x4*)rw)[i]; const int k = i >> 2, e0 = (i & 3) * 4; rwt[(e0 + 0) * 2048 + k] = v.x; rwt[(e0 + 1) * 2048 + k] = v.y; rwt[(e0 + 2) * 2048 + k] = v.z; rwt[(e0 + 3) * 2048 + k] = v.w; }
    __syncthreads();
}
__device__ __forceinline__ void phase_ln1_router(Frame& F, const Args& a, int L) {
    load_router(F, a.in[I_RW]);
    const LAS f32x4* rwt4 = (const LAS f32x4*)F.lds; const int lane = F.lane;
    const float* y = (const float*)(F.ws + WS_Y); float* h32 = (float*)(F.ws + WS_H32); bf16* hb = (bf16*)(F.ws + WS_HB);
    int* tokc = (int*)(F.ws + WS_TOKC); int* toks = (int*)(F.ws + WS_TOKS); float* tokw = (float*)(F.ws + WS_TOKW);
    volatile LAS int* cl = (volatile LAS int*)(F.lds + LDSCTL_OFF + 2048);
    for (int i = F.tid; i < 512; i += 512) cl[i] = -1;
    __syncthreads();
    for (int m = F.gw; m < T; m += F.ngw) {
        f32x4 o[8]; ln_row(y + (size_t)m * D, nullptr, a.in[I_LN1G] + (size_t)L * D, a.in[I_LN1B] + (size_t)L * D, (float*)nullptr, hb + (size_t)m * D, lane, o);
        float myl = 0.f;
#pragma unroll 1
        for (int e = 0; e < 16; ++e) { float s = 0.f;
#pragma unroll
            for (int j = 0; j < 8; ++j) { const f32x4 w = rwt4[e * 512 + j * 64 + lane]; s += (o[j].x * w.x + o[j].y * w.y) + (o[j].z * w.z + o[j].w * w.w); }
            s = wave_sum(s); if (lane == e) myl = s; }
        if (lane < 16) myl += a.in[I_RB][lane];
        float pe[16]; float mx = -1e30f;
#pragma unroll
        for (int e = 0; e < 16; ++e) { pe[e] = __shfl(myl, e); mx = fmaxf(mx, pe[e]); }
#pragma unroll
        for (int e = 0; e < 16; ++e) pe[e] = expf(pe[e] - mx);
        int gsel = 0; float gbest = -1.f; int i1s = 0, i2s = 1; float p1s = 0.f, p2s = 0.f;
#pragma unroll
        for (int g = 0; g < 4; ++g) {
            int i1 = 0; float p1 = pe[4 * g];
#pragma unroll
            for (int i = 1; i < 4; ++i) if (pe[4 * g + i] > p1) { p1 = pe[4 * g + i]; i1 = i; }
            int i2 = -1; float p2 = -1.f;
#pragma unroll
            for (int i = 0; i < 4; ++i) if (i != i1 && pe[4 * g + i] > p2) { p2 = pe[4 * g + i]; i2 = i; }
            const float sg = p1 + p2;
            if (sg > gbest) { gbest = sg; gsel = g; i1s = i1; i2s = i2; p1s = p1; p2s = p2; }
        }
        const int lo = i1s < i2s ? i1s : i2s, hi = i1s < i2s ? i2s : i1s;
        const float wlo = (i1s < i2s ? p1s : p2s) / (p1s + p2s), whi = (i1s < i2s ? p2s : p1s) / (p1s + p2s);
        const int pi = lo == 0 ? hi - 1 : (lo == 1 ? hi + 1 : 5);
        const int cls = gsel * 6 + pi;
        if (lane == 0) { cl[((m - F.gw) / F.ngw) * 8 + F.wave] = cls; tokc[m] = cls; tokw[2 * m] = wlo; tokw[2 * m + 1] = whi; }
    }
    __syncthreads();
    { const int nloc = ((T - F.bx * 8 + F.ngw - 1) / F.ngw) * 8;
      if (F.tid < nloc) { const int c = cl[F.tid]; if (c >= 0) { int rank = 0; for (int j = 0; j < F.tid; ++j) rank += (cl[j] == c) ? 1 : 0; toks[F.bx * 8 + (F.tid & 7) + (F.tid >> 3) * F.ngw] = rank; } }
      if (F.tid < 32) { int n = 0; if (F.tid < 24) for (int j = 0; j < nloc; ++j) n += (cl[j] == F.tid) ? 1 : 0; ((int*)(F.ws + WS_CNTB))[F.bx * 32 + F.tid] = n; } }
    __syncthreads();
}
__device__ __forceinline__ void build_tiles(Frame& F, int L) {
    volatile LAS int* tab = (volatile LAS int*)(F.lds + TILE_OFF); volatile LAS int* part = (volatile LAS int*)(F.lds + LDSCTL_OFF + 4096);
    const int* cntb = (const int*)(F.ws + WS_CNTB); const int chunk = (F.G + 15) / 16;
    if (F.tid < 384) { const int c = F.tid % 24, ch = F.tid / 24; int s = 0; for (int b = ch * chunk; b < (ch + 1) * chunk && b < F.G; ++b) s += cntb[b * 32 + c]; part[ch * 24 + c] = s; }
    __syncthreads();
    if (F.tid < 24) { const int c = F.tid, mych = F.bx / chunk; int tot = 0, base = 0;
        for (int ch = 0; ch < 16; ++ch) { const int v = part[ch * 24 + c]; tot += v; if (ch < mych) base += v; }
        for (int b = mych * chunk; b < F.bx; ++b) base += cntb[b * 32 + c];
        tab[100 + c] = base; tab[128 + c] = tot; }
    __syncthreads();
    if (F.tid == 0) { int off = 0, nt = 0;
        for (int c = 0; c < 24; ++c) { const int n = tab[128 + c]; tab[64 + c] = off; const int k = (n + 255) >> 8; for (int i = 0; i < k && nt < MAXTILES; ++i) tab[nt++] = c; off += k * 256; }
        tab[64 + 24] = off; tab[96] = nt; }
    __syncthreads();
}
__device__ __forceinline__ void phase_gather(Frame& F, int L) {
    volatile LAS int* tab = (volatile LAS int*)(F.lds + TILE_OFF);
    const int* tokc = (const int*)(F.ws + WS_TOKC); int* toks = (int*)(F.ws + WS_TOKS); const float* tokw = (const float*)(F.ws + WS_TOKW);
    int* ptok = (int*)(F.ws + WS_PTOK); float* pw = (float*)(F.ws + WS_PW); const v4u* hb = (const v4u*)(F.ws + WS_HB); v4u* xp = (v4u*)(F.ws + WS_XP);
    if (F.bx < 24) { const int c = F.bx; const int lo = tab[64 + c] + tab[128 + c], hi = tab[64 + c + 1]; for (int r = lo + F.tid; r < hi; r += 512) ptok[r] = -1; }
    for (int t = F.gw; t < T; t += F.ngw) {
        const int cls = tokc[t]; const int pos = tab[64 + cls] + tab[100 + cls] + toks[t];
#pragma unroll
        for (int j = 0; j < 4; ++j) xp[(size_t)pos * 256 + j * 64 + F.lane] = hb[(size_t)t * 256 + j * 64 + F.lane];
        if (F.lane == 0) { ptok[pos] = t; pw[2 * pos] = tokw[2 * t]; pw[2 * pos + 1] = tokw[2 * t + 1]; toks[t] = pos; }
    }
}

constexpr int NPH_LAYER = 9, NPH = 1 + DEPTH * NPH_LAYER;
__global__ void __launch_bounds__(512, 2) fwd(Args args) {
    extern __shared__ __attribute__((aligned(16))) unsigned char lds[];
    const int wave0 = __builtin_amdgcn_readfirstlane(threadIdx.x >> 6);
#define MKFRAME(F) Frame F; { int w_ = wave0; asm volatile("" : "+s"(w_)); int l_; asm volatile("v_mbcnt_lo_u32_b32 %0, -1, 0\n\tv_mbcnt_hi_u32_b32 %0, -1, %0" : "=v"(l_)); int t_ = w_ * 64 + l_; F.lds = (LAS unsigned char*)lds; F.tid = t_; F.lane = t_ & 63; F.wave = __builtin_amdgcn_readfirstlane(t_ >> 6); \
    int g_ = gridDim.x, b_ = blockIdx.x; asm volatile("" : "+s"(g_), "+s"(b_)); F.G = g_; F.bx = b_; F.gw = b_ * 8 + F.wave; F.ngw = g_ * 8; F.ws = args.ws; }
    MKFRAME(F);
    for (int u = F.tid; u < (LDS_BYTES - LDSCTL_OFF) / 4; u += 512) ((LAS unsigned*)(F.lds + LDSCTL_OFF))[u] = 0u;
    __syncthreads();
    volatile LAS unsigned* MISC = (volatile LAS unsigned*)(F.lds + MISC_OFF);
    XcdBarrier bar; bar.bar = (unsigned*)(F.ws + WS_CTL) + CW_BAR; bar.x = xb_xcc_id(); bar.st = MISC + 8;
    const int lo = args.ph_lo, hi = args.ph_hi;
    if (hi - lo > 1 && F.tid == 0) (void)xb_add(&bar.bar[XB_XCNT(bar.x)], 1u);
#ifndef PH_MASK
#define PH_MASK 0x3ff
#endif
#define IN(k) (lo <= (k) && (k) < hi)
#define EN(b) ((PH_MASK >> (b)) & 1)
#define SEAM(k) do { if (IN((k) + 1)) { MKFRAME(Fb_); xcd_barrier(bar, Fb_.tid); } } while (0)
    PG8_LAS unsigned char* ring = (PG8_LAS unsigned char*)lds;

    if (EN(9) && IN(0)) { for (int rep_ = 0; rep_ < (PDBL == 9 ? 2 : 1); ++rep_) { MKFRAME(F0); phase_prologue(F0, args); } SEAM(0); }

    for (int L = 0; L < DEPTH; ++L) {
        const int p0 = 1 + L * NPH_LAYER;
        unsigned char* wl = args.ws + WS_W + (size_t)L * LW_STRIDE;
        if (EN(0) && IN(p0 + 0)) { for (int rep_ = 0; rep_ < (PDBL == 0 ? 2 : 1); ++rep_) {
            MKFRAME(F);
            pg8::SchedDense S; S.A = (const char*)(F.ws + WS_HB); S.Bt = (const char*)(wl + LW_IN); S.tA = (size_t)256 * D * 2; S.tB = (size_t)256 * D * 2; S.so.init(T, ZP, F.G, F.bx);
            EpiZ E{(bf16*)(F.ws + WS_Z), (const float*)(F.ws + WS_CS)};
            pg8::gemm_phase<EpiZ, pg8::SchedDense, true>(ring, F.tid, D, D, D / 64, D / 64, S, E); }
            SEAM(p0 + 0);
        }
        if (EN(1) && IN(p0 + 1)) { for (int rep_ = 0; rep_ < (PDBL == 1 ? 2 : 1); ++rep_) {
            { MKFRAME(F1); for (int u = F1.bx; u < 384; u += F1.G) { MKFRAME(Fu); fa::unit_dilated((LAS char*)Fu.lds, Fu.ws, Fu.wave, Fu.lane, u); } }
            { MKFRAME(F1); phase_kmean(F1); } { MKFRAME(F1); for (int u = (F1.bx + F1.G - 128) % F1.G; u < 96; u += F1.G) unit_compress(F1, args, L, u); } }
            SEAM(p0 + 1); }
        if (EN(2) && IN(p0 + 2)) { for (int rep_ = 0; rep_ < (PDBL == 2 ? 2 : 1); ++rep_) {
            { MKFRAME(F2); unsigned* qh = (unsigned*)(F2.ws + WS_CTL) + CW_Q + (L * 2 + rep_) * 64; volatile LAS int* qw = (volatile LAS int*)(F2.lds + MISC_OFF + 64);
              for (;;) { const int k = dequeue(qh, qw, F2.tid); if (k >= 640) break; const int uid = P2_ORDER[k];
                  if (uid < 384) { MKFRAME(Fu); fa::unit_nsa((LAS char*)Fu.lds, Fu.ws, Fu.wave, Fu.lane, uid); } else { MKFRAME(Fu); fa::unit_moba((LAS char*)Fu.lds, Fu.ws, Fu.wave, Fu.lane, uid - 384); } } }
            { MKFRAME(F2); dil_combine(F2); } }
            SEAM(p0 + 2); }
        if (EN(3) && IN(p0 + 3)) { for (int rep_ = 0; rep_ < (PDBL == 3 ? 2 : 1); ++rep_) {
            MKFRAME(F);
            pg8::SchedDense S; S.A = (const char*)(F.ws + WS_MIX); S.Bt = (const char*)(wl + LW_OUT); S.tA = (size_t)256 * MIXW * 2; S.tB = (size_t)256 * MIXW * 2; S.so.init(T, D, F.G, F.bx);
            EpiRes E{(const bf16*)(F.ws + WS_HB), (float*)(F.ws + WS_Y)};
            pg8::gemm_phase<EpiRes, pg8::SchedDense, false>(ring, F.tid, MIXW, MIXW, MIXW / 64, MIXW / 64, S, E); }
            SEAM(p0 + 3);
        }
        if (EN(4) && IN(p0 + 4)) { MKFRAME(F4); phase_ln1_router(F4, args, L); SEAM(p0 + 4); }
        if (EN(5) && IN(p0 + 5)) { for (int rep_ = 0; rep_ < (PDBL == 5 ? 2 : 1); ++rep_) {
            { MKFRAME(F5); build_tiles(F5, L); phase_gather(F5, L); } __syncthreads();
            { MKFRAME(F); pg8::SchedDense S; S.A = (const char*)(F.ws + WS_PB) + (size_t)L * T * PLE * 2; S.Bt = (const char*)(wl + LW_PP); S.tA = (size_t)256 * PLE * 2; S.tB = (size_t)256 * PLE * 2; S.so.init(T, D, F.G, F.bx);
              EpiF32 E{(float*)(F.ws + WS_PPLE)};
              pg8::gemm_phase<EpiF32, pg8::SchedDense, false>(ring, F.tid, PLE, PLE, PLE / 64, PLE / 64, S, E); }
            { MKFRAME(F); pg8::SchedDense S; S.A = (const char*)(F.ws + WS_HB); S.Bt = (const char*)(wl + LW_PG); S.tA = (size_t)256 * D * 2; S.tB = (size_t)256 * D * 2; S.so.init(T, D, F.G, F.bx);
              EpiPle E{(const bf16*)(F.ws + WS_HB), (const float*)(F.ws + WS_PPLE), args.in[I_PGB] + (size_t)L * D, (float*)(F.ws + WS_Y)};
              pg8::gemm_phase<EpiPle, pg8::SchedDense, false>(ring, F.tid, D, D, D / 64, D / 64, S, E); } }
            SEAM(p0 + 5);
        }
        if (EN(6) && IN(p0 + 6)) { for (int rep_ = 0; rep_ < (PDBL == 6 ? 2 : 1); ++rep_) {
            MKFRAME(F); build_tiles(F, L);
            const volatile LAS int* tab = (const volatile LAS int*)(F.lds + TILE_OFF);
            SchedGU S{(const char*)(F.ws + WS_XP), (const char*)(wl + LW_GU), tab, F.G, F.bx, __builtin_amdgcn_readfirstlane(tab[96])};
            EpiGU E{(bf16*)(F.ws + WS_HID), (const float*)(F.ws + WS_PW)};
            pg8::gemm_phase<EpiGU, SchedGU, true>(ring, F.tid, D, D, D / 64, D / 64, S, E); }
            SEAM(p0 + 6);
        }
        if (EN(7) && IN(p0 + 7)) {
            MKFRAME(F); build_tiles(F, L);
            const volatile LAS int* tab = (const volatile LAS int*)(F.lds + TILE_OFF);
            SchedDown S{(const char*)(F.ws + WS_HID), (const char*)(wl + LW_D), tab, F.G, F.bx, __builtin_amdgcn_readfirstlane(tab[96])};
            EpiDown E{(bf16*)(F.ws + WS_XP)};
            pg8::gemm_phase<EpiDown, SchedDown, false>(ring, F.tid, 1024, EH, 16, 8, S, E);
            SEAM(p0 + 7);
        }
        if (EN(8) && IN(p0 + 8)) { for (int rep_ = 0; rep_ < (PDBL == 8 ? 2 : 1); ++rep_) {
            const bool lastL = (L == DEPTH - 1); MKFRAME(F);
            for (int m = F.gw; m < T; m += F.ngw) { f32x4 o[8];
                ln_row((const float*)(F.ws + WS_Y) + (size_t)m * D, (const bf16*)(F.ws + WS_XP) + (size_t)((const int*)(F.ws + WS_TOKS))[m] * D, args.in[I_LN2G] + (size_t)L * D, args.in[I_LN2B] + (size_t)L * D,
                       lastL ? args.out + (size_t)m * D : (float*)nullptr, lastL ? (bf16*)nullptr : (bf16*)(F.ws + WS_HB) + (size_t)m * D, F.lane, o); } }
            SEAM(p0 + 8);
        }
    }
#undef IN
#undef SEAM
}

extern "C" void kernel_launch(void* const* d_in, const int* in_sizes, int n_in, void* d_out, int out_size, void* d_ws, size_t ws_size, hipStream_t stream) {
    static int grid = 0;
    if (grid == 0) {
        if (n_in != 25 || ws_size < WS_END) { fprintf(stderr, "kernel_launch: unexpected n_in %d / ws %zu\n", n_in, ws_size); grid = -1; return; }
        int dev = 0, cus = 0;
        if (hipGetDevice(&dev) != hipSuccess || hipDeviceGetAttribute(&cus, hipDeviceAttributeMultiprocessorCount, dev) != hipSuccess) { grid = -1; return; }
        if (hipFuncSetAttribute((const void*)fwd, hipFuncAttributeMaxDynamicSharedMemorySize, LDS_BYTES) != hipSuccess) { fprintf(stderr, "kernel_launch: hipFuncSetAttribute failed\n"); grid = -1; return; }
        int per_cu = 0; (void)hipOccupancyMaxActiveBlocksPerMultiprocessor(&per_cu, (const void*)fwd, 512, LDS_BYTES); (void)hipGetLastError();
        grid = cus;
    }
    if (grid < 0) return;
    (void)hipMemsetAsync((char*)d_ws + WS_CTL, 0, CTL_ZERO_BYTES, stream);
    Args a{};
    for (int i = 0; i < 25; ++i) a.in[i] = (const float*)d_in[i];
    a.out = (float*)d_out; a.ws = (unsigned char*)d_ws;
#if MK_SINGLE
    a.ph_lo = 0; a.ph_hi = NPH;
    hipLaunchKernelGGL(fwd, dim3(grid), dim3(512), LDS_BYTES, stream, a);
#else
    for (int p = 0; p < NPH; ++p) { a.ph_lo = p; a.ph_hi = p + 1; const int reps = ((p == 0 && HOSTDBL == 9) || (p > 0 && (p - 1) % NPH_LAYER == HOSTDBL)) ? 2 : 1;
        for (int r = 0; r < reps; ++r) hipLaunchKernelGGL(fwd, dim3(grid), dim3(512), LDS_BYTES, stream, a); }
#endif
}
```

```cpp
#include <hip/hip_runtime.h>
#include <cstdio>
#include <cstdint>

#ifndef PDBL
#define PDBL -1
#endif
#ifndef HOSTDBL
#define HOSTDBL -2
#endif
#ifndef MK_SINGLE
#define MK_SINGLE 1
#endif

namespace pg8 {
#define PG8_LAS __attribute__((address_space(3)))
typedef unsigned short bf16_t;
typedef short bf16x8 __attribute__((ext_vector_type(8)));
typedef float f32x4 __attribute__((ext_vector_type(4)));
typedef unsigned u32x4 __attribute__((ext_vector_type(4)));
constexpr int BM = 256, BK = 64, HALF = 128, HTB = HALF * BK * 2, STAGE_BYTES = 8 * HTB, NXCD = 8, WGM = 8;

__host__ __device__ __forceinline__ int lds_byte(int r, int c) { const int st = (r >> 4) * 2 + (c >> 5), rr = r & 15, cc = c & 31, ob = rr * 64 + cc * 2; return st * 1024 + (ob ^ (((ob >> 9) & 1) << 5)); }
__host__ __device__ __forceinline__ void stage_rc(int b, int& R, int& C) { const int st = b / 1024, sb = b % 1024, swz = sb ^ (((sb >> 9) & 1) << 5); R = (st >> 1) * 16 + swz / 64; C = (st & 1) * 32 + (swz % 64) / 2; }
__host__ __device__ __forceinline__ int perm32(int rho) { const int n = rho >> 4, i = rho & 15; return 8 * (i >> 2) + 4 * n + (i & 3); }

struct Unit { const char* A; const char* B; const char* B2; int pm, pn, aux; };

struct StaticOrder {
    int nM, nN, nwg, G, c;
    __device__ void init(int M, int N, int G_, int c_) { nM = M / BM; nN = N / BM; nwg = nM * nN; G = G_; c = c_; }
    __device__ bool next(int i, int& pm, int& pn) const {
        const long L = (long)i * G + c; if (L >= nwg) return false;
        int wgid = (int)L; { const int q = nwg / NXCD, r = nwg % NXCD, xcd = wgid % NXCD, off = wgid / NXCD; wgid = (xcd < r ? xcd * (q + 1) : r * (q + 1) + (xcd - r) * q) + off; }
        const int nig = WGM * nN, gid = wgid / nig, fm = gid * WGM, gsz = (nM - fm) < WGM ? (nM - fm) : WGM;
        pm = fm + ((wgid % nig) % gsz); pn = (wgid % nig) / gsz; return true;
    }
};
struct SchedDense {
    const char* A; const char* Bt; size_t tA, tB; StaticOrder so;
    __device__ __forceinline__ bool next(int i, Unit& u) const { int pm, pn; if (!so.next(i, pm, pn)) return false; u.pm = pm; u.pn = pn; u.aux = 0; u.A = A + (size_t)pm * tA; u.B = Bt + (size_t)pn * tB; u.B2 = u.B; return true; }
};

__device__ __forceinline__ unsigned cvt_pk_bf16(float lo, float hi) { unsigned r; asm volatile("v_cvt_pk_bf16_f32 %0, %1, %2" : "=v"(r) : "v"(lo), "v"(hi)); return r; }

template <class Epi, class Sched, bool ALIGN_EPI>
__device__ __forceinline__ void gemm_phase(PG8_LAS unsigned char* lds, const int tid_in, const int lda, const int ldb, const int nt, const int ksplit, const Sched& S, const Epi& E) {
    int tid_ = tid_in; asm volatile("" : "+v"(tid_));
    const int tid = tid_, wid = __builtin_amdgcn_readfirstlane(tid >> 6), lane = tid & 63, wr = wid >> 2, wc = wid & 3, fr = lane & 15, fq = lane >> 4;
    unsigned voffA[2], voffB[2];
#pragma unroll
    for (int i = 0; i < 2; ++i) { int R, C; stage_rc(tid * 16 + i * 8192, R, C); const int Rb = Epi::PERM ? ((R & ~31) + perm32(R & 31)) : R;
        voffA[i] = (unsigned)(R * lda + C) * 2u; voffB[i] = (unsigned)(Rb * ldb + C) * 2u; }
    const size_t kstep = (size_t)(BK * 2);
    const size_t hA = (size_t)HALF * lda * 2, hB = (size_t)HALF * ldb * 2;
    const unsigned ldsw = (unsigned)wid * 1024u;
    const int aoff = lds_byte(wr * 64 + fr, fq * 8), boff = lds_byte(wc * 32 + fr, fq * 8);
#define PG8_SA(b, h) (((b) * 2 + (h)) * HTB)
#define PG8_SB(b, h) ((4 + (b) * 2 + (h)) * HTB)
#define PG8_STAGE(bufoff, gbase, voff) do { _Pragma("unroll") for (int _i = 0; _i < 2; ++_i) \
        __builtin_amdgcn_global_load_lds((const unsigned*)((const char*)(gbase) + (voff)[_i]), (PG8_LAS unsigned*)(lds + (bufoff) + ldsw + _i * 8192), 16, 0, 0); } while (0)
#define PG8_LDA(dst, b, h) do { _Pragma("unroll") for (int m = 0; m < 4; ++m) _Pragma("unroll") for (int k = 0; k < 2; ++k) dst[m][k] = *(const PG8_LAS bf16x8*)(lds + PG8_SA(b, h) + aoff + m * 2048 + k * 1024); } while (0)
#define PG8_LDB(dst, b, h) do { _Pragma("unroll") for (int n = 0; n < 2; ++n) _Pragma("unroll") for (int k = 0; k < 2; ++k) dst[n][k] = *(const PG8_LAS bf16x8*)(lds + PG8_SB(b, h) + boff + n * 2048 + k * 1024); } while (0)
#define PG8_MMA(ai, bj, At, Bt) do { __builtin_amdgcn_s_setprio(1); _Pragma("unroll") for (int m = 0; m < 4; ++m) _Pragma("unroll") for (int n = 0; n < 2; ++n) _Pragma("unroll") for (int k = 0; k < 2; ++k) \
        acc[ai][bj][m][n] = __builtin_amdgcn_mfma_f32_16x16x32_bf16(Bt[n][k], At[m][k], acc[ai][bj][m][n], 0, 0, 0); __builtin_amdgcn_s_setprio(0); } while (0)
#define PG8_WAIT_V(n) asm volatile("s_waitcnt vmcnt(" #n ")" ::: "memory")
#define PG8_WAIT_L(n) asm volatile("s_waitcnt lgkmcnt(" #n ")" ::: "memory")
#define PG8_BAR __builtin_amdgcn_s_barrier()
#define PG8_SCHED __builtin_amdgcn_sched_barrier(0)
    Unit cur, nxt; int ui = 0;
    if (!S.next(0, cur)) return;
    f32x4 acc[2][2][4][2];
#pragma unroll
    for (int a = 0; a < 2; ++a)
#pragma unroll
        for (int b = 0; b < 2; ++b)
#pragma unroll
            for (int m = 0; m < 4; ++m)
#pragma unroll
                for (int n = 0; n < 2; ++n) acc[a][b][m][n] = (f32x4){0.f, 0.f, 0.f, 0.f};
    bf16x8 At[4][2], B0[2][2], B1[2][2];
    const char* cA = cur.A; const char* cB = cur.B; const char* cB2 = cur.B2;
    PG8_STAGE(PG8_SB(0, 0), cB, voffB); PG8_STAGE(PG8_SB(0, 1), cB + hB, voffB); PG8_STAGE(PG8_SA(0, 0), cA, voffA); PG8_STAGE(PG8_SA(0, 1), cA + hA, voffA);
    if (wr == 1) PG8_BAR;
    PG8_WAIT_V(2); PG8_BAR;
    PG8_STAGE(PG8_SB(1, 0), cB + kstep, voffB); PG8_STAGE(PG8_SA(1, 0), cA + kstep, voffA); PG8_STAGE(PG8_SB(1, 1), cB + hB + kstep, voffB);
    PG8_WAIT_V(6); PG8_BAR;
    for (;;) {
        const bool has_next = S.next(ui + 1, nxt);
        const char* nA = has_next ? nxt.A : cA; const char* nB = has_next ? nxt.B : cB;
        for (int t = 0; t < nt; t += 2) {
            const bool last = (t == nt - 2);
            const int t2 = t + 2;
            const char* a1 = cA + (size_t)(t + 1) * kstep;
            const char* a2 = last ? nA : cA + (size_t)t2 * kstep;
            const char* b2 = last ? nB : (t2 < ksplit ? cB + (size_t)t2 * kstep : cB2 + (size_t)(t2 - ksplit) * kstep);
            const char* a3 = a2 + kstep; const char* b3 = b2 + kstep;
            PG8_LDB(B0, 0, 0); PG8_LDB(B1, 0, 1); PG8_SCHED; PG8_LDA(At, 0, 0); PG8_STAGE(PG8_SA(1, 1), a1 + hA, voffA);
            PG8_WAIT_V(8); PG8_WAIT_L(0); PG8_BAR; PG8_MMA(0, 0, At, B0); PG8_MMA(0, 1, At, B1); PG8_BAR; PG8_SCHED;
            PG8_LDA(At, 0, 1); PG8_STAGE(PG8_SB(0, 0), b2, voffB); PG8_STAGE(PG8_SB(0, 1), b2 + hB, voffB); PG8_STAGE(PG8_SA(0, 0), a2, voffA);
            PG8_WAIT_V(8); PG8_WAIT_L(0); PG8_BAR; PG8_MMA(1, 0, At, B0); PG8_MMA(1, 1, At, B1); PG8_BAR; PG8_SCHED;
            PG8_LDB(B0, 1, 0); PG8_LDB(B1, 1, 1); PG8_SCHED; PG8_LDA(At, 1, 0); PG8_STAGE(PG8_SA(0, 1), a2 + hA, voffA);
            PG8_WAIT_V(8); PG8_WAIT_L(0); PG8_BAR; PG8_MMA(0, 0, At, B0); PG8_MMA(0, 1, At, B1); PG8_BAR; PG8_SCHED;
            PG8_LDA(At, 1, 1); PG8_STAGE(PG8_SB(1, 0), b3, voffB); PG8_STAGE(PG8_SB(1, 1), b3 + hB, voffB); PG8_STAGE(PG8_SA(1, 0), a3, voffA);
            PG8_WAIT_V(8); PG8_WAIT_L(0); PG8_BAR; PG8_MMA(1, 0, At, B0); PG8_MMA(1, 1, At, B1); PG8_BAR; PG8_SCHED;
        }
        if constexpr (ALIGN_EPI) { if (wr == 0) PG8_BAR; }
        E(acc, cur, wr, wc, fr, fq);
        if (!has_next) break;
#pragma unroll
        for (int a = 0; a < 2; ++a)
#pragma unroll
            for (int b = 0; b < 2; ++b)
#pragma unroll
                for (int m = 0; m < 4; ++m)
#pragma unroll
                    for (int n = 0; n < 2; ++n) acc[a][b][m][n] = (f32x4){0.f, 0.f, 0.f, 0.f};
        cur = nxt; cA = nA; cB = nB; cB2 = nxt.B2; ++ui;
        if constexpr (ALIGN_EPI) { if (wr == 1) PG8_BAR; }
    }
    PG8_WAIT_V(0);
    if constexpr (!ALIGN_EPI) { if (wr == 0) PG8_BAR; }
    PG8_BAR;
#undef PG8_SA
#undef PG8_SB
#undef PG8_STAGE
#undef PG8_LDA
#undef PG8_LDB
#undef PG8_MMA
#undef PG8_WAIT_V
#undef PG8_WAIT_L
#undef PG8_BAR
#undef PG8_SCHED
}
}

constexpr int BATCH = 2, SEQ = 4096, T = BATCH * SEQ, D = 2048, DEPTH = 4;
constexpr int ZP = 5888;
constexpr int MIXW = 1536;
constexpr int NEXP = 16, EH = 512, PLE = 256;
constexpr float LN_EPS = 1e-5f;
constexpr float ALPHA = 1.681792830507429f;
constexpr float SC2 = 0.125f * 1.4426950408889634f;
constexpr int QA = 0, KA = 512, VA = 1024, QB = 1536, KBC = 2304, VBC = 2496, KBS = 2688, VBS = 2880, KBW = 3072, VBW = 3264, QC = 3456, KC = 4224, VC = 4992, GB = 5760;
constexpr int MAXTILES = 56, TPAD = MAXTILES * 256;

constexpr size_t MiB = 1u << 20;
constexpr size_t WS_CTL = 0, CTL_ZERO_BYTES = 1 * MiB;
constexpr size_t WS_CS = 1 * MiB;
constexpr size_t WS_KMEAN = 2 * MiB;
constexpr size_t WS_KCMP = 3 * MiB;
constexpr size_t WS_VCMP = 4 * MiB;
constexpr size_t WS_TOKC = 5 * MiB;
constexpr size_t WS_TOKS = 5 * MiB + 64 * 1024;
constexpr size_t WS_TOKW = 5 * MiB + 128 * 1024;
constexpr size_t WS_CNTB = 5 * MiB + 256 * 1024;
constexpr size_t WS_PTOK = 6 * MiB;
constexpr size_t WS_PW = 6 * MiB + 128 * 1024;
constexpr size_t WS_W = 16 * MiB;
constexpr size_t LW_IN = 0, LW_OUT = LW_IN + (size_t)ZP * D * 2, LW_GU = LW_OUT + (size_t)D * MIXW * 2, LW_D = LW_GU + (size_t)NEXP * 1024 * D * 2,
                 LW_PG = LW_D + (size_t)NEXP * D * EH * 2, LW_PP = LW_PG + (size_t)D * D * 2, LW_C1 = LW_PP + (size_t)D * PLE * 2, LW_END = LW_C1 + (size_t)2 * 128 * 2048 * 2;
constexpr size_t LW_STRIDE = 136 * MiB;
static_assert(LW_END <= LW_STRIDE, "layer weights");
constexpr size_t WS_H32 = 560 * MiB, WS_HB = 624 * MiB, WS_Z = 656 * MiB, WS_Y = 748 * MiB, WS_MIX = 812 * MiB, WS_XP = 836 * MiB, WS_HID = 892 * MiB,
                 WS_PPLE = 920 * MiB, WS_PB = 984 * MiB, WS_END = 1000 * MiB;
static_assert(WS_W + 4 * LW_STRIDE <= WS_H32 && WS_Z + (size_t)T * ZP * 2 <= WS_Y && WS_XP + (size_t)TPAD * D * 2 <= WS_HID && WS_HID + (size_t)TPAD * 1024 * 2 <= WS_PPLE, "ws map");
constexpr int CW_BAR = 4096;
constexpr int CW_CNT = 16384;
constexpr int CW_Q = 20480;
constexpr size_t WS_DILO = WS_PPLE, WS_DILL = WS_PPLE + 32 * MiB;

constexpr int RING_BYTES = 131072, LDSCTL_OFF = RING_BYTES, MISC_OFF = LDSCTL_OFF + 320, TILE_OFF = LDSCTL_OFF + 1024;
constexpr int LDS_BYTES = 147456;

#define GAS __attribute__((address_space(1)))
#define LAS __attribute__((address_space(3)))
typedef unsigned short bf16;
typedef unsigned v4u __attribute__((ext_vector_type(4)));
typedef float f32x4 __attribute__((ext_vector_type(4)));
#define LDS_WAIT() asm volatile("s_waitcnt lgkmcnt(0)" ::: "memory")
__device__ __forceinline__ unsigned f2bf(float f) { unsigned u = __builtin_bit_cast(unsigned, f); return (u + 0x7fffu + ((u >> 16) & 1u)) >> 16; }
__device__ __forceinline__ unsigned pk2(float lo, float hi) { return f2bf(lo) | (f2bf(hi) << 16); }
__device__ __forceinline__ float bf_lo(unsigned u) { return __builtin_bit_cast(float, u << 16); }
__device__ __forceinline__ float bf_hi(unsigned u) { return __builtin_bit_cast(float, u & 0xffff0000u); }
__device__ __forceinline__ float bf1(bf16 u) { return __builtin_bit_cast(float, ((unsigned)u) << 16); }
__device__ __forceinline__ float ex2(float x) { return __builtin_amdgcn_exp2f(x); }

#define XB_TMO      128
#define XB_XCNT(j)  (256  + 64 * (j))
#define XB_XSUB(j)  (1280 + 64 * (j))
#define XB_XGEN(j)  (2304 + 64 * (j))
#define XB_TOP      3328
#define XB_TOPGEN   3392
#define XCD_BAR_WORDS 3456
#define XB_SPIN_CAP (1u << 18)
__device__ __forceinline__ unsigned xb_ld(unsigned* p)              { return __hip_atomic_load(p, __ATOMIC_RELAXED, __HIP_MEMORY_SCOPE_AGENT); }
__device__ __forceinline__ unsigned xb_add(unsigned* p, unsigned v) { return __hip_atomic_fetch_add(p, v, __ATOMIC_RELAXED, __HIP_MEMORY_SCOPE_AGENT); }
__device__ __forceinline__ unsigned xb_xcc_id() { return (unsigned)__builtin_amdgcn_s_getreg((3 << 11) | 20) & 0xFu; }
#define XB_SPIN(cond, bar) do { unsigned _sp = 0; while (cond) { __builtin_amdgcn_s_sleep(1); \
    if ((++_sp & 255u) == 0u) { if (xb_ld(&(bar)[XB_TMO])) break; if (_sp > XB_SPIN_CAP) { atomicAdd(&(bar)[XB_TMO], 1u); break; } } } } while (0)
struct XcdBarrier { unsigned* bar; unsigned x; volatile LAS unsigned* st; };
__device__ __forceinline__ XcdBarrier xcd_barrier_post(unsigned* bar, volatile LAS unsigned* st) {
    XcdBarrier b; b.bar = bar; b.x = xb_xcc_id(); b.st = st;
    if (threadIdx.x == 0) (void)xb_add(&bar[XB_XCNT(b.x)], 1u);
    return b;
}
__device__ __forceinline__ void xcd_barrier_complete(unsigned* bar, unsigned x, unsigned& nloc, unsigned& nx) {
    const unsigned G = gridDim.x * gridDim.y * gridDim.z;
    unsigned sum, cnt, mine, sp = 0u;
    for (;;) {
        sum = 0u; cnt = 0u; mine = 0u;
#pragma unroll
        for (unsigned j = 0; j < 16; ++j) { const unsigned c = xb_ld(&bar[XB_XCNT(j)]); sum += c; cnt += (c > 0u) ? 1u : 0u; mine = (j == x) ? c : mine; }
        if (sum == G) break;
        __builtin_amdgcn_s_sleep(1);
        if ((++sp & 255u) == 0u) { if (xb_ld(&bar[XB_TMO])) break; if (sp > XB_SPIN_CAP) { atomicAdd(&bar[XB_TMO], 1u); break; } }
    }
    nloc = mine > 0u ? mine : 1u; nx = cnt > 0u ? cnt : 1u;
}
__device__ __forceinline__ void xcd_barrier(const XcdBarrier& b, const int tid) {
    asm volatile("s_waitcnt vmcnt(0)" ::: "memory");
    __syncthreads();
    if (tid == 0) {
        unsigned* bar = b.bar;
        __builtin_amdgcn_s_waitcnt(0);
        unsigned nloc = b.st[0], nx = b.st[1];
        if (nloc == 0u) { xcd_barrier_complete(bar, b.x, nloc, nx); b.st[0] = nloc; b.st[1] = nx; }
        const unsigned old = xb_add(&bar[XB_XSUB(b.x)], 1u);
        const unsigned gen = old / nloc;
        if (old + 1u == (gen + 1u) * nloc) {
            __builtin_amdgcn_fence(__ATOMIC_RELEASE, "agent");
            asm volatile("s_waitcnt vmcnt(0)" ::: "memory");
            const unsigned og = xb_add(&bar[XB_TOP], 1u);
            const unsigned tg = og / nx;
            if (og + 1u == (tg + 1u) * nx) xb_add(&bar[XB_TOPGEN], 1u);
            else XB_SPIN(xb_ld(&bar[XB_TOPGEN]) == tg, bar);
            __builtin_amdgcn_fence(__ATOMIC_ACQUIRE, "agent");
            xb_add(&bar[XB_XGEN(b.x)], 1u);
            asm volatile("s_waitcnt vmcnt(0)" ::: "memory");
        } else {
            XB_SPIN(xb_ld(&bar[XB_XGEN(b.x)]) == gen, bar);
            __builtin_amdgcn_fence(__ATOMIC_ACQUIRE, "agent");
            asm volatile("s_waitcnt vmcnt(0)" ::: "memory");
        }
    }
    __syncthreads();
}

struct Args { const float* in[25]; float* out; unsigned char* ws; int ph_lo, ph_hi; };
enum { I_X = 0, I_P, I_POS, I_LNG, I_LNB, I_WIN, I_WOUT, I_CK1, I_CK2, I_PEK, I_CV1, I_CV2, I_PEV, I_LN1G, I_LN1B, I_RW, I_RB, I_WG, I_WU, I_WD, I_PP, I_PGW, I_PGB, I_LN2G, I_LN2B };

struct Frame {
    LAS unsigned char* lds;
    int tid, lane, wave, G, bx, gw, ngw;
    unsigned char* ws;
};

__device__ __forceinline__ float wave_sum(float v) {
#pragma unroll
    for (int o = 1; o < 64; o <<= 1) v += __shfl_xor(v, o);
    return v;
}
__device__ __forceinline__ float wave_max(float v) {
#pragma unroll
    for (int o = 1; o < 64; o <<= 1) v = fmaxf(v, __shfl_xor(v, o));
    return v;
}
template <int OFF> __device__ __forceinline__ void rs_step(float (&v)[64], int lane) {
    const bool up = (lane & OFF) != 0;
#pragma unroll
    for (int i = 0; i < OFF; ++i) { const float send = up ? v[i] : v[i + OFF]; const float keep = up ? v[i + OFF] : v[i]; v[i] = keep + __shfl_xor(send, OFF); }
}
__device__ __forceinline__ void reduce_scatter64(float (&v)[64], int lane) { rs_step<32>(v, lane); rs_step<16>(v, lane); rs_step<8>(v, lane); rs_step<4>(v, lane); rs_step<2>(v, lane); rs_step<1>(v, lane); }

template <int MAP>
__device__ __forceinline__ int rowmap(int n) {
    if (MAP == 1) return n < 3456 ? n : (n < 3492 ? n - 3456 + GB : n - 36);
    if (MAP == 2) return ((n >> 7) << 8) + (n & 127);
    if (MAP == 3) return ((n >> 7) << 8) + 128 + (n & 127);
    return n;
}
template <int MAP>
__device__ __forceinline__ void transpose_item(const float* W, int K, int N, bf16* WT, LAS float* scr, int item, int lane) {
    const int nblk = (N + 31) / 32, kb = item / nblk, nb = item % nblk, k0 = 64 * kb, n0 = 32 * nb;
    const int nn = n0 + (lane & 31); const bool okn = nn < N;
#pragma unroll 8
    for (int i = 0; i < 32; ++i) { const int kk = 2 * i + (lane >> 5); scr[kk * 33 + (lane & 31)] = okn ? W[(size_t)(k0 + kk) * N + nn] : 0.f; }
    LDS_WAIT(); asm volatile("" ::: "memory");
    const int c = lane & 7;
#pragma unroll
    for (int j = 0; j < 4; ++j) { const int n = (lane >> 3) + 8 * j; const LAS float* s = scr + (8 * c) * 33 + n;
        v4u o; o.x = pk2(s[0 * 33], s[1 * 33]); o.y = pk2(s[2 * 33], s[3 * 33]); o.z = pk2(s[4 * 33], s[5 * 33]); o.w = pk2(s[6 * 33], s[7 * 33]);
        if (n0 + n < N) *(v4u*)(WT + (size_t)rowmap<MAP>(n0 + n) * K + k0 + 8 * c) = o; }
    LDS_WAIT(); asm volatile("" ::: "memory");
}

__device__ __forceinline__ void ln_row(const float* src, const bf16* addb, const float* g, const float* b, float* dst32, bf16* dstb, int lane, f32x4 (&o)[8]) {
    const f32x4* xr = (const f32x4*)src + lane;
    f32x4 v[8]; float s = 0.f;
#pragma unroll
    for (int j = 0; j < 8; ++j) { v[j] = xr[64 * j];
        if (addb) { const unsigned long long u = ((const unsigned long long*)addb)[64 * j + lane]; v[j].x += bf_lo((unsigned)u); v[j].y += bf_hi((unsigned)u); v[j].z += bf_lo((unsigned)(u >> 32)); v[j].w += bf_hi((unsigned)(u >> 32)); }
        s += (v[j].x + v[j].y) + (v[j].z + v[j].w); }
    const float mean = wave_sum(s) * (1.f / D); float s2 = 0.f;
#pragma unroll
    for (int j = 0; j < 8; ++j) { v[j] = v[j] - mean; s2 += (v[j].x * v[j].x + v[j].y * v[j].y) + (v[j].z * v[j].z + v[j].w * v[j].w); }
    const float rstd = 1.f / sqrtf(wave_sum(s2) * (1.f / D) + LN_EPS);
#pragma unroll
    for (int j = 0; j < 8; ++j) { const f32x4 gg = ((const f32x4*)g)[64 * j + lane], bb = ((const f32x4*)b)[64 * j + lane]; o[j] = v[j] * rstd * gg + bb; }
    if (dst32) {
#pragma unroll
        for (int j = 0; j < 8; ++j) ((f32x4*)dst32)[64 * j + lane] = o[j];
    }
    if (dstb) {
#pragma unroll
        for (int j = 0; j < 8; ++j) ((unsigned long long*)dstb)[64 * j + lane] = (unsigned long long)pk2(o[j].x, o[j].y) | ((unsigned long long)pk2(o[j].z, o[j].w) << 32);
    }
}

__device__ __forceinline__ void phase_prologue(Frame& F, const Args& a) {
    LAS float* scr = (LAS float*)(F.lds + F.wave * 16384);
    constexpr int N_IN = 32 * 182, N_OUT = 24 * 64, N_G1 = 32 * 16, N_D1 = 8 * 64, N_PG = 32 * 64, N_PP = 4 * 64;
    constexpr int N_C1 = 32 * 4;
    constexpr int PER_LAYER = N_IN + N_OUT + 16 * N_G1 * 2 + 16 * N_D1 + N_PG + N_PP + 2 * N_C1;
    for (int it = F.gw; it < DEPTH * PER_LAYER; it += F.ngw) {
        const int L = it / PER_LAYER; int r = it % PER_LAYER;
        unsigned char* wl = F.ws + WS_W + (size_t)L * LW_STRIDE;
        if (r < N_IN) { transpose_item<1>(a.in[I_WIN] + (size_t)L * D * 5796, D, 5796, (bf16*)(wl + LW_IN), scr, r, F.lane); continue; } r -= N_IN;
        if (r < N_OUT) { transpose_item<0>(a.in[I_WOUT] + (size_t)L * MIXW * D, MIXW, D, (bf16*)(wl + LW_OUT), scr, r, F.lane); continue; } r -= N_OUT;
        if (r < 16 * N_G1) { const int e = r / N_G1; transpose_item<2>(a.in[I_WG] + ((size_t)L * NEXP + e) * D * EH, D, EH, (bf16*)(wl + LW_GU) + (size_t)e * 1024 * D, scr, r % N_G1, F.lane); continue; } r -= 16 * N_G1;
        if (r < 16 * N_G1) { const int e = r / N_G1; transpose_item<3>(a.in[I_WU] + ((size_t)L * NEXP + e) * D * EH, D, EH, (bf16*)(wl + LW_GU) + (size_t)e * 1024 * D, scr, r % N_G1, F.lane); continue; } r -= 16 * N_G1;
        if (r < 16 * N_D1) { const int e = r / N_D1; transpose_item<0>(a.in[I_WD] + ((size_t)L * NEXP + e) * EH * D, EH, D, (bf16*)(wl + LW_D) + (size_t)e * D * EH, scr, r % N_D1, F.lane); continue; } r -= 16 * N_D1;
        if (r < N_PG) { transpose_item<0>(a.in[I_PGW] + (size_t)L * D * D, D, D, (bf16*)(wl + LW_PG), scr, r, F.lane); continue; } r -= N_PG;
        if (r < N_PP) { transpose_item<0>(a.in[I_PP] + (size_t)L * PLE * D, PLE, D, (bf16*)(wl + LW_PP), scr, r, F.lane); continue; } r -= N_PP;
        if (r < N_C1) { transpose_item<0>(a.in[I_CK1] + (size_t)L * 2048 * 128, 2048, 128, (bf16*)(wl + LW_C1), scr, r, F.lane); continue; } r -= N_C1;
        transpose_item<0>(a.in[I_CV1] + (size_t)L * 2048 * 128, 2048, 128, (bf16*)(wl + LW_C1) + 128 * 2048, scr, r, F.lane);
    }
    for (int i = F.gw * 64 + F.lane; i < DEPTH * 92 * (D / 8); i += F.ngw * 64) {
        const int L = i / (92 * (D / 8)), r = i % (92 * (D / 8));
        ((v4u*)(F.ws + WS_W + (size_t)L * LW_STRIDE + LW_IN + (size_t)5796 * D * 2))[r] = (v4u){0u, 0u, 0u, 0u};
    }
    { const f32x4* p4 = (const f32x4*)a.in[I_P]; unsigned long long* pb = (unsigned long long*)(F.ws + WS_PB);
      for (size_t i = (size_t)F.gw * 64 + F.lane; i < (size_t)DEPTH * T * PLE / 4; i += (size_t)F.ngw * 64) { const f32x4 v = p4[i]; pb[i] = (unsigned long long)pk2(v.x, v.y) | ((unsigned long long)pk2(v.z, v.w) << 32); } }
    { float* cs = (float*)(F.ws + WS_CS); const int* pos = (const int*)a.in[I_POS];
      for (int i = F.gw * 64 + F.lane; i < T * 8; i += F.ngw * 64) { const int t = i >> 3, j = i & 7;
          const float inv = expf((float)j * -1.6402954339981079f);
          const float ang = (float)pos[t] * inv;
          const double rev = (double)ang * 0.15915494309189535; const float fr = (float)(rev - floor(rev));
          cs[t * 16 + j] = __builtin_amdgcn_cosf(fr); cs[t * 16 + 8 + j] = __builtin_amdgcn_sinf(fr); } }
    for (int m = F.gw; m < T; m += F.ngw) { f32x4 o[8]; ln_row(a.in[I_X] + (size_t)m * D, nullptr, a.in[I_LNG], a.in[I_LNB], (float*)nullptr, (bf16*)(F.ws + WS_HB) + (size_t)m * D, F.lane, o); }
}

__device__ __forceinline__ bool rope_head(int hd) {
    const unsigned long long lo = 0xFFFFull | (0x7FFFull << 24) | (0x7ull << 42) | (0x7ull << 48) | (0x3FFull << 54), hi = 0x3FFFull;
    return hd < 64 ? ((lo >> hd) & 1ull) != 0ull : ((hi >> (hd - 64)) & 1ull) != 0ull;
}
struct EpiZ {
    static constexpr bool PERM = true;
    bf16* Z; const float* cs;
    __device__ __forceinline__ void operator()(const f32x4 (&acc)[2][2][4][2], const pg8::Unit& u, int wr, int wc, int fr, int fq) const {
        const int row0 = u.pm * 256 + wr * 64 + fr;
#pragma unroll
        for (int bj = 0; bj < 2; ++bj) {
            const int cb = u.pn * 256 + bj * 128 + wc * 32;
            const bool rp = ((wc & 1) == 0) && rope_head(cb >> 6);
#pragma unroll
            for (int ai = 0; ai < 2; ++ai)
#pragma unroll
                for (int m = 0; m < 4; ++m) {
                    const int row = row0 + ai * 128 + m * 16;
                    f32x4 v0 = acc[ai][bj][m][0], v1 = acc[ai][bj][m][1];
                    if (rp) {
                        f32x4 o0, o1;
#pragma unroll
                        for (int i = 0; i < 4; ++i) { o0[i] = __shfl_xor(v0[i], 16); o1[i] = __shfl_xor(v1[i], 16); }
                        const f32x4 c0 = *(const f32x4*)(cs + (size_t)row * 16), c1 = *(const f32x4*)(cs + (size_t)row * 16 + 4), s0 = *(const f32x4*)(cs + (size_t)row * 16 + 8), s1 = *(const f32x4*)(cs + (size_t)row * 16 + 12);
                        if (fq == 0) { v0 = v0 * c0 - o0 * s0; v1 = v1 * c1 - o1 * s1; }
                        else if (fq == 1) { v0 = v0 * c0 + o0 * s0; v1 = v1 * c1 + o1 * s1; }
                    }
                    v4u w; w.x = pg8::cvt_pk_bf16(v0[0], v0[1]); w.y = pg8::cvt_pk_bf16(v0[2], v0[3]); w.z = pg8::cvt_pk_bf16(v1[0], v1[1]); w.w = pg8::cvt_pk_bf16(v1[2], v1[3]);
                    *(v4u*)(Z + (size_t)row * ZP + cb + 8 * fq) = w;
                }
        }
    }
};
struct EpiRes {
    static constexpr bool PERM = false;
    const bf16* h; float* y;
    __device__ __forceinline__ void operator()(const f32x4 (&acc)[2][2][4][2], const pg8::Unit& u, int wr, int wc, int fr, int fq) const {
        const int row0 = u.pm * 256 + wr * 64 + fr, col0 = u.pn * 256 + wc * 32 + 4 * fq;
#pragma unroll
        for (int ai = 0; ai < 2; ++ai)
#pragma unroll
            for (int m = 0; m < 4; ++m) { const size_t off = (size_t)(row0 + ai * 128 + m * 16) * D + col0;
#pragma unroll
                for (int bj = 0; bj < 2; ++bj)
#pragma unroll
                    for (int n = 0; n < 2; ++n) { const size_t o = off + bj * 128 + n * 16; const unsigned long long hv = *(const unsigned long long*)(h + o);
                        const f32x4 hf = {bf_lo((unsigned)hv), bf_hi((unsigned)hv), bf_lo((unsigned)(hv >> 32)), bf_hi((unsigned)(hv >> 32))}; *(f32x4*)(y + o) = hf * ALPHA + acc[ai][bj][m][n]; } }
    }
};
struct EpiF32 {
    static constexpr bool PERM = false;
    float* C;
    __device__ __forceinline__ void operator()(const f32x4 (&acc)[2][2][4][2], const pg8::Unit& u, int wr, int wc, int fr, int fq) const {
        const int row0 = u.pm * 256 + wr * 64 + fr, col0 = u.pn * 256 + wc * 32 + 4 * fq;
#pragma unroll
        for (int ai = 0; ai < 2; ++ai)
#pragma unroll
            for (int m = 0; m < 4; ++m) { const size_t off = (size_t)(row0 + ai * 128 + m * 16) * D + col0;
#pragma unroll
                for (int bj = 0; bj < 2; ++bj)
#pragma unroll
                    for (int n = 0; n < 2; ++n) *(f32x4*)(C + off + bj * 128 + n * 16) = acc[ai][bj][m][n]; }
    }
};
struct EpiPle {
    static constexpr bool PERM = false;
    const bf16* h; const float* P; const float* bias; float* y2;
    __device__ __forceinline__ void operator()(const f32x4 (&acc)[2][2][4][2], const pg8::Unit& u, int wr, int wc, int fr, int fq) const {
        const int row0 = u.pm * 256 + wr * 64 + fr, col0 = u.pn * 256 + wc * 32 + 4 * fq;
#pragma unroll
        for (int bj = 0; bj < 2; ++bj)
#pragma unroll
            for (int n = 0; n < 2; ++n) { const f32x4 bv = *(const f32x4*)(bias + col0 + bj * 128 + n * 16);
#pragma unroll
                for (int ai = 0; ai < 2; ++ai)
#pragma unroll
                    for (int m = 0; m < 4; ++m) { const size_t o = (size_t)(row0 + ai * 128 + m * 16) * D + col0 + bj * 128 + n * 16;
                        const f32x4 x = acc[ai][bj][m][n] + bv; f32x4 sg;
#pragma unroll
                        for (int i = 0; i < 4; ++i) sg[i] = __builtin_amdgcn_rcpf(1.f + __expf(-x[i]));
                        const unsigned long long hv = *(const unsigned long long*)(h + o); const f32x4 hf = {bf_lo((unsigned)hv), bf_hi((unsigned)hv), bf_lo((unsigned)(hv >> 32)), bf_hi((unsigned)(hv >> 32))};
                        *(f32x4*)(y2 + o) = hf * ALPHA + sg * *(const f32x4*)(P + o); } }
    }
};
struct EpiGU {
    static constexpr bool PERM = true;
    bf16* hid; const float* pw;
    __device__ __forceinline__ void operator()(const f32x4 (&acc)[2][2][4][2], const pg8::Unit& u, int wr, int wc, int fr, int fq) const {
        const int slot = u.aux, row0 = u.pm * 256 + wr * 64 + fr, cb = slot * 512 + u.pn * 128 + wc * 32 + 8 * fq;
#pragma unroll
        for (int ai = 0; ai < 2; ++ai)
#pragma unroll
            for (int m = 0; m < 4; ++m) { const int prow = row0 + ai * 128 + m * 16; const float w = pw[prow * 2 + slot];
                float r[8];
#pragma unroll
                for (int n = 0; n < 2; ++n)
#pragma unroll
                    for (int i = 0; i < 4; ++i) { const float g = acc[ai][0][m][n][i], up = acc[ai][1][m][n][i]; r[n * 4 + i] = g * __builtin_amdgcn_rcpf(1.f + __expf(-g)) * up * w; }
                v4u o; o.x = pg8::cvt_pk_bf16(r[0], r[1]); o.y = pg8::cvt_pk_bf16(r[2], r[3]); o.z = pg8::cvt_pk_bf16(r[4], r[5]); o.w = pg8::cvt_pk_bf16(r[6], r[7]);
                *(v4u*)(hid + (size_t)prow * 1024 + cb) = o; }
    }
};
struct EpiDown {
    static constexpr bool PERM = true;
    bf16* ffn;
    __device__ __forceinline__ void operator()(const f32x4 (&acc)[2][2][4][2], const pg8::Unit& u, int wr, int wc, int fr, int fq) const {
        const int row0 = u.pm * 256 + wr * 64 + fr, cb = u.pn * 256 + wc * 32 + 8 * fq;
#pragma unroll
        for (int ai = 0; ai < 2; ++ai)
#pragma unroll
            for (int m = 0; m < 4; ++m) { bf16* rowp = ffn + (size_t)(row0 + ai * 128 + m * 16) * D + cb;
#pragma unroll
                for (int bj = 0; bj < 2; ++bj) { const f32x4 v0 = acc[ai][bj][m][0], v1 = acc[ai][bj][m][1];
                    v4u w; w.x = pg8::cvt_pk_bf16(v0[0], v0[1]); w.y = pg8::cvt_pk_bf16(v0[2], v0[3]); w.z = pg8::cvt_pk_bf16(v1[0], v1[1]); w.w = pg8::cvt_pk_bf16(v1[2], v1[3]);
                    *(v4u*)(rowp + bj * 128) = w; } }
    }
};
struct SchedGU {
    const char* xp; const char* wgu; const volatile LAS int* tab; int G, c, ntiles;
    __device__ __forceinline__ bool next(int i, pg8::Unit& u) const {
        const int L = i * G + c; if (L >= ntiles * 8) return false;
        const int tile = L >> 3, pn = L & 7, cls = __builtin_amdgcn_readfirstlane(tab[tile]), g = cls / 6, pi = cls % 6;
        const int ea = 4 * g + (pi < 3 ? 0 : (pi < 5 ? 1 : 2)), eb = 4 * g + (pi == 0 ? 1 : ((pi == 1 || pi == 3) ? 2 : 3));
        const int slot = pn >> 2, j = pn & 3, e = slot ? eb : ea;
        u.pm = tile; u.pn = j; u.aux = slot; u.A = xp + (size_t)tile * 256 * D * 2; u.B = wgu + ((size_t)e * 1024 + (size_t)j * 256) * D * 2; u.B2 = u.B; return true;
    }
};
struct SchedDown {
    const char* hid; const char* wd; const volatile LAS int* tab; int G, c, ntiles;
    __device__ __forceinline__ bool next(int i, pg8::Unit& u) const {
        const int L = i * G + c; if (L >= ntiles * 8) return false;
        const int tile = L >> 3, pn = L & 7, cls = __builtin_amdgcn_readfirstlane(tab[tile]), g = cls / 6, pi = cls % 6;
        const int ea = 4 * g + (pi < 3 ? 0 : (pi < 5 ? 1 : 2)), eb = 4 * g + (pi == 0 ? 1 : ((pi == 1 || pi == 3) ? 2 : 3));
        u.pm = tile; u.pn = pn; u.aux = 0; u.A = hid + (size_t)tile * 256 * 1024 * 2;
        u.B = wd + ((size_t)ea * D + (size_t)pn * 256) * EH * 2; u.B2 = wd + ((size_t)eb * D + (size_t)pn * 256) * EH * 2; return true;
    }
};

__device__ __forceinline__ void load_row64(const bf16* p, float (&q)[64]) {
    const v4u* pp = (const v4u*)p;
#pragma unroll
    for (int c = 0; c < 8; ++c) { const v4u u = pp[c]; q[8 * c + 0] = bf_lo(u.x); q[8 * c + 1] = bf_hi(u.x); q[8 * c + 2] = bf_lo(u.y); q[8 * c + 3] = bf_hi(u.y);
        q[8 * c + 4] = bf_lo(u.z); q[8 * c + 5] = bf_hi(u.z); q[8 * c + 6] = bf_lo(u.w); q[8 * c + 7] = bf_hi(u.w); }
}
__device__ __forceinline__ float dot_row64(const float (&q)[64], const bf16* p) {
    const v4u* pp = (const v4u*)p; float s0 = 0.f, s1 = 0.f, s2 = 0.f, s3 = 0.f;
#pragma unroll
    for (int c = 0; c < 8; ++c) { const v4u u = pp[c];
        s0 += q[8 * c + 0] * bf_lo(u.x) + q[8 * c + 1] * bf_hi(u.x); s1 += q[8 * c + 2] * bf_lo(u.y) + q[8 * c + 3] * bf_hi(u.y);
        s2 += q[8 * c + 4] * bf_lo(u.z) + q[8 * c + 5] * bf_hi(u.z); s3 += q[8 * c + 6] * bf_lo(u.w) + q[8 * c + 7] * bf_hi(u.w); }
    return (s0 + s1) + (s2 + s3);
}
struct WAcc { float m, l; float a[64]; };
__device__ __forceinline__ void wacc_init(WAcc& A) { A.m = -1e30f; A.l = 0.f;
#pragma unroll
    for (int d = 0; d < 64; ++d) A.a[d] = 0.f; }
__device__ __forceinline__ void wacc_key(WAcc& A, float s2, const bf16* vrow) {
    const float mn = fmaxf(A.m, s2), f = ex2(A.m - mn), p = ex2(s2 - mn); A.m = mn; A.l = A.l * f + p;
    const v4u* pp = (const v4u*)vrow;
#pragma unroll
    for (int c = 0; c < 8; ++c) { const v4u u = pp[c];
        A.a[8 * c + 0] = A.a[8 * c + 0] * f + p * bf_lo(u.x); A.a[8 * c + 1] = A.a[8 * c + 1] * f + p * bf_hi(u.x);
        A.a[8 * c + 2] = A.a[8 * c + 2] * f + p * bf_lo(u.y); A.a[8 * c + 3] = A.a[8 * c + 3] * f + p * bf_hi(u.y);
        A.a[8 * c + 4] = A.a[8 * c + 4] * f + p * bf_lo(u.z); A.a[8 * c + 5] = A.a[8 * c + 5] * f + p * bf_hi(u.z);
        A.a[8 * c + 6] = A.a[8 * c + 6] * f + p * bf_lo(u.w); A.a[8 * c + 7] = A.a[8 * c + 7] * f + p * bf_hi(u.w); }
}
__device__ __forceinline__ float wacc_finish(WAcc& A, int lane, float& lse2) {
    const float M = wave_max(A.m), f = ex2(A.m - M), L = wave_sum(A.l * f);
#pragma unroll
    for (int d = 0; d < 64; ++d) A.a[d] *= f;
    reduce_scatter64(A.a, lane);
    lse2 = M + __log2f(L);
    return L > 0.f ? A.a[0] / L : 0.f;
}

__device__ __forceinline__ void phase_kmean(Frame& F) {
    const bf16* z = (const bf16*)(F.ws + WS_Z); float* km = (float*)(F.ws + WS_KMEAN); LAS float* red = (LAS float*)F.lds;
    for (int it = F.bx; it < 256; it += F.G) {
        const int b = it >> 7, h = (it >> 4) & 7, blk = it & 15, d = F.tid & 63, part = F.tid >> 6;
        const bf16* p = z + ((size_t)b * SEQ + blk * 256 + part * 32) * ZP + KA + h * 64 + d; float s = 0.f;
        bf16 kv_[32];
#pragma unroll
        for (int k = 0; k < 32; ++k) kv_[k] = p[(size_t)k * ZP];
#pragma unroll
        for (int k = 0; k < 32; ++k) s += bf1(kv_[k]);
        red[part * 64 + d] = s; __syncthreads();
        if (F.tid < 64) { float t = 0.f;
#pragma unroll
            for (int q = 0; q < 8; ++q) t += red[q * 64 + d];
            km[(size_t)it * 64 + d] = t * (1.f / 256.f); }
        __syncthreads();
    }
}
__device__ __forceinline__ float gelu_tanh(float x) { const float u = 0.7978845608028654f * (x + 0.044715f * x * x * x); const float e = __expf(2.f * u); const float th = 1.f - 2.f / (e + 1.f); return 0.5f * x * (1.f + th); }
__device__ __forceinline__ void unit_compress(Frame& F, const Args& a, int L, int uid) {
    typedef short bf16x8 __attribute__((ext_vector_type(8))); typedef float f32x16 __attribute__((ext_vector_type(16)));
    const int rb = uid & 7, bh = (uid >> 3) % 6, kv = uid / 48, b = bh / 3, hk = bh % 3, n0 = rb * 32;
    const int lane = F.lane, r32 = lane & 31, hi = lane >> 5, nt = F.wave & 3, kh = F.wave >> 2;
    const bf16* z = (const bf16*)(F.ws + WS_Z) + (size_t)b * SEQ * ZP + (kv ? VBC : KBC) + hk * 64;
    const bf16* w1t = (const bf16*)(F.ws + WS_W + (size_t)L * LW_STRIDE + LW_C1) + (size_t)kv * 128 * 2048;
    const float* pe = a.in[kv ? I_PEV : I_PEK] + (size_t)L * 2048; const float* W2 = a.in[kv ? I_CV2 : I_CK2] + (size_t)L * 128 * 64;
    LAS float* part = (LAS float*)F.lds;
    LAS float* w2s = (LAS float*)(F.lds + 32768);
    for (int i = F.tid; i < 2048; i += 512) ((LAS f32x4*)w2s)[i] = ((const f32x4*)W2)[i];
    const int n = (n0 + r32) < 255 ? (n0 + r32) : 254;
    const bf16* arow = z + (size_t)(16 * n) * ZP + hi * 8; const bf16* brow = w1t + (size_t)(nt * 32 + r32) * 2048 + hi * 8;
    f32x16 acc = f32x16{};
#pragma unroll 8
    for (int st = kh * 64; st < kh * 64 + 64; ++st) { const int j = st >> 2, d0 = st & 3;
        const v4u u = *(const v4u*)(arow + (size_t)j * ZP + d0 * 16); const f32x4 p0 = *(const f32x4*)(pe + j * 64 + d0 * 16 + hi * 8), p1 = *(const f32x4*)(pe + j * 64 + d0 * 16 + hi * 8 + 4);
        v4u av; av.x = pk2(bf_lo(u.x) + p0[0], bf_hi(u.x) + p0[1]); av.y = pk2(bf_lo(u.y) + p0[2], bf_hi(u.y) + p0[3]); av.z = pk2(bf_lo(u.z) + p1[0], bf_hi(u.z) + p1[1]); av.w = pk2(bf_lo(u.w) + p1[2], bf_hi(u.w) + p1[3]);
        const bf16x8 bv = *(const bf16x8*)(brow + st * 16);
        acc = __builtin_amdgcn_mfma_f32_32x32x16_bf16(__builtin_bit_cast(bf16x8, av), bv, acc, 0, 0, 0); }
#pragma unroll
    for (int r = 0; r < 16; ++r) part[(kh * 32 + (r & 3) + 8 * (r >> 2) + 4 * hi) * 128 + nt * 32 + r32] = acc[r];
    __syncthreads();
    for (int i = F.tid; i < 4096; i += 512) part[i] = gelu_tanh(part[i] + part[4096 + i]);
    __syncthreads();
    { const int row = F.tid >> 4, d4 = (F.tid & 15) * 4; f32x4 o = {0.f, 0.f, 0.f, 0.f};
#pragma unroll 8
      for (int c = 0; c < 128; ++c) { const float h = part[row * 128 + c]; const f32x4 w = *(const LAS f32x4*)(w2s + c * 64 + d4); o += w * h; }
      bf16* dst = (bf16*)(F.ws + (kv ? WS_VCMP : WS_KCMP)) + ((size_t)bh * 256 + n0 + row) * 64 + d4;
      if (n0 + row >= 255) o = (f32x4){0.f, 0.f, 0.f, 0.f};
      *(unsigned long long*)dst = (unsigned long long)pk2(o[0], o[1]) | ((unsigned long long)pk2(o[2], o[3]) << 32); }
    __syncthreads();
}
__device__ __forceinline__ void phase_dilated(Frame& F) {
    const bf16* z = (const bf16*)(F.ws + WS_Z); bf16* mix = (bf16*)(F.ws + WS_MIX); const int lane = F.lane;
    for (int it = F.gw; it < T * 4; it += F.ngw) {
        const int t = it >> 2, j = it & 3, b = t / SEQ, s = t % SEQ;
        float og[3], ls[3];
#pragma unroll
        for (int gi = 0; gi < 3; ++gi) {
            const int dil = gi == 0 ? 1 : (gi == 1 ? 4 : 16), head = gi * 4 + j;
            float q[64]; load_row64(z + (size_t)t * ZP + QC + head * 64, q);
            WAcc A; wacc_init(A);
            for (int k = lane; k <= 128; k += 64) { const int sk = s - k * dil;
                if (sk >= 0) { const bf16* kr = z + ((size_t)b * SEQ + sk) * ZP; const float sc = dot_row64(q, kr + KC + head * 64) * SC2; wacc_key(A, sc, kr + VC + head * 64); } }
            og[gi] = wacc_finish(A, lane, ls[gi]);
        }
        const float mx = fmaxf(ls[0], fmaxf(ls[1], ls[2])); const float w0 = ex2(ls[0] - mx), w1 = ex2(ls[1] - mx), w2 = ex2(ls[2] - mx);
        mix[(size_t)t * MIXW + 1280 + j * 64 + lane] = (bf16)f2bf((w0 * og[0] + w1 * og[1] + w2 * og[2]) / (w0 + w1 + w2));
    }
}
__device__ __forceinline__ void phase_moba(Frame& F) {
    const bf16* z = (const bf16*)(F.ws + WS_Z); bf16* mix = (bf16*)(F.ws + WS_MIX); const float* km = (const float*)(F.ws + WS_KMEAN); const int lane = F.lane;
    for (int it = F.gw; it < T * 8; it += F.ngw) {
        const int t = it >> 3, h = it & 7, b = t / SEQ, s = t % SEQ, cur = s >> 8;
        float q[64]; load_row64(z + (size_t)t * ZP + QA + h * 64, q);
        float gate = -1e30f;
        if (lane < cur) { const float* kmr = km + ((size_t)(b * 8 + h) * 16 + lane) * 64; float g = 0.f;
#pragma unroll
            for (int d = 0; d < 64; ++d) g += q[d] * kmr[d];
            gate = g; }
        int rank = 0;
        for (int jj = 0; jj < 16; ++jj) { const float gj = __shfl(gate, jj); rank += (gj > gate || (gj == gate && jj < lane)) ? 1 : 0; }
        const unsigned long long selm = __ballot(lane < cur && rank < 3);
        WAcc A; wacc_init(A);
        unsigned long long mm = selm;
        while (mm) { const int blk = __builtin_ctzll(mm); mm &= mm - 1;
            for (int i = 0; i < 4; ++i) { const bf16* kr = z + ((size_t)b * SEQ + blk * 256 + i * 64 + lane) * ZP; const float sc = dot_row64(q, kr + KA + h * 64) * SC2; wacc_key(A, sc, kr + VA + h * 64); } }
        for (int i = 0; i < 4; ++i) { const int sk = cur * 256 + i * 64 + lane;
            if (sk <= s) { const bf16* kr = z + ((size_t)b * SEQ + sk) * ZP; const float sc = dot_row64(q, kr + KA + h * 64) * SC2; wacc_key(A, sc, kr + VA + h * 64); } }
        float l2; const float o = wacc_finish(A, lane, l2);
        mix[(size_t)t * MIXW + h * 64 + lane] = (bf16)f2bf(o);
    }
}
__device__ __forceinline__ void phase_nsa(Frame& F) {
    const bf16* z = (const bf16*)(F.ws + WS_Z); bf16* mix = (bf16*)(F.ws + WS_MIX); const int lane = F.lane;
    LAS float* ps = (LAS float*)F.lds + F.wave * 320;
    for (int it = F.gw; it < T * 3; it += F.ngw) {
        const int t = it / 3, hk = it % 3, b = t / SEQ, s = t % SEQ, cur = s >> 6;
        const bf16* kc = (const bf16*)(F.ws + WS_KCMP) + ((size_t)(b * 3 + hk) * 256) * 64; const bf16* vc = (const bf16*)(F.ws + WS_VCMP) + ((size_t)(b * 3 + hk) * 256) * 64;
        const int ncv = s >= 31 ? ((s - 31) >> 4) + 1 : 0;
        float psum[4] = {0.f, 0.f, 0.f, 0.f}; float ocmp[4];
#pragma unroll
        for (int g = 0; g < 4; ++g) {
            float q[64]; load_row64(z + (size_t)t * ZP + QB + (hk * 4 + g) * 64, q);
            float sc[4]; float mx = -1e30f;
#pragma unroll
            for (int i = 0; i < 4; ++i) { const int n = lane + 64 * i; sc[i] = n < ncv ? dot_row64(q, kc + (size_t)n * 64) * SC2 : -1e30f; mx = fmaxf(mx, sc[i]); }
            mx = wave_max(mx); float p[4]; float ls = 0.f;
#pragma unroll
            for (int i = 0; i < 4; ++i) { const int n = lane + 64 * i; p[i] = n < ncv ? ex2(sc[i] - mx) : 0.f; ls += p[i]; }
            ls = wave_sum(ls); const float inv = ls > 0.f ? 1.f / ls : 0.f;
            float acc[64];
#pragma unroll
            for (int d = 0; d < 64; ++d) acc[d] = 0.f;
#pragma unroll
            for (int i = 0; i < 4; ++i) { const int n = lane + 64 * i; p[i] *= inv; psum[i] += p[i];
                if (n < ncv) { const v4u* pp = (const v4u*)(vc + (size_t)n * 64);
#pragma unroll
                    for (int c = 0; c < 8; ++c) { const v4u u = pp[c]; acc[8 * c + 0] += p[i] * bf_lo(u.x); acc[8 * c + 1] += p[i] * bf_hi(u.x); acc[8 * c + 2] += p[i] * bf_lo(u.y); acc[8 * c + 3] += p[i] * bf_hi(u.y);
                        acc[8 * c + 4] += p[i] * bf_lo(u.z); acc[8 * c + 5] += p[i] * bf_hi(u.z); acc[8 * c + 6] += p[i] * bf_lo(u.w); acc[8 * c + 7] += p[i] * bf_hi(u.w); } } }
            reduce_scatter64(acc, lane); ocmp[g] = acc[0];
        }
#pragma unroll
        for (int i = 0; i < 4; ++i) ps[lane + 64 * i] = (lane + 64 * i) < 255 ? psum[i] : 0.f;
        LDS_WAIT(); asm volatile("" ::: "memory");
        float imp = ps[4 * lane] + ps[4 * lane + 1] + ps[4 * lane + 2] + ps[4 * lane + 3]; if (lane > 0) imp += ps[4 * lane - 1];
        LDS_WAIT(); asm volatile("" ::: "memory");
        const bool valid = lane <= cur, forced = valid && (lane == 0 || lane > cur - 2);
        const float val = forced ? 1e30f : (valid ? imp : -1e30f);
        int rank = 0;
        for (int jj = 0; jj < 64; ++jj) { const float vj = __shfl(val, jj); rank += (vj > val || (vj == val && jj < lane)) ? 1 : 0; }
        const unsigned long long selm = __ballot(valid && rank < 16);
#pragma unroll
        for (int g = 0; g < 4; ++g) {
            const int head = hk * 4 + g;
            float q[64]; load_row64(z + (size_t)t * ZP + QB + head * 64, q);
            WAcc A; wacc_init(A);
            unsigned long long mm = selm;
            while (mm) { const int blk = __builtin_ctzll(mm); mm &= mm - 1; const int sk = blk * 64 + lane;
                if (sk <= s) { const bf16* kr = z + ((size_t)b * SEQ + sk) * ZP; const float scv = dot_row64(q, kr + KBS + hk * 64) * SC2; wacc_key(A, scv, kr + VBS + hk * 64); } }
            float l2; const float oslc = wacc_finish(A, lane, l2);
            wacc_init(A);
            for (int i = 0; i < 8; ++i) { const int sk = s - 511 + i * 64 + lane;
                if (sk >= 0) { const bf16* kr = z + ((size_t)b * SEQ + sk) * ZP; const float scv = dot_row64(q, kr + KBW + hk * 64) * SC2; wacc_key(A, scv, kr + VBW + hk * 64); } }
            const float owin = wacc_finish(A, lane, l2);
            const bf16* gp = z + (size_t)t * ZP + GB + head * 3;
            const float g0 = 1.f / (1.f + __expf(-bf1(gp[0]))), g1 = 1.f / (1.f + __expf(-bf1(gp[1]))), g2 = 1.f / (1.f + __expf(-bf1(gp[2])));
            mix[(size_t)t * MIXW + 512 + head * 64 + lane] = (bf16)f2bf(g0 * ocmp[g] + g1 * oslc + g2 * owin);
        }
    }
}

namespace fa {
typedef short bf16x8 __attribute__((ext_vector_type(8)));
typedef short s16x4 __attribute__((ext_vector_type(4)));
typedef float f32x16 __attribute__((ext_vector_type(16)));
typedef short v4i16_t __attribute__((ext_vector_type(4)));
constexpr int SLOTB = 8192, LDS_K = 0, LDS_V = 3 * SLOTB, LDS_WS = 6 * SLOTB, LDS_PS = LDS_WS + 8 * 256, LDS_SEL = LDS_PS + 8 * 8192, LDS_Q = LDS_SEL + 1024, LDS_END = LDS_Q + 64;
constexpr float THR = 8.f;
constexpr int NEGBIG = -(1 << 29);
#define FA_MFMA(a, b, c) __builtin_amdgcn_mfma_f32_32x32x16_bf16(a, b, c, 0, 0, 0)
typedef LAS const char* lcp;
__device__ __forceinline__ int crow(int r, int hi) { return (r & 3) + 8 * (r >> 2) + 4 * hi; }
__device__ __forceinline__ void glds16(const void* gsrc, unsigned lds_dst) { unsigned keep;
    asm volatile("s_mov_b32 %0, m0\n\ts_mov_b32 m0, %2\n\ts_nop 0\n\tglobal_load_lds_dwordx4 %1, off\n\ts_mov_b32 m0, %0" : "=&s"(keep) : "v"(gsrc), "s"(lds_dst) : "memory"); }
__device__ __forceinline__ s16x4 vtr(lcp p) { return __builtin_bit_cast(s16x4, __builtin_amdgcn_ds_read_tr16_b64_v4i16((LAS v4i16_t*)p)); }
__device__ __forceinline__ unsigned cvtpk(float lo, float hi) { typedef float f2 __attribute__((ext_vector_type(2))); typedef __bf16 b2 __attribute__((ext_vector_type(2))); f2 v = {lo, hi}; b2 b = __builtin_convertvector(v, b2); return __builtin_bit_cast(unsigned, b); }
__device__ __forceinline__ void half_pair(float v, float& x0, float& x1) { unsigned a = __builtin_bit_cast(unsigned, v), b = a;
    asm volatile("s_nop 1\n\tv_permlane32_swap_b32 %0, %1\n\ts_nop 1" : "+v"(a), "+v"(b));
    x0 = __builtin_bit_cast(float, a); x1 = __builtin_bit_cast(float, b); }
__device__ __forceinline__ float half_max(float v) { float x0, x1; half_pair(v, x0, x1); return fmaxf(x0, x1); }
__device__ __forceinline__ float half_sum(float v) { float x0, x1; half_pair(v, x0, x1); return x0 + x1; }
#define FA_WAIT_BAR(N) asm volatile("s_waitcnt vmcnt(" #N ") lgkmcnt(0)\n\ts_barrier" ::: "memory")

struct Rows { int qlo, qhi, lo_min, lo_max, hi_min, hi_max; };
struct St { float m, l; f32x16 o[2]; };
__device__ __forceinline__ void st_init(St& s) { s.m = -INFINITY; s.l = 0.f; s.o[0] = f32x16{}; s.o[1] = f32x16{}; }

__device__ __forceinline__ float max3f(float a, float b, float c) { float r; asm("v_max3_f32 %0, %1, %2, %3" : "=v"(r) : "v"(a), "v"(b), "v"(c)); return r; }
__device__ __forceinline__ void qk_tile(f32x16& p0, f32x16& p1, lcp kslot, const bf16x8 (&qr)[4], int r32, int hi) {
    lcp kb = kslot + hi * 1024 + r32 * 16;
    bf16x8 kf[8];
#pragma unroll
    for (int d0 = 0; d0 < 4; ++d0) { kf[2 * d0] = *(const LAS bf16x8*)(kb + d0 * 2048); kf[2 * d0 + 1] = *(const LAS bf16x8*)(kb + d0 * 2048 + 512); }
    __builtin_amdgcn_sched_barrier(0);
    p0 = f32x16{}; p1 = f32x16{};
#pragma unroll
    for (int d0 = 0; d0 < 4; ++d0) { p0 = FA_MFMA(kf[2 * d0], qr[d0], p0); p1 = FA_MFMA(kf[2 * d0 + 1], qr[d0], p1); }
}
__device__ __forceinline__ void tile_step(St& s, lcp kslot, lcp vslot, const bf16x8 (&qr)[4], int mode, bool sel, int kb, int qlo, int qhi, LAS float* wsf, int lane, int r32, int hi) {
    typedef float f2 __attribute__((ext_vector_type(2)));
    f32x16 p0, p1; qk_tile(p0, p1, kslot, qr, r32, hi);
    lcp vp = vslot + ((lane >> 4) & 1) * 32 + (lane & 3) * 8 + (4 * hi + ((lane & 15) >> 2)) * 64;
    s16x4 vl[4], vh[4];
#pragma unroll
    for (int i = 0; i < 4; ++i) { vl[i] = vtr(vp + i * 1024); vh[i] = vtr(vp + i * 1024 + 512); }
    __builtin_amdgcn_sched_barrier(0);
    asm volatile("s_nop 15\n\ts_nop 7" : "+v"(p0), "+v"(p1));
    if (mode == 2) { const int x = qhi - kb - 4 * hi, y = qlo - kb - 4 * hi;
#pragma unroll
        for (int r = 0; r < 16; ++r) { const int c = (r & 3) + 8 * (r >> 2); if (c > x || c < y) p0[r] = -INFINITY; if (c + 32 > x || c + 32 < y) p1[r] = -INFINITY; } }
    if (mode == 3) {
#pragma unroll
        for (int r = 0; r < 16; ++r) { p0[r] = sel ? p0[r] : -INFINITY; p1[r] = sel ? p1[r] : -INFINITY; } }
    float ma = max3f(p0[0], p0[1], p1[0]), mb = max3f(p0[2], p0[3], p1[1]); ma = max3f(ma, p1[2], p1[3]);
#pragma unroll
    for (int r = 4; r < 16; r += 4) { ma = max3f(ma, p0[r], p0[r + 1]); mb = max3f(mb, p0[r + 2], p0[r + 3]); ma = max3f(ma, p1[r], p1[r + 1]); mb = max3f(mb, p1[r + 2], p1[r + 3]); }
    const float mx = half_max(fmaxf(ma, mb));
    const float t2 = mx * SC2;
    if (__any(t2 > s.m + THR)) {
        const float mn = fmaxf(s.m, t2);
        const float alpha = (mn == -INFINITY) ? 1.f : ex2(s.m - mn);
        s.l *= alpha; s.m = mn;
        if (hi == 0) wsf[r32] = alpha;
#pragma unroll
        for (int r = 0; r < 16; ++r) { const float a = wsf[crow(r, hi)]; s.o[0][r] *= a; s.o[1][r] *= a; }
    }
    const float mu = (s.m == -INFINITY) ? 0.f : s.m;
    const f2 nmu = {-mu, -mu}; f2 ls2 = {0.f, 0.f};
#pragma unroll
    for (int r = 0; r < 16; r += 2) { f2 a = {p0[r], p0[r + 1]}, c = {p1[r], p1[r + 1]}; a = a * SC2 + nmu; c = c * SC2 + nmu;
        p0[r] = ex2(a.x); p0[r + 1] = ex2(a.y); p1[r] = ex2(c.x); p1[r + 1] = ex2(c.y); ls2 += (f2){p0[r], p0[r + 1]}; ls2 += (f2){p1[r], p1[r + 1]}; }
    s.l += ls2.x + ls2.y;
    typedef unsigned u32x4 __attribute__((ext_vector_type(4)));
    const u32x4 w0 = {cvtpk(p0[0], p0[1]), cvtpk(p0[2], p0[3]), cvtpk(p0[4], p0[5]), cvtpk(p0[6], p0[7])}, w1 = {cvtpk(p0[8], p0[9]), cvtpk(p0[10], p0[11]), cvtpk(p0[12], p0[13]), cvtpk(p0[14], p0[15])};
    const u32x4 w2 = {cvtpk(p1[0], p1[1]), cvtpk(p1[2], p1[3]), cvtpk(p1[4], p1[5]), cvtpk(p1[6], p1[7])}, w3 = {cvtpk(p1[8], p1[9]), cvtpk(p1[10], p1[11]), cvtpk(p1[12], p1[13]), cvtpk(p1[14], p1[15])};
    const bf16x8 pa[4] = {__builtin_bit_cast(bf16x8, w0), __builtin_bit_cast(bf16x8, w1), __builtin_bit_cast(bf16x8, w2), __builtin_bit_cast(bf16x8, w3)};
    s16x4 ul[4], uh[4];
#pragma unroll
    for (int i = 0; i < 4; ++i) { ul[i] = vtr(vp + 4096 + i * 1024); uh[i] = vtr(vp + 4096 + i * 1024 + 512); }
    __builtin_amdgcn_sched_barrier(0);
#pragma unroll
    for (int kg = 0; kg < 4; ++kg) { const s16x4 lo = vl[kg], hh = vh[kg]; const bf16x8 vf = {lo[0], lo[1], lo[2], lo[3], hh[0], hh[1], hh[2], hh[3]}; s.o[0] = FA_MFMA(pa[kg], vf, s.o[0]); }
#pragma unroll
    for (int kg = 0; kg < 4; ++kg) { const s16x4 lo = ul[kg], hh = uh[kg]; const bf16x8 vf = {lo[0], lo[1], lo[2], lo[3], hh[0], hh[1], hh[2], hh[3]}; s.o[1] = FA_MFMA(pa[kg], vf, s.o[1]); }
}
template <bool USESEL, class SelT>
__device__ __forceinline__ void stream_pv(LAS char* L, int wid, int lane, const bf16* Kb, size_t sK, const bf16* Vb, size_t sV, int t_lo, int t_hi,
                                          const bf16x8 (&qr)[4], const Rows& R, SelT selm, int tpb_shift, int cur_blk, St& s) {
    const int r32 = lane & 31, hi = lane >> 5, n = t_hi - t_lo + 1;
    if (n <= 0) return;
    const unsigned lds0 = (unsigned)(uintptr_t)L;
    const bf16* ksrc = Kb + ((size_t)t_lo * 64 + lane) * sK + wid * 8;
    const bf16* vsrc = Vb + ((size_t)t_lo * 64 + 16 * (wid & 3) + (lane >> 2)) * sV + (wid >> 2) * 32 + (lane & 3) * 8;
    const unsigned kdst = lds0 + LDS_K + wid * 1024, vdst = lds0 + LDS_V + wid * 1024;
    LAS float* wsf = (LAS float*)(L + LDS_WS) + wid * 64;
#define FA_ISSUE(i, slot) do { glds16(ksrc + (size_t)(i) * 64 * sK, (unsigned)__builtin_amdgcn_readfirstlane(kdst + (slot) * SLOTB)); glds16(vsrc + (size_t)(i) * 64 * sV, (unsigned)__builtin_amdgcn_readfirstlane(vdst + (slot) * SLOTB)); } while (0)
    asm volatile("s_waitcnt vmcnt(0)" ::: "memory");
    FA_ISSUE(0, 0); if (n > 1) FA_ISSUE(1, 1);
    int slot = 0;
    for (int i = 0; i < n; ++i) {
        if (i + 1 < n) FA_WAIT_BAR(2); else FA_WAIT_BAR(0);
        if (i + 2 < n) { const int s2 = slot >= 1 ? slot - 1 : 2; FA_ISSUE(i + 2, s2); }
        const int t = t_lo + i, kb = t * 64;
        int mode; bool sel = true;
        if (USESEL && (t >> tpb_shift) < cur_blk) { sel = ((selm >> (t >> tpb_shift)) & (SelT)1) != (SelT)0; const unsigned long long bal = __ballot(sel); mode = bal == 0ull ? 0 : (bal == ~0ull ? 1 : 3); }
        else mode = (kb > R.hi_max || kb + 63 < R.lo_min) ? 0 : ((kb + 63 <= R.hi_min && kb >= R.lo_max) ? 1 : 2);
        if (mode != 0) {
            tile_step(s, (lcp)L + LDS_K + slot * SLOTB, (lcp)L + LDS_V + slot * SLOTB, qr, mode, sel, kb, R.qlo, R.qhi, wsf, lane, r32, hi);
        }
        slot = slot == 2 ? 0 : slot + 1;
    }
    asm volatile("s_waitcnt lgkmcnt(0)\n\ts_barrier" ::: "memory");
#undef FA_ISSUE
}
__device__ __forceinline__ float st_invl(const St& s, float& ltot) { ltot = half_sum(s.l); return ltot > 0.f ? 1.f / ltot : 0.f; }
template <bool ACCUM>
__device__ __forceinline__ void scale_rows(f32x16 (&dst)[2], const f32x16 (&o)[2], float fac, LAS float* wsf, int r32, int hi) {
    if (hi == 0) wsf[r32] = fac;
#pragma unroll
    for (int r = 0; r < 16; ++r) { const float a = wsf[crow(r, hi)]; if (ACCUM) { dst[0][r] += o[0][r] * a; dst[1][r] += o[1][r] * a; } else { dst[0][r] = o[0][r] * a; dst[1][r] = o[1][r] * a; } }
}

__device__ __forceinline__ void unit_dilated(LAS char* L, unsigned char* ws, int wid, int lane, int uid) {
    const int r32 = lane & 31, hi = lane >> 5;
    const int b = uid / 192, gi = (uid % 192) >> 6, x = uid & 63, j = x >> 4, y = x & 15;
    const int dil = gi == 0 ? 1 : (gi == 1 ? 4 : 16), res = gi == 0 ? 0 : (gi == 1 ? (y >> 2) : y), u = gi == 0 ? y : (gi == 1 ? (y & 3) : 0), head = gi * 4 + j;
    const bf16* z = (const bf16*)(ws + WS_Z);
    const bf16* base = z + ((size_t)b * SEQ + res) * ZP + head * 64;
    const size_t sr = (size_t)dil * ZP;
    const int i = 256 * u + 32 * wid + r32;
    bf16x8 qr[4];
#pragma unroll
    for (int d0 = 0; d0 < 4; ++d0) qr[d0] = *(const bf16x8*)(base + QC + (size_t)i * sr + d0 * 16 + hi * 8);
    asm volatile("s_waitcnt vmcnt(0)" : "+v"(qr[0]), "+v"(qr[1]), "+v"(qr[2]), "+v"(qr[3]) :: "memory");
    Rows R; R.qhi = i; R.qlo = i - 128; R.hi_min = 256 * u + 32 * wid; R.hi_max = R.hi_min + 31; R.lo_min = R.hi_min - 128; R.lo_max = R.hi_max - 128;
    St s; st_init(s);
    stream_pv<false, unsigned>(L, wid, lane, base + KC, sr, base + VC, sr, (4 * u - 2) > 0 ? 4 * u - 2 : 0, 4 * u + 3, qr, R, 0u, 0, 0, s);
    float ltot; const float inv = st_invl(s, ltot);
    LAS float* wsf = (LAS float*)(L + LDS_WS) + wid * 64;
    f32x16 out[2]; scale_rows<false>(out, s.o, inv, wsf, r32, hi);
    float* dout = (float*)(ws + WS_DILO) + (size_t)gi * T * 256; float* dlse = (float*)(ws + WS_DILL) + (size_t)gi * T * 4;
    if (hi == 0) dlse[((size_t)b * SEQ + (size_t)i * dil + res) * 4 + j] = s.m + __log2f(ltot);
#pragma unroll
    for (int r = 0; r < 16; ++r) { const int q = crow(r, hi); const size_t tok = (size_t)b * SEQ + (size_t)(256 * u + 32 * wid + q) * dil + res;
        dout[tok * 256 + j * 64 + r32] = out[0][r]; dout[tok * 256 + j * 64 + 32 + r32] = out[1][r]; }
}
__device__ __forceinline__ void unit_moba(LAS char* L, unsigned char* ws, int wid, int lane, int uid) {
    const int r32 = lane & 31, hi = lane >> 5, b = uid >> 7, h = (uid >> 4) & 7, qb = uid & 15;
    const bf16* z = (const bf16*)(ws + WS_Z) + (size_t)b * SEQ * ZP;
    const int s = 256 * qb + 32 * wid + r32;
    bf16x8 qr[4];
#pragma unroll
    for (int d0 = 0; d0 < 4; ++d0) qr[d0] = *(const bf16x8*)(z + (size_t)s * ZP + QA + h * 64 + d0 * 16 + hi * 8);
    asm volatile("s_waitcnt vmcnt(0)" : "+v"(qr[0]), "+v"(qr[1]), "+v"(qr[2]), "+v"(qr[3]) :: "memory");
    unsigned selm = 0u;
    if (qb > 0) {
        const float* km = (const float*)(ws + WS_KMEAN) + ((size_t)(b * 8 + h) * 16) * 64;
        f32x16 g = f32x16{};
#pragma unroll
        for (int d0 = 0; d0 < 4; ++d0) {
            f32x4 a0 = {0.f, 0.f, 0.f, 0.f}, a1 = {0.f, 0.f, 0.f, 0.f};
            if (r32 < 16) { a0 = *(const f32x4*)(km + r32 * 64 + d0 * 16 + hi * 8); a1 = *(const f32x4*)(km + r32 * 64 + d0 * 16 + hi * 8 + 4); }
            const float v[8] = {a0[0], a0[1], a0[2], a0[3], a1[0], a1[1], a1[2], a1[3]};
            unsigned wh[4], wl[4];
#pragma unroll
            for (int e = 0; e < 4; ++e) { const unsigned h0 = f2bf(v[2 * e]), h1 = f2bf(v[2 * e + 1]); wh[e] = h0 | (h1 << 16);
                wl[e] = pk2(v[2 * e] - __builtin_bit_cast(float, h0 << 16), v[2 * e + 1] - __builtin_bit_cast(float, h1 << 16)); }
            typedef unsigned u32x4 __attribute__((ext_vector_type(4)));
            const u32x4 uh = {wh[0], wh[1], wh[2], wh[3]}, ul = {wl[0], wl[1], wl[2], wl[3]};
            g = FA_MFMA(__builtin_bit_cast(bf16x8, uh), qr[d0], g); g = FA_MFMA(__builtin_bit_cast(bf16x8, ul), qr[d0], g);
        }
        float gv[16];
#pragma unroll
        for (int r = 0; r < 8; ++r) { float x0, x1; half_pair(g[r], x0, x1); gv[8 * (r >> 2) + (r & 3)] = x0; gv[8 * (r >> 2) + 4 + (r & 3)] = x1; }
#pragma unroll
        for (int i = 0; i < 16; ++i) if (i >= qb) gv[i] = -INFINITY;
#pragma unroll
        for (int i = 0; i < 16; ++i) { int rank = 0;
#pragma unroll
            for (int jx = 0; jx < 16; ++jx) rank += (gv[jx] > gv[i] || (gv[jx] == gv[i] && jx < i)) ? 1 : 0;
            if (i < qb && rank < 3) selm |= (1u << i); }
    }
    Rows R; R.qhi = s; R.qlo = NEGBIG; R.hi_min = 256 * qb + 32 * wid; R.hi_max = R.hi_min + 31; R.lo_min = NEGBIG; R.lo_max = NEGBIG;
    St st; st_init(st);
    stream_pv<true, unsigned>(L, wid, lane, z + KA + h * 64, (size_t)ZP, z + VA + h * 64, (size_t)ZP, 0, 4 * qb + 3, qr, R, selm, 2, qb, st);
    float ltot; const float inv = st_invl(st, ltot);
    LAS float* wsf = (LAS float*)(L + LDS_WS) + wid * 64;
    f32x16 out[2]; scale_rows<false>(out, st.o, inv, wsf, r32, hi);
    bf16* mix = (bf16*)(ws + WS_MIX) + ((size_t)b * SEQ + 256 * qb + 32 * wid) * MIXW + h * 64;
#pragma unroll
    for (int r = 0; r < 16; ++r) { const int q = crow(r, hi); mix[(size_t)q * MIXW + r32] = (bf16)f2bf(out[0][r]); mix[(size_t)q * MIXW + 32 + r32] = (bf16)f2bf(out[1][r]); }
}
__device__ __forceinline__ void unit_nsa(LAS char* L, unsigned char* ws, int wid, int lane, int uid) {
    const int r32 = lane & 31, hi = lane >> 5, bh = uid >> 6, b = bh / 3, hk = bh % 3, tb = uid & 63;
    const int jt = r32 & 7, g = r32 >> 3, head = hk * 4 + g, s = 64 * tb + 8 * wid + jt, smin = 64 * tb + 8 * wid, smax = smin + 7;
    const bf16* z = (const bf16*)(ws + WS_Z) + (size_t)b * SEQ * ZP;
    LAS float* wsf = (LAS float*)(L + LDS_WS) + wid * 64;
    bf16x8 qr[4];
#pragma unroll
    for (int d0 = 0; d0 < 4; ++d0) qr[d0] = *(const bf16x8*)(z + (size_t)s * ZP + QB + head * 64 + d0 * 16 + hi * 8);
    asm volatile("s_waitcnt vmcnt(0)" : "+v"(qr[0]), "+v"(qr[1]), "+v"(qr[2]), "+v"(qr[3]) :: "memory");
    const bf16* gp = z + (size_t)s * ZP + GB + head * 3;
    const float g0 = 1.f / (1.f + __expf(-bf1(gp[0]))), g1 = 1.f / (1.f + __expf(-bf1(gp[1]))), g2 = 1.f / (1.f + __expf(-bf1(gp[2])));
    f32x16 fin[2];
    const bf16* kc = (const bf16*)(ws + WS_KCMP) + ((size_t)(b * 3 + hk) * 256) * 64; const bf16* vc = (const bf16*)(ws + WS_VCMP) + ((size_t)(b * 3 + hk) * 256) * 64;
    const int ncv = s >= 31 ? ((s - 31) >> 4) + 1 : 0, ncv_lo = smin >= 31 ? ((smin - 31) >> 4) + 1 : 0, ncv_hi = smax >= 31 ? ((smax - 31) >> 4) + 1 : 0;
    const int ncv_blk = ((64 * tb + 63 - 31) >> 4) + 1, ct_hi = (ncv_blk - 1) >> 6;
    Rows Rc; Rc.qhi = ncv - 1; Rc.qlo = NEGBIG; Rc.hi_min = ncv_lo - 1; Rc.hi_max = ncv_hi - 1; Rc.lo_min = NEGBIG; Rc.lo_max = NEGBIG;
    St st; st_init(st);
    stream_pv<false, unsigned>(L, wid, lane, kc, (size_t)64, vc, (size_t)64, 0, ct_hi, qr, Rc, 0u, 0, 0, st);
    float ltot; const float invc = st_invl(st, ltot);
    scale_rows<false>(fin, st.o, invc * g0, wsf, r32, hi);
    {
        LAS float* ps = (LAS float*)(L + LDS_PS) + wid * 2048;
        for (int i = lane; i < 2048; i += 64) ps[i] = 0.f;
        const float mu = (st.m == -INFINITY) ? 0.f : st.m;
        const unsigned lds0 = (unsigned)(uintptr_t)L; const bf16* ksrc = kc + (size_t)lane * 64 + wid * 8; const unsigned kdst = lds0 + LDS_K + wid * 1024;
        const int n = ct_hi + 1;
        asm volatile("s_waitcnt vmcnt(0)" ::: "memory");
        glds16(ksrc, (unsigned)__builtin_amdgcn_readfirstlane(kdst)); if (n > 1) glds16(ksrc + 64 * 64, (unsigned)__builtin_amdgcn_readfirstlane(kdst + SLOTB));
        int slot = 0;
        for (int i = 0; i < n; ++i) {
            if (i + 1 < n) FA_WAIT_BAR(1); else FA_WAIT_BAR(0);
            if (i + 2 < n) { const int s2 = slot >= 1 ? slot - 1 : 2; glds16(ksrc + (size_t)(i + 2) * 64 * 64, (unsigned)__builtin_amdgcn_readfirstlane(kdst + s2 * SLOTB)); }
            const int kb = i * 64;
            if (kb <= Rc.hi_max) {
                f32x16 p0, p1; qk_tile(p0, p1, (lcp)L + LDS_K + slot * SLOTB, qr, r32, hi);
#pragma unroll
                for (int r = 0; r < 16; ++r) { const int k = kb + crow(r, hi);
                    float a = (k <= Rc.qhi) ? ex2(__builtin_fmaf(p0[r], SC2, -mu)) * invc : 0.f, c = (k + 32 <= Rc.qhi) ? ex2(__builtin_fmaf(p1[r], SC2, -mu)) * invc : 0.f;
                    a += __shfl_xor(a, 8); a += __shfl_xor(a, 16); c += __shfl_xor(c, 8); c += __shfl_xor(c, 16);
                    if (r32 < 8) { ps[r32 * 256 + k] = a; ps[r32 * 256 + k + 32] = c; } }
            }
            slot = slot == 2 ? 0 : slot + 1;
        }
        asm volatile("s_waitcnt lgkmcnt(0)\n\ts_barrier" ::: "memory");
    }
    unsigned long long selm = 0ull;
    {
        const LAS float* ps = (const LAS float*)(L + LDS_PS) + wid * 2048;
#pragma unroll 1
        for (int j = 0; j < 8; ++j) {
            const LAS float* pj = ps + j * 256;
            float imp = (pj[4 * lane] + pj[4 * lane + 1]) + (pj[4 * lane + 2] + (lane < 63 ? pj[4 * lane + 3] : 0.f)); if (lane > 0) imp += pj[4 * lane - 1];
            const bool valid = lane <= tb, forced = valid && (lane == 0 || lane > tb - 2);
            const float val = forced ? 1e30f : (valid ? imp : -1e30f);
            int rank = 0;
            for (int jj = 0; jj < 64; ++jj) { const float vj = __shfl(val, jj); rank += (vj > val || (vj == val && jj < lane)) ? 1 : 0; }
            const unsigned long long mk = __ballot(valid && rank < 16);
            if (jt == j) selm = mk;
        }
    }
    Rows Rs; Rs.qhi = s; Rs.qlo = NEGBIG; Rs.hi_min = smin; Rs.hi_max = smax; Rs.lo_min = NEGBIG; Rs.lo_max = NEGBIG;
    st_init(st);
    stream_pv<true, unsigned long long>(L, wid, lane, z + KBS + hk * 64, (size_t)ZP, z + VBS + hk * 64, (size_t)ZP, 0, tb, qr, Rs, selm, 0, tb, st);
    { const float inv = st_invl(st, ltot); scale_rows<true>(fin, st.o, inv * g1, wsf, r32, hi); }
    Rows Rw; Rw.qhi = s; Rw.qlo = s - 511; Rw.hi_min = smin; Rw.hi_max = smax; Rw.lo_min = smin - 511; Rw.lo_max = smax - 511;
    st_init(st);
    stream_pv<false, unsigned>(L, wid, lane, z + KBW + hk * 64, (size_t)ZP, z + VBW + hk * 64, (size_t)ZP, (tb - 8) > 0 ? tb - 8 : 0, tb, qr, Rw, 0u, 0, 0, st);
    { const float inv = st_invl(st, ltot); scale_rows<true>(fin, st.o, inv * g2, wsf, r32, hi); }
    bf16* mix = (bf16*)(ws + WS_MIX) + ((size_t)b * SEQ + 64 * tb + 8 * wid) * MIXW + 512 + hk * 256;
#pragma unroll
    for (int r = 0; r < 16; ++r) { const int q = crow(r, hi); bf16* o = mix + (size_t)(q & 7) * MIXW + (q >> 3) * 64;
        o[r32] = (bf16)f2bf(fin[0][r]); o[32 + r32] = (bf16)f2bf(fin[1][r]); }
}
#undef FA_MFMA
}
__device__ const unsigned short P2_ORDER[640] = {63,127,191,255,319,383,62,126,190,254,318,382,61,125,189,253,317,381,60,124,188,252,316,380,59,123,187,251,315,379,58,122,186,250,314,378,57,121,185,249,313,377,56,120,184,248,312,376,55,119,183,247,311,375,54,118,182,246,310,374,53,117,181,245,309,373,52,116,180,244,308,372,51,115,179,243,307,371,50,114,178,242,306,370,49,113,177,241,305,369,48,112,176,240,304,368,47,111,175,239,303,367,46,110,174,238,302,366,399,415,431,447,463,479,495,511,527,543,559,575,591,607,623,639,45,109,173,237,301,365,44,108,172,236,300,364,43,107,171,235,299,363,42,106,170,234,298,362,398,414,430,446,462,478,494,510,526,542,558,574,590,606,622,638,41,105,169,233,297,361,40,104,168,232,296,360,39,103,167,231,295,359,38,102,166,230,294,358,397,413,429,445,461,477,493,509,525,541,557,573,589,605,621,637,37,101,165,229,293,357,36,100,164,228,292,356,35,99,163,227,291,355,34,98,162,226,290,354,396,412,428,444,460,476,492,508,524,540,556,572,588,604,620,636,33,97,161,225,289,353,32,96,160,224,288,352,395,411,427,443,459,475,491,507,523,539,555,571,587,603,619,635,31,95,159,223,287,351,30,94,158,222,286,350,29,93,157,221,285,349,28,92,156,220,284,348,394,410,426,442,458,474,490,506,522,538,554,570,586,602,618,634,27,91,155,219,283,347,26,90,154,218,282,346,25,89,153,217,281,345,24,88,152,216,280,344,393,409,425,441,457,473,489,505,521,537,553,569,585,601,617,633,23,87,151,215,279,343,22,86,150,214,278,342,21,85,149,213,277,341,20,84,148,212,276,340,392,408,424,440,456,472,488,504,520,536,552,568,584,600,616,632,19,83,147,211,275,339,18,82,146,210,274,338,17,81,145,209,273,337,16,80,144,208,272,336,391,407,423,439,455,471,487,503,519,535,551,567,583,599,615,631,15,79,143,207,271,335,14,78,142,206,270,334,390,406,422,438,454,470,486,502,518,534,550,566,582,598,614,630,13,77,141,205,269,333,12,76,140,204,268,332,11,75,139,203,267,331,10,74,138,202,266,330,389,405,421,437,453,469,485,501,517,533,549,565,581,597,613,629,9,73,137,201,265,329,8,72,136,200,264,328,7,71,135,199,263,327,388,404,420,436,452,468,484,500,516,532,548,564,580,596,612,628,6,70,134,198,262,326,5,69,133,197,261,325,387,403,419,435,451,467,483,499,515,531,547,563,579,595,611,627,4,68,132,196,260,324,3,67,131,195,259,323,386,402,418,434,450,466,482,498,514,530,546,562,578,594,610,626,2,66,130,194,258,322,1,65,129,193,257,321,385,401,417,433,449,465,481,497,513,529,545,561,577,593,609,625,0,64,128,192,256,320,384,400,416,432,448,464,480,496,512,528,544,560,576,592,608,624};

__device__ __forceinline__ int dequeue(unsigned* ctr, volatile LAS int* w, int tid) {
    if (tid == 0) *w = (int)__hip_atomic_fetch_add(ctr, 1u, __ATOMIC_RELAXED, __HIP_MEMORY_SCOPE_AGENT);
    __syncthreads(); const int v = *w; __syncthreads(); return __builtin_amdgcn_readfirstlane(v);
}
__device__ __forceinline__ void dil_combine(Frame& F) {
    const float* dout = (const float*)(F.ws + WS_DILO); const float* dlse = (const float*)(F.ws + WS_DILL); bf16* mix = (bf16*)(F.ws + WS_MIX);
    for (int i = F.gw * 64 + F.lane; i < T * 256; i += F.ngw * 64) { const int t = i >> 8, c = i & 255, j = c >> 6;
        const float l0 = dlse[(size_t)t * 4 + j], l1 = dlse[(size_t)T * 4 + (size_t)t * 4 + j], l2 = dlse[(size_t)2 * T * 4 + (size_t)t * 4 + j];
        const float mx = fmaxf(l0, fmaxf(l1, l2)), w0 = ex2(l0 - mx), w1 = ex2(l1 - mx), w2 = ex2(l2 - mx);
        const float o = w0 * dout[i] + w1 * dout[(size_t)T * 256 + i] + w2 * dout[(size_t)2 * T * 256 + i];
        mix[(size_t)t * MIXW + 1280 + c] = (bf16)f2bf(o / (w0 + w1 + w2)); }
}
__device__ __forceinline__ void load_router(Frame& F, const float* rw) {
    LAS float* rwt = (LAS float*)F.lds;
    for (int i = F.tid; i < 8192; i += 512) { const f32x4 v = ((const f32x4*)rw)[i]; const int k = i >> 2, e0 = (i & 3) * 4; rwt[(e0 + 0) * 2048 + k] = v.x; rwt[(e0 + 1) * 2048 + k] = v.y; rwt[(e0 + 2) * 2048 + k] = v.z; rwt[(e0 + 3) * 2048 + k] = v.w; }
    __syncthreads();
}
__device__ __forceinline__ void phase_ln1_router(Frame& F, const Args& a, int L) {
    load_router(F, a.in[I_RW]);
    const LAS f32x4* rwt4 = (const LAS f32x4*)F.lds; const int lane = F.lane;
    const float* y = (const float*)(F.ws + WS_Y); float* h32 = (float*)(F.ws + WS_H32); bf16* hb = (bf16*)(F.ws + WS_HB);
    int* tokc = (int*)(F.ws + WS_TOKC); int* toks = (int*)(F.ws + WS_TOKS); float* tokw = (float*)(F.ws + WS_TOKW);
    volatile LAS int* cl = (volatile LAS int*)(F.lds + LDSCTL_OFF + 2048);
    for (int i = F.tid; i < 512; i += 512) cl[i] = -1;
    __syncthreads();
    for (int m = F.gw; m < T; m += F.ngw) {
        f32x4 o[8]; ln_row(y + (size_t)m * D, nullptr, a.in[I_LN1G] + (size_t)L * D, a.in[I_LN1B] + (size_t)L * D, (float*)nullptr, hb + (size_t)m * D, lane, o);
        float myl = 0.f;
#pragma unroll 1
        for (int e = 0; e < 16; ++e) { float s = 0.f;
#pragma unroll
            for (int j = 0; j < 8; ++j) { const f32x4 w = rwt4[e * 512 + j * 64 + lane]; s += (o[j].x * w.x + o[j].y * w.y) + (o[j].z * w.z + o[j].w * w.w); }
            s = wave_sum(s); if (lane == e) myl = s; }
        if (lane < 16) myl += a.in[I_RB][lane];
        float pe[16]; float mx = -1e30f;
#pragma unroll
        for (int e = 0; e < 16; ++e) { pe[e] = __shfl(myl, e); mx = fmaxf(mx, pe[e]); }
#pragma unroll
        for (int e = 0; e < 16; ++e) pe[e] = expf(pe[e] - mx);
        int gsel = 0; float gbest = -1.f; int i1s = 0, i2s = 1; float p1s = 0.f, p2s = 0.f;
#pragma unroll
        for (int g = 0; g < 4; ++g) {
            int i1 = 0; float p1 = pe[4 * g];
#pragma unroll
            for (int i = 1; i < 4; ++i) if (pe[4 * g + i] > p1) { p1 = pe[4 * g + i]; i1 = i; }
            int i2 = -1; float p2 = -1.f;
#pragma unroll
            for (int i = 0; i < 4; ++i) if (i != i1 && pe[4 * g + i] > p2) { p2 = pe[4 * g + i]; i2 = i; }
            const float sg = p1 + p2;
            if (sg > gbest) { gbest = sg; gsel = g; i1s = i1; i2s = i2; p1s = p1; p2s = p2; }
        }
        const int lo = i1s < i2s ? i1s : i2s, hi = i1s < i2s ? i2s : i1s;
        const float wlo = (i1s < i2s ? p1s : p2s) / (p1s + p2s), whi = (i1s < i2s ? p2s : p1s) / (p1s + p2s);
        const int pi = lo == 0 ? hi - 1 : (lo == 1 ? hi + 1 : 5);
        const int cls = gsel * 6 + pi;
        if (lane == 0) { cl[((m - F.gw) / F.ngw) * 8 + F.wave] = cls; tokc[m] = cls; tokw[2 * m] = wlo; tokw[2 * m + 1] = whi; }
    }
    __syncthreads();
    { const int nloc = ((T - F.bx * 8 + F.ngw - 1) / F.ngw) * 8;
      if (F.tid < nloc) { const int c = cl[F.tid]; if (c >= 0) { int rank = 0; for (int j = 0; j < F.tid; ++j) rank += (cl[j] == c) ? 1 : 0; toks[F.bx * 8 + (F.tid & 7) + (F.tid >> 3) * F.ngw] = rank; } }
      if (F.tid < 32) { int n = 0; if (F.tid < 24) for (int j = 0; j < nloc; ++j) n += (cl[j] == F.tid) ? 1 : 0; ((int*)(F.ws + WS_CNTB))[F.bx * 32 + F.tid] = n; } }
    __syncthreads();
}
__device__ __forceinline__ void build_tiles(Frame& F, int L) {
    volatile LAS int* tab = (volatile LAS int*)(F.lds + TILE_OFF); volatile LAS int* part = (volatile LAS int*)(F.lds + LDSCTL_OFF + 4096);
    const int* cntb = (const int*)(F.ws + WS_CNTB); const int chunk = (F.G + 15) / 16;
    if (F.tid < 384) { const int c = F.tid % 24, ch = F.tid / 24; int s = 0; for (int b = ch * chunk; b < (ch + 1) * chunk && b < F.G; ++b) s += cntb[b * 32 + c]; part[ch * 24 + c] = s; }
    __syncthreads();
    if (F.tid < 24) { const int c = F.tid, mych = F.bx / chunk; int tot = 0, base = 0;
        for (int ch = 0; ch < 16; ++ch) { const int v = part[ch * 24 + c]; tot += v; if (ch < mych) base += v; }
        for (int b = mych * chunk; b < F.bx; ++b) base += cntb[b * 32 + c];
        tab[100 + c] = base; tab[128 + c] = tot; }
    __syncthreads();
    if (F.tid == 0) { int off = 0, nt = 0;
        for (int c = 0; c < 24; ++c) { const int n = tab[128 + c]; tab[64 + c] = off; const int k = (n + 255) >> 8; for (int i = 0; i < k && nt < MAXTILES; ++i) tab[nt++] = c; off += k * 256; }
        tab[64 + 24] = off; tab[96] = nt; }
    __syncthreads();
}
__device__ __forceinline__ void phase_gather(Frame& F, int L) {
    volatile LAS int* tab = (volatile LAS int*)(F.lds + TILE_OFF);
    const int* tokc = (const int*)(F.ws + WS_TOKC); int* toks = (int*)(F.ws + WS_TOKS); const float* tokw = (const float*)(F.ws + WS_TOKW);
    int* ptok = (int*)(F.ws + WS_PTOK); float* pw = (float*)(F.ws + WS_PW); const v4u* hb = (const v4u*)(F.ws + WS_HB); v4u* xp = (v4u*)(F.ws + WS_XP);
    if (F.bx < 24) { const int c = F.bx; const int lo = tab[64 + c] + tab[128 + c], hi = tab[64 + c + 1]; for (int r = lo + F.tid; r < hi; r += 512) ptok[r] = -1; }
    for (int t = F.gw; t < T; t += F.ngw) {
        const int cls = tokc[t]; const int pos = tab[64 + cls] + tab[100 + cls] + toks[t];
#pragma unroll
        for (int j = 0; j < 4; ++j) xp[(size_t)pos * 256 + j * 64 + F.lane] = hb[(size_t)t * 256 + j * 64 + F.lane];
        if (F.lane == 0) { ptok[pos] = t; pw[2 * pos] = tokw[2 * t]; pw[2 * pos + 1] = tokw[2 * t + 1]; toks[t] = pos; }
    }
}

constexpr int NPH_LAYER = 9, NPH = 1 + DEPTH * NPH_LAYER;
__global__ void __launch_bounds__(512, 2) fwd(Args args) {
    extern __shared__ __attribute__((aligned(16))) unsigned char lds[];
    const int wave0 = __builtin_amdgcn_readfirstlane(threadIdx.x >> 6);
#define MKFRAME(F) Frame F; { int w_ = wave0; asm volatile("" : "+s"(w_)); int l_; asm volatile("v_mbcnt_lo_u32_b32 %0, -1, 0\n\tv_mbcnt_hi_u32_b32 %0, -1, %0" : "=v"(l_)); int t_ = w_ * 64 + l_; F.lds = (LAS unsigned char*)lds; F.tid = t_; F.lane = t_ & 63; F.wave = __builtin_amdgcn_readfirstlane(t_ >> 6); \
    int g_ = gridDim.x, b_ = blockIdx.x; asm volatile("" : "+s"(g_), "+s"(b_)); F.G = g_; F.bx = b_; F.gw = b_ * 8 + F.wave; F.ngw = g_ * 8; F.ws = args.ws; }
    MKFRAME(F);
    for (int u = F.tid; u < (LDS_BYTES - LDSCTL_OFF) / 4; u += 512) ((LAS unsigned*)(F.lds + LDSCTL_OFF))[u] = 0u;
    __syncthreads();
    volatile LAS unsigned* MISC = (volatile LAS unsigned*)(F.lds + MISC_OFF);
    XcdBarrier bar; bar.bar = (unsigned*)(F.ws + WS_CTL) + CW_BAR; bar.x = xb_xcc_id(); bar.st = MISC + 8;
    const int lo = args.ph_lo, hi = args.ph_hi;
    if (hi - lo > 1 && F.tid == 0) (void)xb_add(&bar.bar[XB_XCNT(bar.x)], 1u);
#ifndef PH_MASK
#define PH_MASK 0x3ff
#endif
#define IN(k) (lo <= (k) && (k) < hi)
#define EN(b) ((PH_MASK >> (b)) & 1)
#define SEAM(k) do { if (IN((k) + 1)) { MKFRAME(Fb_); xcd_barrier(bar, Fb_.tid); } } while (0)
    PG8_LAS unsigned char* ring = (PG8_LAS unsigned char*)lds;

    if (EN(9) && IN(0)) { for (int rep_ = 0; rep_ < (PDBL == 9 ? 2 : 1); ++rep_) { MKFRAME(F0); phase_prologue(F0, args); } SEAM(0); }

    for (int L = 0; L < DEPTH; ++L) {
        const int p0 = 1 + L * NPH_LAYER;
        unsigned char* wl = args.ws + WS_W + (size_t)L * LW_STRIDE;
        if (EN(0) && IN(p0 + 0)) { for (int rep_ = 0; rep_ < (PDBL == 0 ? 2 : 1); ++rep_) {
            MKFRAME(F);
            pg8::SchedDense S; S.A = (const char*)(F.ws + WS_HB); S.Bt = (const char*)(wl + LW_IN); S.tA = (size_t)256 * D * 2; S.tB = (size_t)256 * D * 2; S.so.init(T, ZP, F.G, F.bx);
            EpiZ E{(bf16*)(F.ws + WS_Z), (const float*)(F.ws + WS_CS)};
            pg8::gemm_phase<EpiZ, pg8::SchedDense, true>(ring, F.tid, D, D, D / 64, D / 64, S, E); }
            SEAM(p0 + 0);
        }
        if (EN(1) && IN(p0 + 1)) { for (int rep_ = 0; rep_ < (PDBL == 1 ? 2 : 1); ++rep_) {
            { MKFRAME(F1); for (int u = F1.bx; u < 384; u += F1.G) { MKFRAME(Fu); fa::unit_dilated((LAS char*)Fu.lds, Fu.ws, Fu.wave, Fu.lane, u); } }
            { MKFRAME(F1); phase_kmean(F1); } { MKFRAME(F1); for (int u = (F1.bx + F1.G - 128) % F1.G; u < 96; u += F1.G) unit_compress(F1, args, L, u); } }
            SEAM(p0 + 1); }
        if (EN(2) && IN(p0 + 2)) { for (int rep_ = 0; rep_ < (PDBL == 2 ? 2 : 1); ++rep_) {
            { MKFRAME(F2); unsigned* qh = (unsigned*)(F2.ws + WS_CTL) + CW_Q + (L * 2 + rep_) * 64; volatile LAS int* qw = (volatile LAS int*)(F2.lds + MISC_OFF + 64);
              for (;;) { const int k = dequeue(qh, qw, F2.tid); if (k >= 640) break; const int uid = P2_ORDER[k];
                  if (uid < 384) { MKFRAME(Fu); fa::unit_nsa((LAS char*)Fu.lds, Fu.ws, Fu.wave, Fu.lane, uid); } else { MKFRAME(Fu); fa::unit_moba((LAS char*)Fu.lds, Fu.ws, Fu.wave, Fu.lane, uid - 384); } } }
            { MKFRAME(F2); dil_combine(F2); } }
            SEAM(p0 + 2); }
        if (EN(3) && IN(p0 + 3)) { for (int rep_ = 0; rep_ < (PDBL == 3 ? 2 : 1); ++rep_) {
            MKFRAME(F);
            pg8::SchedDense S; S.A = (const char*)(F.ws + WS_MIX); S.Bt = (const char*)(wl + LW_OUT); S.tA = (size_t)256 * MIXW * 2; S.tB = (size_t)256 * MIXW * 2; S.so.init(T, D, F.G, F.bx);
            EpiRes E{(const bf16*)(F.ws + WS_HB), (float*)(F.ws + WS_Y)};
            pg8::gemm_phase<EpiRes, pg8::SchedDense, false>(ring, F.tid, MIXW, MIXW, MIXW / 64, MIXW / 64, S, E); }
            SEAM(p0 + 3);
        }
        if (EN(4) && IN(p0 + 4)) { MKFRAME(F4); phase_ln1_router(F4, args, L); SEAM(p0 + 4); }
        if (EN(5) && IN(p0 + 5)) { for (int rep_ = 0; rep_ < (PDBL == 5 ? 2 : 1); ++rep_) {
            { MKFRAME(F5); build_tiles(F5, L); phase_gather(F5, L); } __syncthreads();
            { MKFRAME(F); pg8::SchedDense S; S.A = (const char*)(F.ws + WS_PB) + (size_t)L * T * PLE * 2; S.Bt = (const char*)(wl + LW_PP); S.tA = (size_t)256 * PLE * 2; S.tB = (size_t)256 * PLE * 2; S.so.init(T, D, F.G, F.bx);
              EpiF32 E{(float*)(F.ws + WS_PPLE)};
              pg8::gemm_phase<EpiF32, pg8::SchedDense, false>(ring, F.tid, PLE, PLE, PLE / 64, PLE / 64, S, E); }
            { MKFRAME(F); pg8::SchedDense S; S.A = (const char*)(F.ws + WS_HB); S.Bt = (const char*)(wl + LW_PG); S.tA = (size_t)256 * D * 2; S.tB = (size_t)256 * D * 2; S.so.init(T, D, F.G, F.bx);
              EpiPle E{(const bf16*)(F.ws + WS_HB), (const float*)(F.ws + WS_PPLE), args.in[I_PGB] + (size_t)L * D, (float*)(F.ws + WS_Y)};
              pg8::gemm_phase<EpiPle, pg8::SchedDense, false>(ring, F.tid, D, D, D / 64, D / 64, S, E); } }
            SEAM(p0 + 5);
        }
        if (EN(6) && IN(p0 + 6)) { for (int rep_ = 0; rep_ < (PDBL == 6 ? 2 : 1); ++rep_) {
            MKFRAME(F); build_tiles(F, L);
            const volatile LAS int* tab = (const volatile LAS int*)(F.lds + TILE_OFF);
            SchedGU S{(const char*)(F.ws + WS_XP), (const char*)(wl + LW_GU), tab, F.G, F.bx, __builtin_amdgcn_readfirstlane(tab[96])};
            EpiGU E{(bf16*)(F.ws + WS_HID), (const float*)(F.ws + WS_PW)};
            pg8::gemm_phase<EpiGU, SchedGU, true>(ring, F.tid, D, D, D / 64, D / 64, S, E); }
            SEAM(p0 + 6);
        }
        if (EN(7) && IN(p0 + 7)) {
            MKFRAME(F); build_tiles(F, L);
            const volatile LAS int* tab = (const volatile LAS int*)(F.lds + TILE_OFF);
            SchedDown S{(const char*)(F.ws + WS_HID), (const char*)(wl + LW_D), tab, F.G, F.bx, __builtin_amdgcn_readfirstlane(tab[96])};
            EpiDown E{(bf16*)(F.ws + WS_XP)};
            pg8::gemm_phase<EpiDown, SchedDown, false>(ring, F.tid, 1024, EH, 16, 8, S, E);
            SEAM(p0 + 7);
        }
        if (EN(8) && IN(p0 + 8)) { for (int rep_ = 0; rep_ < (PDBL == 8 ? 2 : 1); ++rep_) {
            const bool lastL = (L == DEPTH - 1); MKFRAME(F);
            for (int m = F.gw; m < T; m += F.ngw) { f32x4 o[8];
                ln_row((const float*)(F.ws + WS_Y) + (size_t)m * D, (const bf16*)(F.ws + WS_XP) + (size_t)((const int*)(F.ws + WS_TOKS))[m] * D, args.in[I_LN2G] + (size_t)L * D, args.in[I_LN2B] + (size_t)L * D,
                       lastL ? args.out + (size_t)m * D : (float*)nullptr, lastL ? (bf16*)nullptr : (bf16*)(F.ws + WS_HB) + (size_t)m * D, F.lane, o); } }
            SEAM(p0 + 8);
        }
    }
#undef IN
#undef SEAM
}

extern "C" void kernel_launch(void* const* d_in, const int* in_sizes, int n_in, void* d_out, int out_size, void* d_ws, size_t ws_size, hipStream_t stream) {
    static int grid = 0;
    if (grid == 0) {
        if (n_in != 25 || ws_size < WS_END) { fprintf(stderr, "kernel_launch: unexpected n_in %d / ws %zu\n", n_in, ws_size); grid = -1; return; }
        int dev = 0, cus = 0;
        if (hipGetDevice(&dev) != hipSuccess || hipDeviceGetAttribute(&cus, hipDeviceAttributeMultiprocessorCount, dev) != hipSuccess) { grid = -1; return; }
        if (hipFuncSetAttribute((const void*)fwd, hipFuncAttributeMaxDynamicSharedMemorySize, LDS_BYTES) != hipSuccess) { fprintf(stderr, "kernel_launch: hipFuncSetAttribute failed\n"); grid = -1; return; }
        int per_cu = 0; (void)hipOccupancyMaxActiveBlocksPerMultiprocessor(&per_cu, (const void*)fwd, 512, LDS_BYTES); (void)hipGetLastError();
        grid = cus;
    }
    if (grid < 0) return;
    (void)hipMemsetAsync((char*)d_ws + WS_CTL, 0, CTL_ZERO_BYTES, stream);
    Args a{};
    for (int i = 0; i < 25; ++i) a.in[i] = (const float*)d_in[i];
    a.out = (float*)d_out; a.ws = (unsigned char*)d_ws;
#if MK_SINGLE
    a.ph_lo = 0; a.ph_hi = NPH;
    hipLaunchKernelGGL(fwd, dim3(grid), dim3(512), LDS_BYTES, stream, a);
#else
    for (int p = 0; p < NPH; ++p) { a.ph_lo = p; a.ph_hi = p + 1; const int reps = ((p == 0 && HOSTDBL == 9) || (p > 0 && (p - 1) % NPH_LAYER == HOSTDBL)) ? 2 : 1;
        for (int r = 0; r < reps; ++r) hipLaunchKernelGGL(fwd, dim3(grid), dim3(512), LDS_BYTES, stream, a); }
#endif
}
```
